# Optimizing an MI355X kernel written in HIP

```python
import math
import jax, jax.numpy as jnp
from jax import lax
import numpy as np

D_MODEL = 1024
BATCH = 2
SEQ = 8192
DEPTH = 2

N_EVEN = (DEPTH + 1) // 2
N_ODD = DEPTH // 2

D_A = D_MODEL // 2
D_B = D_MODEL // 2
CONV_A = 31
CONV_B = 3
D_IN_EVEN = 2 * D_A + 3 * D_B

D_RNN = D_MODEL
RNN_BLOCK = 256
RNN_HEADS = D_RNN // RNN_BLOCK
CONV_C = 4
LRU_C = 8.0

N_EXPERTS = 16
N_EXPERT_GROUPS = 4
EXPERTS_PER_GROUP = N_EXPERTS // N_EXPERT_GROUPS
TOP_K = 2
D_EXPERT = D_MODEL
MOE_BLOCK = 128

LN_EPS = 1e-5
ALPHA = (2.0 * DEPTH) ** 0.25
BETA = (8.0 * DEPTH) ** -0.25

kernel_name = "hybrid_conformer_shortconv_rglru_grouped_moe_deepnorm"


def layer_norm(x, g, b):
    xf = x.astype(jnp.float32)
    mu = jnp.mean(xf, axis=-1, keepdims=True)
    var = jnp.mean(jnp.square(xf - mu), axis=-1, keepdims=True)
    y = (xf - mu) * lax.rsqrt(var + LN_EPS)
    return (y * g.astype(jnp.float32) + b.astype(jnp.float32)).astype(x.dtype)


def causal_depthwise_conv(x, w):
    k, c = w.shape
    return lax.conv_general_dilated(
        x, w[:, None, :].astype(x.dtype), window_strides=(1,), padding=[(k - 1, 0)],
        dimension_numbers=("NWC", "WIO", "NWC"), feature_group_count=c)


def conv_mixer(x, w_in, a_dw, a_dw_b, a_ln_g, a_ln_b, b_dw, w_out):
    u = jnp.einsum("bsd,de->bse", x, w_in)
    a_val, a_gate, b_b, b_c, b_x = jnp.split(
        u, [D_A, 2 * D_A, 2 * D_A + D_B, 2 * D_A + 2 * D_B], axis=-1)
    a = a_val * jax.nn.sigmoid(a_gate)
    a = causal_depthwise_conv(a, a_dw) + a_dw_b
    a = jax.nn.silu(layer_norm(a, a_ln_g, a_ln_b))
    bb = b_b * causal_depthwise_conv(b_c * b_x, b_dw)
    return jnp.einsum("bse,ed->bsd", jnp.concatenate([a, bb], axis=-1), w_out)


def _linear_recurrence_combine(c1, c2):
    a1, b1 = c1
    a2, b2 = c2
    return a1 * a2, a2 * b1 + b2


def rglru_mixer(x, w_in, c_dw, c_dw_b, w_gate_a, b_gate_a, w_gate_x, b_gate_x, lam, w_out):
    bsz, seq, _ = x.shape
    u = jnp.einsum("bsd,de->bse", x, w_in)
    y_branch, xr = jnp.split(u, 2, axis=-1)
    xr = causal_depthwise_conv(xr, c_dw) + c_dw_b
    xh = xr.reshape(bsz, seq, RNN_HEADS, RNN_BLOCK)
    r = jax.nn.sigmoid(jnp.einsum("bshi,hij->bshj", xh, w_gate_a) + b_gate_a)
    i = jax.nn.sigmoid(jnp.einsum("bshi,hij->bshj", xh, w_gate_x) + b_gate_x)
    r = r.reshape(bsz, seq, D_RNN).astype(jnp.float32)
    i = i.reshape(bsz, seq, D_RNN)
    log_a = -LRU_C * r * jax.nn.softplus(-lam.astype(jnp.float32))
    a = jnp.exp(log_a)
    mult = jnp.sqrt(-jnp.expm1(2.0 * log_a))
    b = mult * (i * xr).astype(jnp.float32)
    _, h = lax.associative_scan(_linear_recurrence_combine, (a, b), axis=1)
    out = jax.nn.gelu(y_branch) * h.astype(x.dtype)
    return jnp.einsum("bse,ed->bsd", out, w_out)


def route(xf, w_router, b_router):
    t = xf.shape[0]
    logits = (xf @ w_router + b_router).astype(jnp.float32)
    probs = jax.nn.softmax(logits, axis=-1)
    pg = probs.reshape(t, N_EXPERT_GROUPS, EXPERTS_PER_GROUP)
    group_score = lax.top_k(pg, TOP_K)[0].sum(-1)
    g_sel = jnp.argmax(group_score, axis=-1)
    p_in = jnp.take_along_axis(pg, g_sel[:, None, None], axis=1)[:, 0]
    top_p, top_i = lax.top_k(p_in, TOP_K)
    expert_idx = g_sel[:, None] * EXPERTS_PER_GROUP + top_i
    gates = top_p / jnp.sum(top_p, axis=-1, keepdims=True)
    return expert_idx, gates


def moe(x, w_router, b_router, w1, w3, w2):
    bsz, seq, d = x.shape
    t = bsz * seq
    xf = x.reshape(t, d)
    e_idx, gates = route(xf, w_router, b_router)
    n_assign = t * TOP_K
    e_flat = e_idx.reshape(n_assign)
    tok_flat = jnp.repeat(jnp.arange(t, dtype=jnp.int32), TOP_K)
    g_flat = gates.reshape(n_assign)
    order = jnp.argsort(e_flat)
    e_s, tok_s, g_s = e_flat[order], tok_flat[order], g_flat[order]
    counts = jnp.bincount(e_flat, length=N_EXPERTS)
    padded = (counts + MOE_BLOCK - 1) // MOE_BLOCK * MOE_BLOCK
    start = jnp.cumsum(counts) - counts
    pend = jnp.cumsum(padded)
    pstart = pend - padded
    dest = pstart[e_s] + jnp.arange(n_assign, dtype=jnp.int32) - start[e_s]
    n_blocks = -(-n_assign // MOE_BLOCK) + N_EXPERTS
    n_pad = n_blocks * MOE_BLOCK
    x_pad = jnp.zeros((n_pad, d), x.dtype).at[dest].set(xf[tok_s])
    block_expert = jnp.minimum(
        jnp.searchsorted(pend, jnp.arange(n_blocks, dtype=pend.dtype) * MOE_BLOCK, side="right"),
        N_EXPERTS - 1)

    def expert_block(args):
        xb, e = args
        hb = jax.nn.silu(xb @ w1[e]) * (xb @ w3[e])
        return hb @ w2[e]

    y_pad = lax.map(expert_block, (x_pad.reshape(n_blocks, MOE_BLOCK, d), block_expert))
    y = y_pad.reshape(n_pad, d)[dest] * g_s[:, None].astype(x.dtype)
    out = jnp.zeros((t, d), x.dtype).at[tok_s].add(y)
    return out.reshape(bsz, seq, d)


def setup_inputs(seed: int = 0) -> dict:
    key = jax.random.key(seed)
    ks = jax.random.split(key, 26)
    nrm = lambda k, shape, s: jax.random.normal(k, shape, jnp.float32) * s
    a0 = jax.random.uniform(ks[19], (N_ODD, D_RNN), jnp.float32, 0.9, 0.999)
    s0 = a0 ** (1.0 / LRU_C)
    lam = jnp.log(s0) - jnp.log1p(-s0)
    return {
        "x": nrm(ks[0], (BATCH, SEQ, D_MODEL), 1.0),
        "ln1_g": 1.0 + nrm(ks[1], (DEPTH, D_MODEL), 0.02),
        "ln1_b": nrm(ks[2], (DEPTH, D_MODEL), 0.02),
        "ln2_g": 1.0 + nrm(ks[3], (DEPTH, D_MODEL), 0.02),
        "ln2_b": nrm(ks[4], (DEPTH, D_MODEL), 0.02),
        "even_w_in": nrm(ks[5], (N_EVEN, D_MODEL, D_IN_EVEN), D_MODEL ** -0.5),
        "even_a_dw": nrm(ks[6], (N_EVEN, CONV_A, D_A), CONV_A ** -0.5),
        "even_a_dw_b": nrm(ks[7], (N_EVEN, D_A), 0.02),
        "even_a_ln_g": 1.0 + nrm(ks[8], (N_EVEN, D_A), 0.02),
        "even_a_ln_b": nrm(ks[9], (N_EVEN, D_A), 0.02),
        "even_b_dw": nrm(ks[10], (N_EVEN, CONV_B, D_B), CONV_B ** -0.5),
        "even_w_out": nrm(ks[11], (N_EVEN, D_A + D_B, D_MODEL), BETA * (D_A + D_B) ** -0.5),
        "odd_w_in": nrm(ks[12], (N_ODD, D_MODEL, 2 * D_RNN), D_MODEL ** -0.5),
        "odd_c_dw": nrm(ks[13], (N_ODD, CONV_C, D_RNN), CONV_C ** -0.5),
        "odd_c_dw_b": nrm(ks[14], (N_ODD, D_RNN), 0.02),
        "odd_w_gate_a": nrm(ks[15], (N_ODD, RNN_HEADS, RNN_BLOCK, RNN_BLOCK), RNN_BLOCK ** -0.5),
        "odd_b_gate_a": nrm(ks[16], (N_ODD, RNN_HEADS, RNN_BLOCK), 0.02),
        "odd_w_gate_x": nrm(ks[17], (N_ODD, RNN_HEADS, RNN_BLOCK, RNN_BLOCK), RNN_BLOCK ** -0.5),
        "odd_b_gate_x": nrm(ks[18], (N_ODD, RNN_HEADS, RNN_BLOCK), 0.02),
        "odd_lam": lam,
        "odd_w_out": nrm(ks[20], (N_ODD, D_RNN, D_MODEL), BETA * D_RNN ** -0.5),
        "w_router": nrm(ks[21], (D_MODEL, N_EXPERTS), D_MODEL ** -0.5),
        "b_router": nrm(ks[22], (N_EXPERTS,), 0.01),
        "moe_w1": nrm(ks[23], (DEPTH, N_EXPERTS, D_MODEL, D_EXPERT), D_MODEL ** -0.5),
        "moe_w3": nrm(ks[24], (DEPTH, N_EXPERTS, D_MODEL, D_EXPERT), D_MODEL ** -0.5),
        "moe_w2": nrm(ks[25], (DEPTH, N_EXPERTS, D_EXPERT, D_MODEL), BETA * D_EXPERT ** -0.5),
    }


def reference(x, ln1_g, ln1_b, ln2_g, ln2_b, even_w_in, even_a_dw, even_a_dw_b, even_a_ln_g,
              even_a_ln_b, even_b_dw, even_w_out, odd_w_in, odd_c_dw, odd_c_dw_b, odd_w_gate_a,
              odd_b_gate_a, odd_w_gate_x, odd_b_gate_x, odd_lam, odd_w_out, w_router, b_router,
              moe_w1, moe_w3, moe_w2):
    for layer in range(DEPTH):
        j = layer // 2
        if layer % 2 == 0:
            m = conv_mixer(x, even_w_in[j], even_a_dw[j], even_a_dw_b[j], even_a_ln_g[j],
                           even_a_ln_b[j], even_b_dw[j], even_w_out[j])
        else:
            m = rglru_mixer(x, odd_w_in[j], odd_c_dw[j], odd_c_dw_b[j], odd_w_gate_a[j],
                            odd_b_gate_a[j], odd_w_gate_x[j], odd_b_gate_x[j], odd_lam[j],
                            odd_w_out[j])
        x = layer_norm(ALPHA * x + m, ln1_g[layer], ln1_b[layer])
        f = moe(x, w_router, b_router, moe_w1[layer], moe_w3[layer], moe_w2[layer])
        x = layer_norm(ALPHA * x + f, ln2_g[layer], ln2_b[layer])
    return x
```

```cpp
#define BUILD_MODE 0
#include <hip/hip_runtime.h>
#include <cstdio>
#include <cstdint>
#include <cmath>
constexpr int D = 1024, BATCH = 2, SEQ = 8192, T = BATCH * SEQ, DEPTH = 2;
constexpr int DA = 512, DB = 512, DIN0 = 2 * DA + 3 * DB, CONVA = 31, CONVB = 3;
constexpr int DRNN = 1024, RBLK = 256, RHEADS = 4, CONVC = 4;
constexpr int NE = 16, NG = 4, EPG = 4, DEXP = 1024;
constexpr float LN_EPS = 1e-5f, ALPHA = 1.41421356237309515f;
namespace ref {
__device__ __forceinline__ float sigmoidf_(float x) { return 1.0f / (1.0f + expf(-x)); }
__device__ __forceinline__ float siluf_(float x) { return x * sigmoidf_(x); }
__device__ __forceinline__ float gelu_tanh_(float x) { const float u = 0.7978845608028654f * (x + 0.044715f * x * x * x); return 0.5f * x * (1.0f + tanhf(u)); }
__device__ __forceinline__ float wsum(float v) {
#pragma unroll
    for (int o = 1; o < 64; o <<= 1) v += __shfl_xor(v, o);
    return v;
}
template <int MODE>
__global__ void __launch_bounds__(256) gemm(const float* A, int lda, int azoff, const int* arow, const float* B, const float* B2, int ldb, size_t bstride,
                                            float* C, int ldc, int czoff, const int* cnt, const int* start, int M, int N, int K) {
    const int z = blockIdx.z;
    const int m_cnt = cnt ? cnt[z] : M, r0 = start ? start[z] : 0;
    const int tm = blockIdx.y * 128, tn = blockIdx.x * 64;
    if (tm >= m_cnt) return;
    A += (size_t)z * azoff; C += (size_t)z * czoff; B += (size_t)z * bstride; if (MODE == 1) B2 += (size_t)z * bstride;
    __shared__ float As[16][132]; __shared__ float Bs[16][64]; __shared__ float Bs2[MODE == 1 ? 16 : 1][64];
    const int tid = threadIdx.x, tx = tid & 15, ty = tid >> 4;
    float acc[8][4], acc2[8][4];
#pragma unroll
    for (int i = 0; i < 8; ++i)
#pragma unroll
        for (int j = 0; j < 4; ++j) { acc[i][j] = 0.f; acc2[i][j] = 0.f; }
    const int arow_l = tid >> 2, akq = (tid & 3) * 4;
    long src0, src1;
    { const int g0 = tm + arow_l, g1 = g0 + 64;
      src0 = g0 < m_cnt ? (long)(arow ? arow[r0 + g0] : r0 + g0) : -1; src1 = g1 < m_cnt ? (long)(arow ? arow[r0 + g1] : r0 + g1) : -1; }
    const int bk = tid >> 4, bn = (tid & 15) * 4;
    for (int k0 = 0; k0 < K; k0 += 16) {
        float4 a0 = src0 >= 0 ? *(const float4*)(A + (size_t)src0 * lda + k0 + akq) : make_float4(0, 0, 0, 0);
        float4 a1 = src1 >= 0 ? *(const float4*)(A + (size_t)src1 * lda + k0 + akq) : make_float4(0, 0, 0, 0);
        As[akq + 0][arow_l] = a0.x; As[akq + 1][arow_l] = a0.y; As[akq + 2][arow_l] = a0.z; As[akq + 3][arow_l] = a0.w;
        As[akq + 0][arow_l + 64] = a1.x; As[akq + 1][arow_l + 64] = a1.y; As[akq + 2][arow_l + 64] = a1.z; As[akq + 3][arow_l + 64] = a1.w;
        *(float4*)&Bs[bk][bn] = *(const float4*)(B + (size_t)(k0 + bk) * ldb + tn + bn);
        if (MODE == 1) *(float4*)&Bs2[bk][bn] = *(const float4*)(B2 + (size_t)(k0 + bk) * ldb + tn + bn);
        __syncthreads();
#pragma unroll
        for (int kk = 0; kk < 16; ++kk) {
            const float4 al = *(const float4*)&As[kk][ty * 8], ah = *(const float4*)&As[kk][ty * 8 + 4];
            const float4 b = *(const float4*)&Bs[kk][tx * 4];
            const float av[8] = {al.x, al.y, al.z, al.w, ah.x, ah.y, ah.z, ah.w}; const float bv[4] = {b.x, b.y, b.z, b.w};
#pragma unroll
            for (int i = 0; i < 8; ++i)
#pragma unroll
                for (int j = 0; j < 4; ++j) acc[i][j] += av[i] * bv[j];
            if (MODE == 1) { const float4 b2 = *(const float4*)&Bs2[kk][tx * 4]; const float b2v[4] = {b2.x, b2.y, b2.z, b2.w};
#pragma unroll
                for (int i = 0; i < 8; ++i)
#pragma unroll
                    for (int j = 0; j < 4; ++j) acc2[i][j] += av[i] * b2v[j]; }
        }
        __syncthreads();
    }
#pragma unroll
    for (int i = 0; i < 8; ++i) { const int gr = tm + ty * 8 + i; if (gr < m_cnt) {
        float4 o;
        if (MODE == 1) { o.x = siluf_(acc[i][0]) * acc2[i][0]; o.y = siluf_(acc[i][1]) * acc2[i][1]; o.z = siluf_(acc[i][2]) * acc2[i][2]; o.w = siluf_(acc[i][3]) * acc2[i][3]; }
        else { o.x = acc[i][0]; o.y = acc[i][1]; o.z = acc[i][2]; o.w = acc[i][3]; }
        *(float4*)(C + (size_t)(r0 + gr) * ldc + tn + tx * 4) = o; } }
}
__global__ void mixA_pre(const float* u0, const float* w, const float* bias, float* apre, int nt) {
    const int idx = blockIdx.x * blockDim.x + threadIdx.x; if (idx >= nt * DA) return;
    const int t = idx / DA, c = idx % DA, s = t % SEQ; float acc = bias[c];
    for (int k = 0; k < CONVA; ++k) { const int d = CONVA - 1 - k; if (s - d < 0) continue; const float* r = u0 + (size_t)(t - d) * DIN0; acc += w[k * DA + c] * (r[c] * sigmoidf_(r[DA + c])); }
    apre[idx] = acc;
}
__global__ void mixB(const float* u0, const float* w, float* cat, int nt) {
    const int idx = blockIdx.x * blockDim.x + threadIdx.x; if (idx >= nt * DB) return;
    const int t = idx / DB, c = idx % DB, s = t % SEQ; float acc = 0.f;
    for (int k = 0; k < CONVB; ++k) { const int d = CONVB - 1 - k; if (s - d < 0) continue; const float* r = u0 + (size_t)(t - d) * DIN0; acc += w[k * DB + c] * (r[2 * DA + DB + c] * r[2 * DA + 2 * DB + c]); }
    cat[(size_t)t * D + DA + c] = u0[(size_t)t * DIN0 + 2 * DA + c] * acc;
}
__global__ void __launch_bounds__(64) ln_rows(const float* in, int ldi, const float* res, int ldr, float alpha, int n, const float* g, const float* b, float* out, int ldo, int act) {
    const int row = blockIdx.x, lane = threadIdx.x; float s = 0.f;
    for (int c = lane; c < n; c += 64) { float v = in[(size_t)row * ldi + c]; if (res) v += alpha * res[(size_t)row * ldr + c]; s += v; }
    const float mean = wsum(s) / n; float q = 0.f;
    for (int c = lane; c < n; c += 64) { float v = in[(size_t)row * ldi + c]; if (res) v += alpha * res[(size_t)row * ldr + c]; v -= mean; q += v * v; }
    const float rstd = 1.0f / sqrtf(wsum(q) / n + LN_EPS);
    for (int c = lane; c < n; c += 64) { float v = in[(size_t)row * ldi + c]; if (res) v += alpha * res[(size_t)row * ldr + c]; v = (v - mean) * rstd * g[c] + b[c]; if (act == 1) v = siluf_(v); out[(size_t)row * ldo + c] = v; }
}
__global__ void __launch_bounds__(64) route(const float* x1, const float* wr, const float* br, int* eidx, float* gate) {
    const int t = blockIdx.x, lane = threadIdx.x; float l[NE];
#pragma unroll
    for (int e = 0; e < NE; ++e) l[e] = 0.f;
    for (int c = lane; c < D; c += 64) { const float xv = x1[(size_t)t * D + c];
#pragma unroll
        for (int e = 0; e < NE; ++e) l[e] += xv * wr[c * NE + e]; }
#pragma unroll
    for (int e = 0; e < NE; ++e) l[e] = wsum(l[e]) + br[e];
    if (lane == 0) {
        float mx = l[0];
#pragma unroll
        for (int e = 1; e < NE; ++e) mx = fmaxf(mx, l[e]);
        float p[NE], sum = 0.f;
#pragma unroll
        for (int e = 0; e < NE; ++e) { p[e] = expf(l[e] - mx); sum += p[e]; }
#pragma unroll
        for (int e = 0; e < NE; ++e) p[e] /= sum;
        int gsel = 0; float best = -1.f;
#pragma unroll
        for (int g = 0; g < NG; ++g) { float m1 = -1.f, m2 = -1.f;
#pragma unroll
            for (int j = 0; j < EPG; ++j) { const float v = p[g * EPG + j]; if (v > m1) { m2 = m1; m1 = v; } else if (v > m2) m2 = v; }
            const float sc = m1 + m2; if (sc > best) { best = sc; gsel = g; } }
        float q[EPG];
#pragma unroll
        for (int g = 0; g < NG; ++g) if (g == gsel) {
#pragma unroll
            for (int j = 0; j < EPG; ++j) q[j] = p[g * EPG + j]; }
        int i1 = 0; float p1 = q[0];
#pragma unroll
        for (int j = 1; j < EPG; ++j) if (q[j] > p1) { p1 = q[j]; i1 = j; }
        int i2 = -1; float p2 = -1.f;
#pragma unroll
        for (int j = 0; j < EPG; ++j) if (j != i1 && q[j] > p2) { p2 = q[j]; i2 = j; }
        eidx[2 * t] = gsel * EPG + i1; eidx[2 * t + 1] = gsel * EPG + i2; gate[2 * t] = p1 / (p1 + p2); gate[2 * t + 1] = p2 / (p1 + p2);
    }
}
__global__ void __launch_bounds__(64) lists(const int* eidx, int nt, int* cnt, int* start, int* list, int* rowof) {
    __shared__ int c_[NE], s_[NE]; const int e = threadIdx.x;
    if (e < NE) { int c = 0; for (int a = 0; a < 2 * nt; ++a) c += (eidx[a] == e); c_[e] = c; cnt[e] = c; }
    __syncthreads();
    if (e == 0) { int acc = 0; for (int j = 0; j < NE; ++j) { s_[j] = acc; start[j] = acc; acc += c_[j]; } }
    __syncthreads();
    if (e < NE) { int p = s_[e]; for (int a = 0; a < 2 * nt; ++a) if (eidx[a] == e) { list[p] = a >> 1; rowof[a] = p; ++p; } }
}
__global__ void __launch_bounds__(64) combine_ln(const float* x1, const float* y, const int* rowof, const float* gate, const float* g, const float* b, float* out) {
    const int t = blockIdx.x, lane = threadIdx.x; const int r0 = rowof[2 * t], r1 = rowof[2 * t + 1]; const float g0 = gate[2 * t], g1 = gate[2 * t + 1];
    float v[D / 64]; float s = 0.f;
#pragma unroll
    for (int i = 0; i < D / 64; ++i) { const int c = lane + 64 * i; v[i] = ALPHA * x1[(size_t)t * D + c] + (g0 * y[(size_t)r0 * D + c] + g1 * y[(size_t)r1 * D + c]); s += v[i]; }
    const float mean = wsum(s) / D; float q = 0.f;
#pragma unroll
    for (int i = 0; i < D / 64; ++i) { v[i] -= mean; q += v[i] * v[i]; }
    const float rstd = 1.0f / sqrtf(wsum(q) / D + LN_EPS);
#pragma unroll
    for (int i = 0; i < D / 64; ++i) { const int c = lane + 64 * i; out[(size_t)t * D + c] = v[i] * rstd * g[c] + b[c]; }
}
__global__ void conv4(const float* u1, const float* w, const float* bias, float* xc, int nt) {
    const int idx = blockIdx.x * blockDim.x + threadIdx.x; if (idx >= nt * DRNN) return;
    const int t = idx / DRNN, c = idx % DRNN, s = t % SEQ; float acc = bias[c];
    for (int k = 0; k < CONVC; ++k) { const int d = CONVC - 1 - k; if (s - d < 0) continue; acc += w[k * DRNN + c] * u1[(size_t)(t - d) * (2 * DRNN) + DRNN + c]; }
    xc[idx] = acc;
}
__global__ void ab(float* ra, float* rx, const float* xc, const float* ba, const float* bx, const float* lam, int nt) {
    const int idx = blockIdx.x * blockDim.x + threadIdx.x; if (idx >= nt * DRNN) return;
    const int c = idx % DRNN; const float r = sigmoidf_(ra[idx] + ba[c]), i = sigmoidf_(rx[idx] + bx[c]);
    const float sp = log1pf(expf(-lam[c])); const float la = -8.0f * r * sp; const float a = expf(la); const float mult = sqrtf(-expm1f(2.0f * la));
    ra[idx] = a; rx[idx] = mult * (i * xc[idx]);
}
__global__ void scan(const float* a, float* b, int nt) {
    const int idx = blockIdx.x * blockDim.x + threadIdx.x; const int nb = (nt + SEQ - 1) / SEQ; if (idx >= nb * DRNN) return;
    const int bt = idx / DRNN, c = idx % DRNN; const int t1 = min(nt, (bt + 1) * SEQ); float h = 0.f;
    for (int t = bt * SEQ; t < t1; ++t) { const size_t o = (size_t)t * DRNN + c; h = a[o] * h + b[o]; b[o] = h; }
}
__global__ void gelu_mul(const float* u1, const float* h, float* out, int nt) {
    const int idx = blockIdx.x * blockDim.x + threadIdx.x; if (idx >= nt * DRNN) return;
    const int t = idx / DRNN, c = idx % DRNN; out[idx] = gelu_tanh_(u1[(size_t)t * (2 * DRNN) + c]) * h[idx];
}

struct Bufs { float *RU, *R1, *R2, *R3, *RX1, *RX2; int *eidx, *list, *rowof, *cnt, *start; float* gate; };
__host__ inline Bufs carve(unsigned char* base, int nt) {
    Bufs b; size_t o = 0; auto take = [&](size_t bytes) { unsigned char* p = base + o; o += (bytes + 255) & ~(size_t)255; return p; };
    b.RU = (float*)take((size_t)nt * DIN0 * 4); b.R1 = (float*)take((size_t)nt * D * 4); b.R2 = (float*)take((size_t)nt * D * 4); b.R3 = (float*)take((size_t)nt * D * 4);
    b.RX1 = (float*)take((size_t)nt * D * 4); b.RX2 = (float*)take((size_t)nt * D * 4);
    b.eidx = (int*)take((size_t)nt * 2 * 4); b.gate = (float*)take((size_t)nt * 2 * 4); b.list = (int*)take((size_t)nt * 2 * 4); b.rowof = (int*)take((size_t)nt * 2 * 4);
    b.cnt = (int*)take(64); b.start = (int*)take(64); return b;
}
__host__ inline size_t bytes_needed(int nt) { return (size_t)nt * (DIN0 + 5 * D) * 4 + (size_t)nt * 32 + 4096; }
#define RGEMM(MODE, gx, gy, gz, ...) hipLaunchKernelGGL((ref::gemm<MODE>), dim3(gx, gy, gz), dim3(256), 0, st, __VA_ARGS__)
struct Fwd {
    Bufs b; int nt; hipStream_t st; void* const* in;
    const float* I(int i) const { return (const float*)in[i]; }
    void mixer0(const float* x) {
        RGEMM(0, DIN0 / 64, (nt + 127) / 128, 1, x, D, 0, nullptr, I(5), nullptr, DIN0, 0, b.RU, DIN0, 0, nullptr, nullptr, nt, DIN0, D);
        hipLaunchKernelGGL(mixA_pre, dim3((nt * DA + 255) / 256), dim3(256), 0, st, b.RU, I(6), I(7), b.R1, nt);
        hipLaunchKernelGGL(ln_rows, dim3(nt), dim3(64), 0, st, b.R1, DA, nullptr, 0, 0.f, DA, I(8), I(9), b.R2, D, 1);
        hipLaunchKernelGGL(mixB, dim3((nt * DB + 255) / 256), dim3(256), 0, st, b.RU, I(10), b.R2, nt);
        RGEMM(0, D / 64, (nt + 127) / 128, 1, b.R2, D, 0, nullptr, I(11), nullptr, D, 0, b.R3, D, 0, nullptr, nullptr, nt, D, D);
    }
    void ln1(const float* xres, int layer) {
        hipLaunchKernelGGL(ln_rows, dim3(nt), dim3(64), 0, st, layer == 0 ? b.R3 : b.R1, D, xres, D, ALPHA, D, I(1) + layer * D, I(2) + layer * D, b.RX1, D, 0);
    }
    void routing() {
        hipLaunchKernelGGL(route, dim3(nt), dim3(64), 0, st, b.RX1, I(21), I(22), b.eidx, b.gate);
        hipLaunchKernelGGL(lists, dim3(1), dim3(64), 0, st, b.eidx, nt, b.cnt, b.start, b.list, b.rowof);
    }
    void moe_h(int layer) {
        const size_t lo = (size_t)layer * NE * D * DEXP;
        RGEMM(1, DEXP / 64, (nt + 127) / 128, NE, b.RX1, D, 0, b.list, I(23) + lo, I(24) + lo, DEXP, (size_t)D * DEXP, b.RU, DEXP, 0, b.cnt, b.start, 0, DEXP, D);
    }
    void moe_y(int layer) {
        const size_t lo = (size_t)layer * NE * D * DEXP;
        RGEMM(0, D / 64, (nt + 127) / 128, NE, b.RU, DEXP, 0, nullptr, I(25) + lo, nullptr, D, (size_t)DEXP * D, b.R1, D, 0, b.cnt, b.start, 0, D, DEXP);
    }
    void combine(int layer, float* out) {
        hipLaunchKernelGGL(combine_ln, dim3(nt), dim3(64), 0, st, b.RX1, b.R1, b.rowof, b.gate, I(3) + layer * D, I(4) + layer * D, out);
    }
    void mixer1_in() {
        RGEMM(0, 2 * DRNN / 64, (nt + 127) / 128, 1, b.RX2, D, 0, nullptr, I(12), nullptr, 2 * DRNN, 0, b.RU, 2 * DRNN, 0, nullptr, nullptr, nt, 2 * DRNN, D);
        hipLaunchKernelGGL(conv4, dim3((nt * DRNN + 255) / 256), dim3(256), 0, st, b.RU, I(13), I(14), b.R1, nt);
    }
    void mixer1_gates() {
        RGEMM(0, RBLK / 64, (nt + 127) / 128, RHEADS, b.R1, DRNN, RBLK, nullptr, I(15), nullptr, RBLK, (size_t)RBLK * RBLK, b.R2, DRNN, RBLK, nullptr, nullptr, nt, RBLK, RBLK);
        RGEMM(0, RBLK / 64, (nt + 127) / 128, RHEADS, b.R1, DRNN, RBLK, nullptr, I(17), nullptr, RBLK, (size_t)RBLK * RBLK, b.R3, DRNN, RBLK, nullptr, nullptr, nt, RBLK, RBLK);
        hipLaunchKernelGGL(ab, dim3((nt * DRNN + 255) / 256), dim3(256), 0, st, b.R2, b.R3, b.R1, I(16), I(18), I(19), nt);
    }
    void mixer1_scan_out() {
        const int nb = (nt + SEQ - 1) / SEQ;
        hipLaunchKernelGGL(scan, dim3((nb * DRNN + 63) / 64), dim3(64), 0, st, b.R2, b.R3, nt);
        hipLaunchKernelGGL(gelu_mul, dim3((nt * DRNN + 255) / 256), dim3(256), 0, st, b.RU, b.R3, b.R2, nt);
        RGEMM(0, D / 64, (nt + 127) / 128, 1, b.R2, DRNN, 0, nullptr, I(20), nullptr, D, 0, b.R1, D, 0, nullptr, nullptr, nt, D, DRNN);
    }
};
}
extern "C" void kernel_launch(void* const* d_in, const int* in_sizes, int n_in, void* d_out, int out_size, void* d_ws, size_t ws_size, hipStream_t stream) {
    if (n_in != 26 || out_size != T * D || ws_size < ref::bytes_needed(T)) { fprintf(stderr, "kernel_launch: unexpected shapes (n_in %d out %d ws %zu)\n", n_in, out_size, ws_size); return; }
    ref::Fwd f{ref::carve((unsigned char*)d_ws, T), T, stream, d_in};
    const float* x = (const float*)d_in[0];
    f.mixer0(x); f.ln1(x, 0); f.routing(); f.moe_h(0); f.moe_y(0); f.combine(0, f.b.RX2);
    f.mixer1_in(); f.mixer1_gates(); f.mixer1_scan_out(); f.ln1(f.b.RX2, 1); f.routing(); f.moe_h(1); f.moe_y(1); f.combine(1, (float*)d_out);
}
```

```cpp
#define BUILD_MODE 1
#define N_LAUNCHES 1
#include <hip/hip_runtime.h>
#include <cstdio>
#include <cstdint>
#include <cmath>
constexpr int D = 1024, BATCH = 2, SEQ = 8192, T = BATCH * SEQ, DEPTH = 2;
constexpr int DA = 512, DB = 512, DIN0 = 2 * DA + 3 * DB, CONVA = 31, CONVB = 3;
constexpr int DRNN = 1024, RBLK = 256, RHEADS = 4, CONVC = 4;
constexpr int NE = 16, NG = 4, EPG = 4, DEXP = 1024;
constexpr float LN_EPS = 1e-5f, ALPHA = 1.41421356237309515f;
#define LAS __attribute__((address_space(3)))
#define GAS __attribute__((address_space(1)))
typedef unsigned short bf16_t;
typedef short bf16x8 __attribute__((ext_vector_type(8)));
typedef float f32x4 __attribute__((ext_vector_type(4)));
typedef float f32x2 __attribute__((ext_vector_type(2)));
typedef unsigned u32x4 __attribute__((ext_vector_type(4)));
typedef unsigned u32x2 __attribute__((ext_vector_type(2)));
typedef GAS unsigned gu32;
#define RLX_AGENT __ATOMIC_RELAXED, __HIP_MEMORY_SCOPE_AGENT
#define LDS_WAIT() asm volatile("s_waitcnt lgkmcnt(0)" ::: "memory")
#define VM_WAIT() asm volatile("s_waitcnt vmcnt(0)" ::: "memory")

__device__ __forceinline__ unsigned cvt_pk_bf16(float lo, float hi) { unsigned r; asm volatile("v_cvt_pk_bf16_f32 %0, %1, %2" : "=v"(r) : "v"(lo), "v"(hi)); return r; }
__device__ __forceinline__ float bf_lo(unsigned u) { return __uint_as_float(u << 16); }
__device__ __forceinline__ float bf_hi(unsigned u) { return __uint_as_float(u & 0xffff0000u); }
__device__ __forceinline__ float fsigmoid(float x) { return __builtin_amdgcn_rcpf(1.0f + __builtin_amdgcn_exp2f(-1.4426950408889634f * x)); }
__device__ __forceinline__ float fsilu(float x) { return x * fsigmoid(x); }
__device__ __forceinline__ float fgelu_tanh(float x) { return x * fsigmoid(1.5957691216057308f * (x + 0.044715f * x * x * x)); }
__device__ __forceinline__ float wave_sum(float v) {
#pragma unroll
    for (int o = 1; o < 64; o <<= 1) v += __shfl_xor(v, o);
    return v;
}

namespace pg8 {
constexpr int BM = 256, BK = 64, HALF = 128, HTB = HALF * BK * 2, STAGE_BYTES = 8 * HTB, NXCD = 8, WGM = 8;
__host__ __device__ __forceinline__ int lds_byte(int r, int c) { const int st = (r >> 4) * 2 + (c >> 5), rr = r & 15, cc = c & 31, ob = rr * 64 + cc * 2; return st * 1024 + (ob ^ (((ob >> 9) & 1) << 5)); }
__host__ __device__ __forceinline__ void stage_rc(int b, int& R, int& C) { const int st = b / 1024, sb = b % 1024, swz = sb ^ (((sb >> 9) & 1) << 5); R = (st >> 1) * 16 + swz / 64; C = (st & 1) * 32 + (swz % 64) / 2; }
__host__ __device__ __forceinline__ int perm32(int rho) { const int n = rho >> 4, i = rho & 15; return 8 * (i >> 2) + 4 * n + (i & 3); }

struct Unit { const char* A; const char* B; int row0, pn, e, gtab; };
__device__ __forceinline__ bool tile_of(int i, int G, int c, int nM, int nN, int& pm, int& pn) {
    const int nwg = nM * nN; const long L = (long)i * G + c; if (L >= nwg) return false;
    int wgid = (int)L; { const int q = nwg / NXCD, r = nwg % NXCD, xcd = wgid % NXCD, off = wgid / NXCD; wgid = (xcd < r ? xcd * (q + 1) : r * (q + 1) + (xcd - r) * q) + off; }
    const int nig = WGM * nN, gid = wgid / nig, fm = gid * WGM, gsz = (nM - fm) < WGM ? (nM - fm) : WGM;
    pm = fm + ((wgid % nig) % gsz); pn = (wgid % nig) / gsz; return true;
}

template <class Epi, class Sched, bool GATHER>
__device__ __forceinline__ void gemm_phase(LAS unsigned char* lds, const int lda, const int ldb, const int K, const Sched& S, const Epi& E) {
    int tid_ = threadIdx.x; asm volatile("" : "+v"(tid_));
    const int tid = tid_, wid = __builtin_amdgcn_readfirstlane(tid >> 6), lane = tid & 63, wr = wid >> 2, wc = wid & 3, fr = lane & 15, fq = lane >> 4;
    const int nt = K / BK;
    unsigned voffA[2], voffB[2]; int RA[2], CA[2];
#pragma unroll
    for (int i = 0; i < 2; ++i) { int R, C; stage_rc(tid * 16 + i * 8192, R, C); const int Rb = Epi::PERM ? ((R & ~31) + perm32(R & 31)) : R;
        voffA[i] = (unsigned)(R * lda + C) * 2u; voffB[i] = (unsigned)(Rb * ldb + C) * 2u; RA[i] = R; CA[i] = C; }
    const size_t kstep = (size_t)(BK * 2);
    const size_t hstepA = (size_t)HALF * lda * 2, hstepB = (size_t)HALF * ldb * 2;
    const unsigned ldsw = (unsigned)wid * 1024u;
    const int aoff = lds_byte(wr * 64 + fr, fq * 8), boff = lds_byte(wc * 32 + fr, fq * 8);
#define PG8_SA(b, h) (((b) * 2 + (h)) * HTB)
#define PG8_SB(b, h) ((4 + (b) * 2 + (h)) * HTB)
#define PG8_ST2(bufoff, gbase, o0, o1) do { \
        __builtin_amdgcn_global_load_lds((const unsigned*)((const char*)(gbase) + (o0)), (LAS unsigned*)(lds + (bufoff) + ldsw), 16, 0, 0); \
        __builtin_amdgcn_global_load_lds((const unsigned*)((const char*)(gbase) + (o1)), (LAS unsigned*)(lds + (bufoff) + ldsw + 8192), 16, 0, 0); } while (0)
#define PG8_STB(bufoff, gbase, h) PG8_ST2(bufoff, (gbase) + (h) * hstepB, voffB[0], voffB[1])
#define PG8_STA(bufoff, gbase, h, G0, G1) do { if constexpr (GATHER) { PG8_ST2(bufoff, gbase, G0, G1); } else { PG8_ST2(bufoff, (gbase) + (h) * hstepA, voffA[0], voffA[1]); } } while (0)
#define PG8_LDA(dst, b, h) do { _Pragma("unroll") for (int m = 0; m < 4; ++m) _Pragma("unroll") for (int k = 0; k < 2; ++k) dst[m][k] = *(const LAS bf16x8*)(lds + PG8_SA(b, h) + aoff + m * 2048 + k * 1024); } while (0)
#define PG8_LDB(dst, b, h) do { _Pragma("unroll") for (int n = 0; n < 2; ++n) _Pragma("unroll") for (int k = 0; k < 2; ++k) dst[n][k] = *(const LAS bf16x8*)(lds + PG8_SB(b, h) + boff + n * 2048 + k * 1024); } while (0)
#define PG8_MMA(ai, bj, At, Bt) do { __builtin_amdgcn_s_setprio(1); _Pragma("unroll") for (int m = 0; m < 4; ++m) _Pragma("unroll") for (int n = 0; n < 2; ++n) _Pragma("unroll") for (int k = 0; k < 2; ++k) \
        acc[ai][bj][m][n] = __builtin_amdgcn_mfma_f32_16x16x32_bf16(Bt[n][k], At[m][k], acc[ai][bj][m][n], 0, 0, 0); __builtin_amdgcn_s_setprio(0); } while (0)
#define PG8_WAIT_V(n) asm volatile("s_waitcnt vmcnt(" #n ")" ::: "memory")
#define PG8_WAIT_L(n) asm volatile("s_waitcnt lgkmcnt(" #n ")" ::: "memory")
#define PG8_BAR __builtin_amdgcn_s_barrier()
#define PG8_SCHED __builtin_amdgcn_sched_barrier(0)
    Unit cur, nxt; int ui = 0;
    if (!S.next(0, cur)) return;
    f32x4 acc[2][2][4][2];
#pragma unroll
    for (int a = 0; a < 2; ++a)
#pragma unroll
        for (int b = 0; b < 2; ++b)
#pragma unroll
            for (int m = 0; m < 4; ++m)
#pragma unroll
                for (int n = 0; n < 2; ++n) acc[a][b][m][n] = (f32x4){0.f, 0.f, 0.f, 0.f};
    bf16x8 At[4][2], B0[2][2], B1[2][2];
    unsigned gc[2][2] = {{0u, 0u}, {0u, 0u}}, gn[2][2] = {{0u, 0u}, {0u, 0u}};
    if constexpr (GATHER) {
#pragma unroll
        for (int h = 0; h < 2; ++h)
#pragma unroll
            for (int i = 0; i < 2; ++i) gc[h][i] = *(const LAS unsigned*)(lds + cur.gtab + (h * HALF + RA[i]) * 4) + (unsigned)CA[i] * 2u;
    }
    const char* cA = cur.A; const char* cB = cur.B;
    PG8_STB(PG8_SB(0, 0), cB, 0); PG8_STB(PG8_SB(0, 1), cB, 1); PG8_STA(PG8_SA(0, 0), cA, 0, gc[0][0], gc[0][1]); PG8_STA(PG8_SA(0, 1), cA, 1, gc[1][0], gc[1][1]);
    if (wr == 1) PG8_BAR;
    PG8_WAIT_V(2); PG8_BAR;
    PG8_STB(PG8_SB(1, 0), cB + kstep, 0); PG8_STA(PG8_SA(1, 0), cA + kstep, 0, gc[0][0], gc[0][1]); PG8_STB(PG8_SB(1, 1), cB + kstep, 1);
    PG8_WAIT_V(6); PG8_BAR;
    for (;;) {
        const bool has_next = S.next(ui + 1, nxt);
        const char* nA = has_next ? nxt.A : cA; const char* nB = has_next ? nxt.B : cB;
        if constexpr (GATHER) {
#pragma unroll
            for (int h = 0; h < 2; ++h)
#pragma unroll
                for (int i = 0; i < 2; ++i) gn[h][i] = has_next ? (*(const LAS unsigned*)(lds + nxt.gtab + (h * HALF + RA[i]) * 4) + (unsigned)CA[i] * 2u) : gc[h][i];
        }
#pragma unroll 1
        for (int t = 0; t < nt; t += 2) {
            const bool last = (t == nt - 2);
            const char* a1 = cA + (size_t)(t + 1) * kstep;
            const char* a2 = last ? nA : cA + (size_t)(t + 2) * kstep; const char* b2 = last ? nB : cB + (size_t)(t + 2) * kstep;
            const char* a3 = a2 + kstep; const char* b3 = b2 + kstep;
            const unsigned g00 = last ? gn[0][0] : gc[0][0], g01 = last ? gn[0][1] : gc[0][1], g10 = last ? gn[1][0] : gc[1][0], g11 = last ? gn[1][1] : gc[1][1];
            PG8_LDB(B0, 0, 0); PG8_LDB(B1, 0, 1); PG8_SCHED; PG8_LDA(At, 0, 0); PG8_STA(PG8_SA(1, 1), a1, 1, gc[1][0], gc[1][1]);
            PG8_WAIT_V(8); PG8_WAIT_L(0); PG8_BAR; PG8_MMA(0, 0, At, B0); PG8_MMA(0, 1, At, B1); PG8_BAR; PG8_SCHED;
            PG8_LDA(At, 0, 1); PG8_STB(PG8_SB(0, 0), b2, 0); PG8_STB(PG8_SB(0, 1), b2, 1); PG8_STA(PG8_SA(0, 0), a2, 0, g00, g01);
            PG8_WAIT_V(8); PG8_WAIT_L(0); PG8_BAR; PG8_MMA(1, 0, At, B0); PG8_MMA(1, 1, At, B1); PG8_BAR; PG8_SCHED;
            PG8_LDB(B0, 1, 0); PG8_LDB(B1, 1, 1); PG8_SCHED; PG8_LDA(At, 1, 0); PG8_STA(PG8_SA(0, 1), a2, 1, g10, g11);
            PG8_WAIT_V(8); PG8_WAIT_L(0); PG8_BAR; PG8_MMA(0, 0, At, B0); PG8_MMA(0, 1, At, B1); PG8_BAR; PG8_SCHED;
            PG8_LDA(At, 1, 1); PG8_STB(PG8_SB(1, 0), b3, 0); PG8_STB(PG8_SB(1, 1), b3, 1); PG8_STA(PG8_SA(1, 0), a3, 0, g00, g01);
            PG8_WAIT_V(8); PG8_WAIT_L(0); PG8_BAR; PG8_MMA(1, 0, At, B0); PG8_MMA(1, 1, At, B1); PG8_BAR; PG8_SCHED;
        }
        if (wr == 0) PG8_BAR;
        E(acc, cur, wr, wc, fr, fq);
        if (!has_next) break;
#pragma unroll
        for (int a = 0; a < 2; ++a)
#pragma unroll
            for (int b = 0; b < 2; ++b)
#pragma unroll
                for (int m = 0; m < 4; ++m)
#pragma unroll
                    for (int n = 0; n < 2; ++n) acc[a][b][m][n] = (f32x4){0.f, 0.f, 0.f, 0.f};
        cur = nxt; cA = nA; cB = nB; ++ui;
        if constexpr (GATHER) {
#pragma unroll
            for (int h = 0; h < 2; ++h)
#pragma unroll
                for (int i = 0; i < 2; ++i) gc[h][i] = gn[h][i];
        }
        if (wr == 1) PG8_BAR;
    }
    PG8_WAIT_V(0);
    PG8_BAR;
#undef PG8_SA
#undef PG8_SB
#undef PG8_ST2
#undef PG8_STB
#undef PG8_STA
#undef PG8_LDA
#undef PG8_LDB
#undef PG8_MMA
#undef PG8_WAIT_V
#undef PG8_WAIT_L
#undef PG8_BAR
#undef PG8_SCHED
}

typedef f32x4 AccT[2][2][4][2];
__device__ __forceinline__ u32x4 pack8(const f32x4 a, const f32x4 b) { u32x4 w; w.x = cvt_pk_bf16(a[0], a[1]); w.y = cvt_pk_bf16(a[2], a[3]); w.z = cvt_pk_bf16(b[0], b[1]); w.w = cvt_pk_bf16(b[2], b[3]); return w; }
template <int ACT> __device__ __forceinline__ void store_plain(const AccT& acc, bf16_t* O, int ldo, int row0, int col0, int wr, int wc, int fr, int fq) {
#pragma unroll
    for (int ai = 0; ai < 2; ++ai)
#pragma unroll
        for (int m = 0; m < 4; ++m) { bf16_t* rowp = O + (size_t)(row0 + ai * HALF + wr * 64 + m * 16 + fr) * ldo + col0 + wc * 32 + 8 * fq;
#pragma unroll
            for (int bj = 0; bj < 2; ++bj) { f32x4 v0 = acc[ai][bj][m][0], v1 = acc[ai][bj][m][1];
                if (ACT == 1) {
#pragma unroll
                    for (int j = 0; j < 4; ++j) { v0[j] = fgelu_tanh(v0[j]); v1[j] = fgelu_tanh(v1[j]); } }
                *(u32x4*)(rowp + bj * HALF) = pack8(v0, v1); } }
}
template <int MODE> __device__ __forceinline__ void store_pair(const AccT& acc, bf16_t* O, int ldo, int row0, int col0, int wr, int wc, int fr, int fq) {
#pragma unroll
    for (int ai = 0; ai < 2; ++ai)
#pragma unroll
        for (int m = 0; m < 4; ++m) { bf16_t* rowp = O + (size_t)(row0 + ai * HALF + wr * 64 + m * 16 + fr) * ldo + col0 + wc * 32 + 8 * fq;
            f32x4 o[2];
#pragma unroll
            for (int n = 0; n < 2; ++n) { const f32x4 v = acc[ai][0][m][n], g = acc[ai][1][m][n];
#pragma unroll
                for (int j = 0; j < 4; ++j) o[n][j] = MODE == 0 ? v[j] * fsigmoid(g[j]) : (MODE == 1 ? v[j] * g[j] : fsilu(v[j]) * g[j]); }
            *(u32x4*)rowp = pack8(o[0], o[1]); }
}
struct EpiIn0 {
    static constexpr bool PERM = true; bf16_t* U0;
    __device__ __forceinline__ void operator()(const AccT& acc, const Unit& u, int wr, int wc, int fr, int fq) const {
        if (u.pn < 4) store_pair<0>(acc, U0, 1536, u.row0, 128 * u.pn, wr, wc, fr, fq);
        else if (u.pn < 8) store_pair<1>(acc, U0, 1536, u.row0, 512 + 128 * (u.pn - 4), wr, wc, fr, fq);
        else store_plain<0>(acc, U0, 1536, u.row0, 1024 + 256 * (u.pn - 8), wr, wc, fr, fq);
    }
};
struct EpiIn1 {
    static constexpr bool PERM = true; bf16_t* GY; bf16_t* XR;
    __device__ __forceinline__ void operator()(const AccT& acc, const Unit& u, int wr, int wc, int fr, int fq) const {
        if (u.pn < 4) store_plain<1>(acc, GY, D, u.row0, 256 * u.pn, wr, wc, fr, fq);
        else store_plain<0>(acc, XR, D, u.row0, 256 * (u.pn - 4), wr, wc, fr, fq);
    }
};
struct EpiMoe1 { static constexpr bool PERM = true; bf16_t* H;
    __device__ __forceinline__ void operator()(const AccT& acc, const Unit& u, int wr, int wc, int fr, int fq) const { store_pair<2>(acc, H, DEXP, u.row0, 128 * u.pn, wr, wc, fr, fq); } };
struct EpiMoe2 { static constexpr bool PERM = true; bf16_t* Y;
    __device__ __forceinline__ void operator()(const AccT& acc, const Unit& u, int wr, int wc, int fr, int fq) const { store_plain<0>(acc, Y, D, u.row0, 256 * u.pn, wr, wc, fr, fq); } };
template <bool RESBF> struct EpiRes { static constexpr bool PERM = false; const void* res; float* Y;
    __device__ __forceinline__ void operator()(const AccT& acc, const Unit& u, int wr, int wc, int fr, int fq) const {
#pragma unroll
        for (int ai = 0; ai < 2; ++ai)
#pragma unroll
            for (int m = 0; m < 4; ++m) { const size_t off = (size_t)(u.row0 + ai * HALF + wr * 64 + m * 16 + fr) * D + u.pn * 256 + wc * 32 + 4 * fq;
#pragma unroll
                for (int bj = 0; bj < 2; ++bj)
#pragma unroll
                    for (int n = 0; n < 2; ++n) { const size_t o = off + bj * HALF + n * 16; f32x4 r;
                        if (RESBF) { const u32x2 w = *(const u32x2*)((const bf16_t*)res + o); r = (f32x4){bf_lo(w.x), bf_hi(w.x), bf_lo(w.y), bf_hi(w.y)}; }
                        else r = *(const f32x4*)((const float*)res + o);
                        *(f32x4*)(Y + o) = r * ALPHA + acc[ai][bj][m][n]; } }
    }
};
struct EpiGates { static constexpr bool PERM = true; const bf16_t* XC; const float* ba; const float* bx; const float* spl; bf16_t* L2A; bf16_t* BV;
    __device__ __forceinline__ void operator()(const AccT& acc, const Unit& u, int wr, int wc, int fr, int fq) const {
        const int col = 128 * u.pn + wc * 32 + 8 * fq;
#pragma unroll
        for (int ai = 0; ai < 2; ++ai)
#pragma unroll
            for (int m = 0; m < 4; ++m) { const size_t o = (size_t)(u.row0 + ai * HALF + wr * 64 + m * 16 + fr) * DRNN + col;
                const u32x4 xw = *(const u32x4*)(XC + o); const float xv[8] = {bf_lo(xw.x), bf_hi(xw.x), bf_lo(xw.y), bf_hi(xw.y), bf_lo(xw.z), bf_hi(xw.z), bf_lo(xw.w), bf_hi(xw.w)};
                f32x4 la2[2], bo[2];
#pragma unroll
                for (int n = 0; n < 2; ++n) { const f32x4 cba = *(const f32x4*)(ba + col + 4 * n), cbx = *(const f32x4*)(bx + col + 4 * n), csp = *(const f32x4*)(spl + col + 4 * n);
#pragma unroll
                    for (int j = 0; j < 4; ++j) { const float r = fsigmoid(acc[ai][0][m][n][j] + cba[j]), ig = fsigmoid(acc[ai][1][m][n][j] + cbx[j]);
                        const float l2 = -1.4426950408889634f * csp[j] * r;
                        const float a = __builtin_amdgcn_exp2f(l2); la2[n][j] = l2; bo[n][j] = __builtin_sqrtf(fmaxf(1.0f - a * a, 0.f)) * (ig * xv[4 * n + j]); } }
                *(u32x4*)(L2A + o) = pack8(la2[0], la2[1]); *(u32x4*)(BV + o) = pack8(bo[0], bo[1]);
                asm volatile("" ::: "memory"); }
    }
};
}

constexpr size_t MiB = 1u << 20;
constexpr size_t WS_CTL = 0, CTL_ZERO_BYTES = 65536;
constexpr size_t WS_WIN0 = 2 * MiB, WS_WOUT0 = 7 * MiB, WS_WIN1 = 9 * MiB, WS_WGT = 13 * MiB, WS_WOUT1 = 14 * MiB, WS_W13 = 16 * MiB, WS_W2 = 144 * MiB, WS_SPL = 208 * MiB;
constexpr size_t WS_X1 = 212 * MiB, WS_X2 = 244 * MiB;
constexpr size_t WS_R = 276 * MiB;
constexpr size_t WS_U0 = WS_R, WS_CAT0 = WS_R + 48 * MiB, WS_YPRE0 = WS_R + 80 * MiB;
constexpr size_t WS_GY = WS_R, WS_XR = WS_R + 32 * MiB, WS_XC = WS_R + 64 * MiB, WS_BV = WS_R + 96 * MiB, WS_YPRE1 = WS_R + 64 * MiB;
constexpr size_t WS_H = WS_R, WS_Y = WS_R + 72 * MiB;
constexpr size_t WS_LIST = 420 * MiB, WS_TOKSLOT = 421 * MiB, WS_TOKGATE = WS_TOKSLOT + 256 * 1024, WS_AGG = 422 * MiB, WS_FAST_END = 424 * MiB;
constexpr int NPAD_ROWS = 2 * T + NE * 256;
static_assert(WS_H + (size_t)NPAD_ROWS * DEXP * 2 <= WS_Y && WS_Y + (size_t)NPAD_ROWS * D * 2 <= WS_LIST, "H / Y fit");
constexpr int CW_TMO = 0, CW_CODE = 1, CW_GCOUNT = 256  , CW_BAR = 4096;
constexpr int RING_BYTES = 131072, LDSCTL_OFF = RING_BYTES, MISC_OFF = LDSCTL_OFF + 320, UNITS_OFF = LDSCTL_OFF + 512, MOEMETA_OFF = LDSCTL_OFF + 768, GTAB_OFF = LDSCTL_OFF + 1024, MAX_UNITS = 8;
constexpr int LDS_BYTES = 147456;
static_assert(GTAB_OFF + MAX_UNITS * 1024 <= LDS_BYTES, "LDS map");
constexpr int NWAVES = 8, NTHREADS = 512;

#define XB_TMO      128
#define XB_XCNT(j)  (256  + 64 * (j))
#define XB_XSUB(j)  (1280 + 64 * (j))
#define XB_XGEN(j)  (2304 + 64 * (j))
#define XB_TOP      3328
#define XB_TOPGEN   3392
#define XCD_BAR_WORDS 3456
#define XB_SPIN_CAP (1u << 18)
__device__ __forceinline__ unsigned xb_ld(unsigned* p)              { return __hip_atomic_load(p, __ATOMIC_RELAXED, __HIP_MEMORY_SCOPE_AGENT); }
__device__ __forceinline__ unsigned xb_add(unsigned* p, unsigned v) { return __hip_atomic_fetch_add(p, v, __ATOMIC_RELAXED, __HIP_MEMORY_SCOPE_AGENT); }
__device__ __forceinline__ unsigned xb_xcc_id() { return (unsigned)__builtin_amdgcn_s_getreg((3 << 11) | 20) & 0xFu; }
#define XB_SPIN(cond, bar) do { unsigned _sp = 0; while (cond) { __builtin_amdgcn_s_sleep(1); \
    if ((++_sp & 255u) == 0u) { if (xb_ld(&(bar)[XB_TMO])) break; if (_sp > XB_SPIN_CAP) { atomicAdd(&(bar)[XB_TMO], 1u); break; } } } } while (0)
struct XcdBarrier { unsigned* bar; unsigned x; volatile LAS unsigned* st; };
__device__ __forceinline__ XcdBarrier xcd_barrier_post(unsigned* bar, volatile LAS unsigned* st) {
    XcdBarrier b; b.bar = bar; b.x = xb_xcc_id(); b.st = st;
    if (threadIdx.x == 0) (void)xb_add(&bar[XB_XCNT(b.x)], 1u);
    return b;
}
__device__ __forceinline__ void xcd_barrier_complete(unsigned* bar, unsigned x, unsigned& nloc, unsigned& nx) {
    const unsigned G = gridDim.x * gridDim.y * gridDim.z;
    unsigned sum, cnt, mine, sp = 0u;
    for (;;) {
        sum = 0u; cnt = 0u; mine = 0u;
#pragma unroll
        for (unsigned j = 0; j < 16; ++j) { const unsigned c = xb_ld(&bar[XB_XCNT(j)]); sum += c; cnt += (c > 0u) ? 1u : 0u; mine = (j == x) ? c : mine; }
        if (sum == G) break;
        __builtin_amdgcn_s_sleep(1);
        if ((++sp & 255u) == 0u) { if (xb_ld(&bar[XB_TMO])) break; if (sp > XB_SPIN_CAP) { atomicAdd(&bar[XB_TMO], 1u); break; } }
    }
    nloc = mine > 0u ? mine : 1u; nx = cnt > 0u ? cnt : 1u;
}
__device__ __forceinline__ void xcd_barrier(const XcdBarrier& b) {
    asm volatile("s_waitcnt vmcnt(0)" ::: "memory");
    __syncthreads();
    if (threadIdx.x == 0) {
        unsigned* bar = b.bar;
        __builtin_amdgcn_s_waitcnt(0);
        unsigned nloc = b.st[0], nx = b.st[1];
        if (nloc == 0u) { xcd_barrier_complete(bar, b.x, nloc, nx); b.st[0] = nloc; b.st[1] = nx; }
        const unsigned old = xb_add(&bar[XB_XSUB(b.x)], 1u);
        const unsigned gen = old / nloc;
        if (old + 1u == (gen + 1u) * nloc) {
            __builtin_amdgcn_fence(__ATOMIC_RELEASE, "agent");
            asm volatile("s_waitcnt vmcnt(0)" ::: "memory");
            const unsigned og = xb_add(&bar[XB_TOP], 1u);
            const unsigned tg = og / nx;
            if (og + 1u == (tg + 1u) * nx) xb_add(&bar[XB_TOPGEN], 1u);
            else XB_SPIN(xb_ld(&bar[XB_TOPGEN]) == tg, bar);
            __builtin_amdgcn_fence(__ATOMIC_ACQUIRE, "agent");
            xb_add(&bar[XB_XGEN(b.x)], 1u);
            asm volatile("s_waitcnt vmcnt(0)" ::: "memory");
        } else {
            XB_SPIN(xb_ld(&bar[XB_XGEN(b.x)]) == gen, bar);
            __builtin_amdgcn_fence(__ATOMIC_ACQUIRE, "agent");
            asm volatile("s_waitcnt vmcnt(0)" ::: "memory");
        }
    }
    __syncthreads();
}

struct Args { const float* in[26]; float* out; unsigned char* ws; int ph_lo, ph_hi; };
struct Frame {
    LAS unsigned char* lds; unsigned char* ws; const float* const* in; float* out;
    int tid, lane, wave, vcu, G;
    template <class Tp> __device__ __forceinline__ Tp* W(size_t off) const { return (Tp*)(ws + off); }
    __device__ __forceinline__ const float* I(int i) const { return in[i]; }
    __device__ __forceinline__ unsigned* ctl() const { return (unsigned*)(ws + WS_CTL); }
    __device__ __forceinline__ void retid() { int t = threadIdx.x; asm volatile("" : "+v"(t)); tid = t; lane = t & 63; }
};

__device__ __forceinline__ void cvt_item(const float* src, int ldsrc, int k0, int c0, bf16_t* dst, int lddst, int drow0, LAS unsigned* scr, int lane) {
    const int cg = lane & 15, rp = lane >> 4;
    const float* sp = src + (size_t)k0 * ldsrc + c0 + 4 * cg;
    f32x4 v[16];
#pragma unroll
    for (int j = 0; j < 8; ++j) { const int r = 2 * (rp + 4 * j); v[2 * j] = *(const f32x4*)(sp + (size_t)r * ldsrc); v[2 * j + 1] = *(const f32x4*)(sp + (size_t)(r + 1) * ldsrc); }
#pragma unroll
    for (int j = 0; j < 8; ++j) { const int kd = rp + 4 * j;
#pragma unroll
        for (int i = 0; i < 4; ++i) scr[(4 * cg + i) * 33 + kd] = cvt_pk_bf16(v[2 * j][i], v[2 * j + 1][i]); }
    LDS_WAIT();
    const int kc = lane & 7;
#pragma unroll
    for (int jj = 0; jj < 8; ++jj) { const int n = (lane >> 3) + 8 * jj; const LAS unsigned* s = scr + n * 33 + 4 * kc;
        u32x4 o; o.x = s[0]; o.y = s[1]; o.z = s[2]; o.w = s[3];
        *(u32x4*)(dst + (size_t)(drow0 + n) * lddst + k0 + 8 * kc) = o; }
    LDS_WAIT();
}
__device__ __forceinline__ void p0_prologue(Frame& F) {
    F.retid();
    LAS unsigned* scr = (LAS unsigned*)(F.lds + F.wave * 8448);
    const int gw = F.vcu * NWAVES + F.wave, NGW = F.G * NWAVES;
    constexpr int I_IN0 = 16 * 40, I_OUT0 = 16 * 16, I_IN1 = 16 * 32, I_GT = 4 * 4 * 8, I_OUT1 = 16 * 16, I_W13 = 32 * 16 * 32, I_W2 = 32 * 16 * 16;
    constexpr int NITEMS = I_IN0 + I_OUT0 + I_IN1 + I_GT + I_OUT1 + I_W13 + I_W2;
    for (int it = gw; it < NITEMS; it += NGW) {
        int r = it;
        if (r < I_IN0) { const int kb = r / 40, db = r % 40, p = db >> 2, q = db & 3; int sc;
            if (p < 4) sc = (q < 2) ? 128 * p + 64 * q : 512 + 128 * p + 64 * (q - 2);
            else if (p < 8) sc = (q < 2) ? 1536 + 128 * (p - 4) + 64 * q : 2048 + 128 * (p - 4) + 64 * (q - 2);
            else sc = 1024 + 256 * (p - 8) + 64 * q;
            cvt_item(F.I(5), DIN0, 64 * kb, sc, F.W<bf16_t>(WS_WIN0), D, 64 * db, scr, F.lane); continue; } r -= I_IN0;
        if (r < I_OUT0) { const int kb = r / 16, db = r % 16; cvt_item(F.I(11), D, 64 * kb, 64 * db, F.W<bf16_t>(WS_WOUT0), D, 64 * db, scr, F.lane); continue; } r -= I_OUT0;
        if (r < I_IN1) { const int kb = r / 32, db = r % 32; cvt_item(F.I(12), 2 * DRNN, 64 * kb, 64 * db, F.W<bf16_t>(WS_WIN1), D, 64 * db, scr, F.lane); continue; } r -= I_IN1;
        if (r < I_GT) { const int h = r / 32, r2 = r % 32, kb = r2 / 8, db = r2 % 8, p = db >> 2, q = db & 3;
            const float* src = (q < 2 ? F.I(15) : F.I(17)) + (size_t)h * RBLK * RBLK; const int sc = 128 * p + 64 * (q & 1);
            cvt_item(src, RBLK, 64 * kb, sc, F.W<bf16_t>(WS_WGT) + (size_t)h * 512 * RBLK, RBLK, 64 * db, scr, F.lane); continue; } r -= I_GT;
        if (r < I_OUT1) { const int kb = r / 16, db = r % 16; cvt_item(F.I(20), D, 64 * kb, 64 * db, F.W<bf16_t>(WS_WOUT1), DRNN, 64 * db, scr, F.lane); continue; } r -= I_OUT1;
        if (r < I_W13) { const int le = r / 512, r2 = r % 512, kb = r2 / 32, db = r2 % 32, p = db >> 2, q = db & 3;
            const float* src = (q < 2 ? F.I(23) : F.I(24)) + (size_t)le * D * DEXP; const int sc = 128 * p + 64 * (q & 1);
            cvt_item(src, DEXP, 64 * kb, sc, F.W<bf16_t>(WS_W13) + (size_t)le * 2 * DEXP * D, D, 64 * db, scr, F.lane); continue; } r -= I_W13;
        { const int le = r / 256, r2 = r % 256, kb = r2 / 16, db = r2 % 16;
            cvt_item(F.I(25) + (size_t)le * DEXP * D, D, 64 * kb, 64 * db, F.W<bf16_t>(WS_W2) + (size_t)le * D * DEXP, DEXP, 64 * db, scr, F.lane); }
    }
    { const float* x = F.I(0); bf16_t* xb = F.W<bf16_t>(WS_X2); const size_t n8 = (size_t)T * D / 8, stride = (size_t)F.G * NTHREADS;
      for (size_t i = (size_t)F.vcu * NTHREADS + F.tid; i < n8; i += stride) { const f32x4 a = *(const f32x4*)(x + i * 8), b = *(const f32x4*)(x + i * 8 + 4); *(u32x4*)(xb + i * 8) = pg8::pack8(a, b); } }
    { const int i = F.vcu * NTHREADS + F.tid; if (i < DRNN) F.W<float>(WS_SPL)[i] = 8.0f * log1pf(expf(-F.I(19)[i])); }
}

struct DenseOrder {
    const char* A; const char* B; size_t a_tile, b_tile; int nM, nN, G, c;
    __device__ __forceinline__ bool next(int i, pg8::Unit& u) const { int pm, pn; if (!pg8::tile_of(i, G, c, nM, nN, pm, pn)) return false;
        u.A = A + (size_t)pm * a_tile; u.B = B + (size_t)pn * b_tile; u.row0 = pm * 256; u.pn = pn; u.e = 0; u.gtab = 0; return true; }
};
struct GatesOrder {
    const char* XC; const char* WG; int G, c;
    __device__ __forceinline__ bool next(int i, pg8::Unit& u) const { int pm, pn; if (!pg8::tile_of(i, G, c, T / 256, 2 * RHEADS, pm, pn)) return false;
        u.A = XC + (size_t)pm * 256 * DRNN * 2 + (size_t)(pn >> 1) * RBLK * 2; u.B = WG + (size_t)pn * 256 * RBLK * 2; u.row0 = pm * 256; u.pn = pn; u.e = 0; u.gtab = 0; return true; }
};
struct MoeOrder { LAS const int* units; int nu; const char* A; const char* B; size_t b_exp, b_tile; bool gather;
    __device__ __forceinline__ bool next(int i, pg8::Unit& u) const { if (i >= nu) return false;
        const int e = __builtin_amdgcn_readfirstlane(units[4 * i]), pm = __builtin_amdgcn_readfirstlane(units[4 * i + 1]), pn = __builtin_amdgcn_readfirstlane(units[4 * i + 2]);
        u.A = gather ? A : A + (size_t)pm * 256 * DEXP * 2; u.B = B + (size_t)e * b_exp + (size_t)pn * b_tile; u.row0 = pm * 256; u.pn = pn; u.e = e; u.gtab = GTAB_OFF + i * 1024; return true; }
};
__device__ __forceinline__ int moe_setup(Frame& F, int layer, int nN, bool gather) {
    F.retid();
    LAS int* meta = (LAS int*)(F.lds + MOEMETA_OFF); LAS int* units = (LAS int*)(F.lds + UNITS_OFF); LAS unsigned* gtab = (LAS unsigned*)(F.lds + GTAB_OFF);
    const unsigned* gcount = F.ctl() + CW_GCOUNT + 32 * layer;
    if (F.tid < NE) meta[17 + F.tid] = (int)__hip_atomic_load(gcount + F.tid, RLX_AGENT);
    __syncthreads();
    if (F.tid == 0) { int acc = 0; for (int e = 0; e < NE; ++e) { meta[e] = acc; acc += (meta[17 + e] + 255) >> 8; } meta[NE] = acc; }
    __syncthreads();
    const int nM = meta[NE]; int nu = 0;
    for (int i = 0; i < MAX_UNITS; ++i) { int pm, pn; if (!pg8::tile_of(i, F.G, (int)blockIdx.x, nM, nN, pm, pn)) break;
        int e = 0;
#pragma unroll
        for (int j = 1; j < NE; ++j) e += (meta[j] <= pm) ? 1 : 0;
        if (F.tid == 0) { units[4 * i] = e; units[4 * i + 1] = pm; units[4 * i + 2] = pn; units[4 * i + 3] = 0; }
        if (gather && F.tid < 256) { const int idx = (pm - meta[e]) * 256 + F.tid; const int cnt = meta[17 + e];
            const int tok = idx < cnt ? F.W<int>(WS_LIST)[e * T + idx] : 0; gtab[i * 256 + F.tid] = (unsigned)tok * (unsigned)(D * 2); }
        nu = i + 1; }
    __syncthreads();
    return nu;
}

__device__ __forceinline__ void p_mix0(Frame& F) {
    F.retid();
    LAS float* wA = (LAS float*)F.lds;
    LAS float* wB = wA + CONVA * DA;
    LAS float* pb = wB + CONVB * DB;
    for (int i = F.tid; i < CONVA * DA; i += NTHREADS) wA[i] = F.I(6)[i];
    for (int i = F.tid; i < CONVB * DB; i += NTHREADS) wB[i] = F.I(10)[i];
    for (int i = F.tid; i < DA; i += NTHREADS) { pb[i] = F.I(7)[i]; pb[DA + i] = F.I(8)[i]; pb[2 * DA + i] = F.I(9)[i]; }
    __syncthreads();
    const bf16_t* U0 = F.W<bf16_t>(WS_U0); bf16_t* CAT = F.W<bf16_t>(WS_CAT0);
    const int c0 = 8 * F.lane;
    for (int tb = F.vcu * NWAVES + F.wave; tb < T / 8; tb += F.G * NWAVES) {
        for (int i = 0; i < 8; ++i) { const int t = tb * 8 + i, s = t & (SEQ - 1);
            float acc[8];
#pragma unroll
            for (int j = 0; j < 8; ++j) acc[j] = pb[c0 + j];
#pragma unroll 1
            for (int kc = 0; kc < 4; ++kc) {
#pragma unroll
                for (int kk = 0; kk < 8; ++kk) { const int k = kc * 8 + kk, kq = k < CONVA ? k : CONVA - 1; const int d = CONVA - 1 - kq; const bool ok = (k < CONVA) && (s >= d); const size_t rr = ok ? (size_t)(t - d) : (size_t)t;
                    const u32x4 w = *(const u32x4*)(U0 + rr * 1536 + c0); const f32x4 w0 = *(const LAS f32x4*)(wA + kq * DA + c0), w1 = *(const LAS f32x4*)(wA + kq * DA + c0 + 4);
                    const float m = ok ? 1.f : 0.f;
                    acc[0] += m * w0[0] * bf_lo(w.x); acc[1] += m * w0[1] * bf_hi(w.x); acc[2] += m * w0[2] * bf_lo(w.y); acc[3] += m * w0[3] * bf_hi(w.y);
                    acc[4] += m * w1[0] * bf_lo(w.z); acc[5] += m * w1[1] * bf_hi(w.z); acc[6] += m * w1[2] * bf_lo(w.w); acc[7] += m * w1[3] * bf_hi(w.w); }
            }
            float sm = 0.f;
#pragma unroll
            for (int j = 0; j < 8; ++j) sm += acc[j];
            const float mean = wave_sum(sm) * (1.0f / DA); float q = 0.f;
#pragma unroll
            for (int j = 0; j < 8; ++j) { acc[j] -= mean; q += acc[j] * acc[j]; }
            const float rstd = 1.0f / sqrtf(wave_sum(q) * (1.0f / DA) + LN_EPS);
            f32x4 o0, o1;
#pragma unroll
            for (int j = 0; j < 4; ++j) { o0[j] = fsilu(acc[j] * rstd * pb[DA + c0 + j] + pb[2 * DA + c0 + j]); o1[j] = fsilu(acc[4 + j] * rstd * pb[DA + c0 + 4 + j] + pb[2 * DA + c0 + 4 + j]); }
            *(u32x4*)(CAT + (size_t)t * D + c0) = pg8::pack8(o0, o1);
            float cb[8];
#pragma unroll
            for (int j = 0; j < 8; ++j) cb[j] = 0.f;
#pragma unroll
            for (int k = 0; k < CONVB; ++k) { const int d = CONVB - 1 - k; const bool ok = s >= d; const size_t rr = ok ? (size_t)(t - d) : (size_t)t;
                const u32x4 w = *(const u32x4*)(U0 + rr * 1536 + 512 + c0); const f32x4 w0 = *(const LAS f32x4*)(wB + k * DB + c0), w1 = *(const LAS f32x4*)(wB + k * DB + c0 + 4);
                const float m = ok ? 1.f : 0.f;
                cb[0] += m * w0[0] * bf_lo(w.x); cb[1] += m * w0[1] * bf_hi(w.x); cb[2] += m * w0[2] * bf_lo(w.y); cb[3] += m * w0[3] * bf_hi(w.y);
                cb[4] += m * w1[0] * bf_lo(w.z); cb[5] += m * w1[1] * bf_hi(w.z); cb[6] += m * w1[2] * bf_lo(w.w); cb[7] += m * w1[3] * bf_hi(w.w); }
            const u32x4 bw = *(const u32x4*)(U0 + (size_t)t * 1536 + 1024 + c0);
            const f32x4 p0 = {bf_lo(bw.x) * cb[0], bf_hi(bw.x) * cb[1], bf_lo(bw.y) * cb[2], bf_hi(bw.y) * cb[3]}, p1 = {bf_lo(bw.z) * cb[4], bf_hi(bw.z) * cb[5], bf_lo(bw.w) * cb[6], bf_hi(bw.w) * cb[7]};
            *(u32x4*)(CAT + (size_t)t * D + 512 + c0) = pg8::pack8(p0, p1);
        }
    }
    __syncthreads();
}

__device__ __forceinline__ void route16(const float (&l)[NE], int& e1, int& e2, float& g1, float& g2) {
    float mx = l[0];
#pragma unroll
    for (int e = 1; e < NE; ++e) mx = fmaxf(mx, l[e]);
    float p[NE];
#pragma unroll
    for (int e = 0; e < NE; ++e) p[e] = __expf(l[e] - mx);
    int gsel = 0; float best = -1.f, bq0 = 0.f, bq1 = 0.f, bq2 = 0.f, bq3 = 0.f;
#pragma unroll
    for (int g = 0; g < NG; ++g) { float m1 = -1.f, m2 = -1.f;
#pragma unroll
        for (int j = 0; j < EPG; ++j) { const float v = p[g * EPG + j]; if (v > m1) { m2 = m1; m1 = v; } else if (v > m2) m2 = v; }
        const float sc = m1 + m2; if (sc > best) { best = sc; gsel = g; bq0 = p[g * EPG]; bq1 = p[g * EPG + 1]; bq2 = p[g * EPG + 2]; bq3 = p[g * EPG + 3]; } }
    int i1 = 0; float p1 = bq0;
    if (bq1 > p1) { p1 = bq1; i1 = 1; } if (bq2 > p1) { p1 = bq2; i1 = 2; } if (bq3 > p1) { p1 = bq3; i1 = 3; }
    int i2 = -1; float p2 = -1.f;
    if (i1 != 0 && bq0 > p2) { p2 = bq0; i2 = 0; } if (i1 != 1 && bq1 > p2) { p2 = bq1; i2 = 1; } if (i1 != 2 && bq2 > p2) { p2 = bq2; i2 = 2; } if (i1 != 3 && bq3 > p2) { p2 = bq3; i2 = 3; }
    e1 = gsel * EPG + i1; e2 = gsel * EPG + i2; const float inv = 1.0f / (p1 + p2); g1 = p1 * inv; g2 = p2 * inv;
}
__device__ __forceinline__ void p_ln1_route(Frame& F, int layer, const float* YPRE) {
    F.retid();
    LAS float* wrT = (LAS float*)F.lds;
    LAS int* rt = (LAS int*)(F.lds + 65536);
    LAS int* re = rt; LAS int* rlp = rt + 128; LAS float* rg = (LAS float*)(rt + 256); LAS int* lcount = rt + 384; LAS int* gbase = rt + 400;
    { const float* wr = F.I(21);
      for (int idx = F.tid; idx < D * NE / 4; idx += NTHREADS) { const f32x4 v = *(const f32x4*)(wr + idx * 4); const int c = idx >> 2, e4 = (idx & 3) * 4;
          wrT[(e4 + 0) * D + c] = v[0]; wrT[(e4 + 1) * D + c] = v[1]; wrT[(e4 + 2) * D + c] = v[2]; wrT[(e4 + 3) * D + c] = v[3]; } }
    const float* g1p = F.I(1) + layer * D; const float* b1p = F.I(2) + layer * D; const float* br = F.I(22);
    bf16_t* X1 = F.W<bf16_t>(WS_X1); unsigned* gcount = F.ctl() + CW_GCOUNT + 32 * layer;
    int* LIST = F.W<int>(WS_LIST); int* TOKSLOT = F.W<int>(WS_TOKSLOT); float* TOKGATE = F.W<float>(WS_TOKGATE);
    const int lane = F.lane;
    for (int tb = F.vcu; tb < T / 64; tb += F.G) {
        if (F.tid < NE) lcount[F.tid] = 0;
        __syncthreads();
        const int tok0 = tb * 64;
        f32x4 xn[4];
        { const float* yr = YPRE + (size_t)(tok0 + F.wave * 8) * D + 4 * lane;
#pragma unroll
          for (int j = 0; j < 4; ++j) xn[j] = *(const f32x4*)(yr + 256 * j); }
#pragma unroll 1
        for (int r = 0; r < 8; ++r) {
            const int rl = F.wave * 8 + r;
            f32x4 x[4]; float lg[NE];
#pragma unroll
            for (int j = 0; j < 4; ++j) x[j] = xn[j];
            if (r < 7) { const float* yr = YPRE + (size_t)(tok0 + rl + 1) * D + 4 * lane;
#pragma unroll
                for (int j = 0; j < 4; ++j) xn[j] = *(const f32x4*)(yr + 256 * j); }
            float s = 0.f;
#pragma unroll
            for (int j = 0; j < 4; ++j) s += (x[j][0] + x[j][1]) + (x[j][2] + x[j][3]);
            const float mean = wave_sum(s) * (1.0f / D); float q = 0.f;
#pragma unroll
            for (int j = 0; j < 4; ++j) { x[j] = x[j] - mean; q += (x[j][0] * x[j][0] + x[j][1] * x[j][1]) + (x[j][2] * x[j][2] + x[j][3] * x[j][3]); }
            const float rstd = 1.0f / sqrtf(wave_sum(q) * (1.0f / D) + LN_EPS);
#pragma unroll
            for (int j = 0; j < 4; ++j) { const f32x4 gg = *(const f32x4*)(g1p + 256 * j + 4 * lane), bb = *(const f32x4*)(b1p + 256 * j + 4 * lane);
                x[j] = x[j] * rstd * gg + bb;
                u32x2 w; w.x = cvt_pk_bf16(x[j][0], x[j][1]); w.y = cvt_pk_bf16(x[j][2], x[j][3]);
                *(u32x2*)(X1 + (size_t)(tok0 + rl) * D + 256 * j + 4 * lane) = w; }
#pragma unroll
            for (int e = 0; e < NE; ++e) { float a = 0.f;
#pragma unroll
                for (int j = 0; j < 4; ++j) { const f32x4 w = *(const LAS f32x4*)(wrT + e * D + 256 * j + 4 * lane);
                    a += (x[j][0] * w[0] + x[j][1] * w[1]) + (x[j][2] * w[2] + x[j][3] * w[3]); }
                lg[e] = a; }
            float a8[8], a4[4], a2[2], a1;
#pragma unroll
            for (int i = 0; i < 8; ++i) { const bool hi = lane & 1; const float send = hi ? lg[2 * i] : lg[2 * i + 1], keep = hi ? lg[2 * i + 1] : lg[2 * i]; a8[i] = keep + __shfl_xor(send, 1); }
#pragma unroll
            for (int i = 0; i < 4; ++i) { const bool hi = lane & 2; const float send = hi ? a8[2 * i] : a8[2 * i + 1], keep = hi ? a8[2 * i + 1] : a8[2 * i]; a4[i] = keep + __shfl_xor(send, 2); }
#pragma unroll
            for (int i = 0; i < 2; ++i) { const bool hi = lane & 4; const float send = hi ? a4[2 * i] : a4[2 * i + 1], keep = hi ? a4[2 * i + 1] : a4[2 * i]; a2[i] = keep + __shfl_xor(send, 4); }
            { const bool hi = lane & 8; const float send = hi ? a2[0] : a2[1], keep = hi ? a2[1] : a2[0]; a1 = keep + __shfl_xor(send, 8); }
            a1 += __shfl_xor(a1, 16); a1 += __shfl_xor(a1, 32);
            float l[NE];
#pragma unroll
            for (int e = 0; e < NE; ++e) l[e] = __int_as_float(__builtin_amdgcn_readlane(__float_as_int(a1), e)) + br[e];
            int e1, e2; float g1, g2; route16(l, e1, e2, g1, g2);
            if (lane == 0) {
                const int lp1 = __hip_atomic_fetch_add(lcount + e1, 1, __ATOMIC_RELAXED, __HIP_MEMORY_SCOPE_WORKGROUP), lp2 = __hip_atomic_fetch_add(lcount + e2, 1, __ATOMIC_RELAXED, __HIP_MEMORY_SCOPE_WORKGROUP);
                re[2 * rl] = e1; re[2 * rl + 1] = e2; rlp[2 * rl] = lp1; rlp[2 * rl + 1] = lp2; rg[2 * rl] = g1; rg[2 * rl + 1] = g2; }
        }
        __syncthreads();
        if (F.tid < NE) gbase[F.tid] = (int)__hip_atomic_fetch_add(gcount + F.tid, (unsigned)lcount[F.tid], RLX_AGENT);
        __syncthreads();
        if (F.tid < 128) { const int e = re[F.tid], pos = gbase[e] + rlp[F.tid], tok = tok0 + (F.tid >> 1);
            LIST[e * T + pos] = tok; TOKSLOT[tok * 2 + (F.tid & 1)] = e * T + pos; TOKGATE[tok * 2 + (F.tid & 1)] = rg[F.tid]; }
        __syncthreads();
    }
}

__device__ __forceinline__ void p_combine(Frame& F, int layer) {
    F.retid();
    const unsigned* gcount = F.ctl() + CW_GCOUNT + 32 * layer;
    const int lane = F.lane;
    int pre; { const int cnt = lane < NE ? (int)__hip_atomic_load(gcount + (lane & 15), RLX_AGENT) : 0; const int tiles = (cnt + 255) >> 8; int inc = tiles;
#pragma unroll
        for (int o = 1; o < 16; o <<= 1) { const int v = __shfl_up(inc, o); if (lane >= o) inc += v; }
        pre = (inc - tiles) * 256; }
    const bf16_t* X1 = F.W<bf16_t>(WS_X1); const bf16_t* Y = F.W<bf16_t>(WS_Y); const int* TOKSLOT = F.W<int>(WS_TOKSLOT); const float* TOKGATE = F.W<float>(WS_TOKGATE);
    const float* g2p = F.I(3) + layer * D; const float* b2p = F.I(4) + layer * D;
    bf16_t* X2 = F.W<bf16_t>(WS_X2);
    for (int tb = F.vcu * NWAVES + F.wave; tb < T / 8; tb += F.G * NWAVES) {
#pragma unroll 2
        for (int i = 0; i < 8; ++i) { const int t = tb * 8 + i;
            const int s0 = __builtin_amdgcn_readfirstlane(TOKSLOT[2 * t]), s1 = __builtin_amdgcn_readfirstlane(TOKSLOT[2 * t + 1]);
            const float g0 = TOKGATE[2 * t], g1 = TOKGATE[2 * t + 1];
            const int r0 = __builtin_amdgcn_readlane(pre, s0 >> 14) + (s0 & (T - 1)), r1 = __builtin_amdgcn_readlane(pre, s1 >> 14) + (s1 & (T - 1));
            f32x4 v[4]; float s = 0.f;
#pragma unroll
            for (int j = 0; j < 4; ++j) { const u32x2 xw = *(const u32x2*)(X1 + (size_t)t * D + 256 * j + 4 * lane), y0 = *(const u32x2*)(Y + (size_t)r0 * D + 256 * j + 4 * lane), y1 = *(const u32x2*)(Y + (size_t)r1 * D + 256 * j + 4 * lane);
                v[j][0] = ALPHA * bf_lo(xw.x) + (g0 * bf_lo(y0.x) + g1 * bf_lo(y1.x)); v[j][1] = ALPHA * bf_hi(xw.x) + (g0 * bf_hi(y0.x) + g1 * bf_hi(y1.x));
                v[j][2] = ALPHA * bf_lo(xw.y) + (g0 * bf_lo(y0.y) + g1 * bf_lo(y1.y)); v[j][3] = ALPHA * bf_hi(xw.y) + (g0 * bf_hi(y0.y) + g1 * bf_hi(y1.y));
                s += (v[j][0] + v[j][1]) + (v[j][2] + v[j][3]); }
            const float mean = wave_sum(s) * (1.0f / D); float q = 0.f;
#pragma unroll
            for (int j = 0; j < 4; ++j) { v[j] = v[j] - mean; q += (v[j][0] * v[j][0] + v[j][1] * v[j][1]) + (v[j][2] * v[j][2] + v[j][3] * v[j][3]); }
            const float rstd = 1.0f / sqrtf(wave_sum(q) * (1.0f / D) + LN_EPS);
#pragma unroll
            for (int j = 0; j < 4; ++j) { const f32x4 gg = *(const f32x4*)(g2p + 256 * j + 4 * lane), bb = *(const f32x4*)(b2p + 256 * j + 4 * lane); const f32x4 o = v[j] * rstd * gg + bb;
                if (layer == 0) { u32x2 w; w.x = cvt_pk_bf16(o[0], o[1]); w.y = cvt_pk_bf16(o[2], o[3]); *(u32x2*)(X2 + (size_t)t * D + 256 * j + 4 * lane) = w; }
                else *(f32x4*)(F.out + (size_t)t * D + 256 * j + 4 * lane) = o; }
        }
    }
}

__device__ __forceinline__ void p_conv4(Frame& F) {
    F.retid();
    const bf16_t* XR = F.W<bf16_t>(WS_XR); bf16_t* XC = F.W<bf16_t>(WS_XC); const float* w = F.I(13); const float* bias = F.I(14);
    const int lane = F.lane;
    f32x4 wk[2][CONVC][2], bs[2][2];
#pragma unroll
    for (int hh = 0; hh < 2; ++hh) { const int c0 = 8 * lane + 512 * hh;
#pragma unroll
        for (int k = 0; k < CONVC; ++k) { wk[hh][k][0] = *(const f32x4*)(w + k * DRNN + c0); wk[hh][k][1] = *(const f32x4*)(w + k * DRNN + c0 + 4); }
        bs[hh][0] = *(const f32x4*)(bias + c0); bs[hh][1] = *(const f32x4*)(bias + c0 + 4); }
    for (int tb = F.vcu * NWAVES + F.wave; tb < T / 8; tb += F.G * NWAVES) {
#pragma unroll 2
        for (int i = 0; i < 8; ++i) { const int t = tb * 8 + i, s = t & (SEQ - 1);
#pragma unroll
            for (int hh = 0; hh < 2; ++hh) { const int c0 = 8 * lane + 512 * hh; f32x4 a0 = bs[hh][0], a1 = bs[hh][1];
#pragma unroll
                for (int k = 0; k < CONVC; ++k) { const int d = CONVC - 1 - k; const bool ok = s >= d; const size_t rr = ok ? (size_t)(t - d) : (size_t)t; const float m = ok ? 1.f : 0.f;
                    const u32x4 xw = *(const u32x4*)(XR + rr * DRNN + c0);
                    const f32x4 x0 = {bf_lo(xw.x), bf_hi(xw.x), bf_lo(xw.y), bf_hi(xw.y)}, x1 = {bf_lo(xw.z), bf_hi(xw.z), bf_lo(xw.w), bf_hi(xw.w)};
                    a0 += (wk[hh][k][0] * m) * x0; a1 += (wk[hh][k][1] * m) * x1; }
                *(u32x4*)(XC + (size_t)t * DRNN + c0) = pg8::pack8(a0, a1); }
        }
    }
}

constexpr int SCH = 64, NCHUNK = SEQ / SCH;
__device__ __forceinline__ void p_scan1(Frame& F) {
    F.retid();
    const bf16_t* L2A = F.W<bf16_t>(WS_XR); const bf16_t* BV = F.W<bf16_t>(WS_BV); float* AGG = F.W<float>(WS_AGG);
    for (int task = F.vcu * NWAVES + F.wave; task < BATCH * NCHUNK * 8; task += F.G * NWAVES) {
        const int bc = task >> 3, c = (task & 7) * 128 + 2 * F.lane; const size_t base = (size_t)bc * SCH * DRNN + c;
        float sl0 = 0.f, sl1 = 0.f, h0 = 0.f, h1 = 0.f;
#pragma unroll 16
        for (int s = 0; s < SCH; ++s) { const unsigned lw = *(const unsigned*)(L2A + base + (size_t)s * DRNN), bw = *(const unsigned*)(BV + base + (size_t)s * DRNN);
            const float l0 = bf_lo(lw), l1 = bf_hi(lw); sl0 += l0; sl1 += l1;
            h0 = __builtin_amdgcn_exp2f(l0) * h0 + bf_lo(bw); h1 = __builtin_amdgcn_exp2f(l1) * h1 + bf_hi(bw); }
        *(f32x4*)(AGG + ((size_t)bc * DRNN + c) * 2) = (f32x4){sl0, h0, sl1, h1};
    }
}
__device__ __forceinline__ void p_scan2(Frame& F) {
    F.retid();
    const bf16_t* L2A = F.W<bf16_t>(WS_XR); const bf16_t* BV = F.W<bf16_t>(WS_BV); const float* AGG = F.W<float>(WS_AGG); bf16_t* GY = F.W<bf16_t>(WS_GY);
    for (int task = F.vcu * NWAVES + F.wave; task < BATCH * NCHUNK * 8; task += F.G * NWAVES) {
        const int bc = task >> 3, c = (task & 7) * 128 + 2 * F.lane; const int b = bc / NCHUNK, ch = bc % NCHUNK;
        float h0 = 0.f, h1 = 0.f;
#pragma unroll 8
        for (int j = 0; j < ch; ++j) { const f32x4 g = *(const f32x4*)(AGG + ((size_t)(b * NCHUNK + j) * DRNN + c) * 2);
            h0 = __builtin_amdgcn_exp2f(g[0]) * h0 + g[1]; h1 = __builtin_amdgcn_exp2f(g[2]) * h1 + g[3]; }
        const size_t base = (size_t)bc * SCH * DRNN + c;
#pragma unroll 16
        for (int s = 0; s < SCH; ++s) { const size_t o = base + (size_t)s * DRNN; const unsigned lw = *(const unsigned*)(L2A + o), bw = *(const unsigned*)(BV + o), gw = *(const unsigned*)(GY + o);
            h0 = __builtin_amdgcn_exp2f(bf_lo(lw)) * h0 + bf_lo(bw); h1 = __builtin_amdgcn_exp2f(bf_hi(lw)) * h1 + bf_hi(bw);
            *(unsigned*)(GY + o) = cvt_pk_bf16(bf_lo(gw) * h0, bf_hi(gw) * h1); }
    }
}

constexpr int NPH = 18;
#ifndef N_LAUNCHES
#define N_LAUNCHES 1
#endif
__global__ void __launch_bounds__(NTHREADS, 2) mega_fwd(Args args) {
    extern __shared__ __attribute__((aligned(16))) unsigned char lds_raw[];
    Frame F;
    F.lds = (LAS unsigned char*)lds_raw; F.ws = args.ws; F.in = args.in; F.out = args.out;
    F.tid = threadIdx.x; F.lane = F.tid & 63; F.wave = __builtin_amdgcn_readfirstlane(F.tid >> 6);
    F.G = gridDim.x; { const int bx = blockIdx.x; F.vcu = (F.G % 8 == 0) ? (bx % 8) * (F.G / 8) + bx / 8 : bx; }
    for (int u = F.tid; u < (LDS_BYTES - LDSCTL_OFF) / 4; u += NTHREADS) ((LAS unsigned*)(F.lds + LDSCTL_OFF))[u] = 0u;
    __syncthreads();
    XcdBarrier bar; bar.bar = F.ctl() + CW_BAR; bar.x = 0; bar.st = nullptr;
    if (N_LAUNCHES == 1) bar = xcd_barrier_post(F.ctl() + CW_BAR, (volatile LAS unsigned*)(F.lds + MISC_OFF) + 8);
    const int lo = args.ph_lo, hi = args.ph_hi;
#ifndef PH_MASK
#define PH_MASK 0x3ffff
#endif
#define IN(k) (((PH_MASK >> (k)) & 1) && lo <= (k) && (k) < hi)
#define SEAM(k) do { if (IN(k) && IN((k) + 1)) xcd_barrier(bar); } while (0)
    const int cblk = (int)blockIdx.x;

    if (IN(0)) { p0_prologue(F); } SEAM(0);
    if (IN(1)) { DenseOrder S{F.W<char>(WS_X2), F.W<char>(WS_WIN0), (size_t)256 * D * 2, (size_t)256 * D * 2, T / 256, DIN0 / 256, F.G, cblk};
        pg8::EpiIn0 E{F.W<bf16_t>(WS_U0)}; pg8::gemm_phase<pg8::EpiIn0, DenseOrder, false>(F.lds, D, D, D, S, E); } SEAM(1);
    if (IN(2)) { p_mix0(F); } SEAM(2);
    if (IN(3)) { DenseOrder S{F.W<char>(WS_CAT0), F.W<char>(WS_WOUT0), (size_t)256 * D * 2, (size_t)256 * D * 2, T / 256, D / 256, F.G, cblk};
        pg8::EpiRes<false> E{F.I(0), F.W<float>(WS_YPRE0)}; pg8::gemm_phase<pg8::EpiRes<false>, DenseOrder, false>(F.lds, D, D, D, S, E); } SEAM(3);
    if (IN(4)) { p_ln1_route(F, 0, F.W<float>(WS_YPRE0)); } SEAM(4);
#pragma unroll 1
    for (int layer = 0; layer < 2; ++layer) {
        const int pb = layer == 0 ? 5 : 15;
        if (IN(pb)) { const int nu = moe_setup(F, layer, 2 * DEXP / 256, true);
            MoeOrder S{(LAS const int*)(F.lds + UNITS_OFF), nu, F.W<char>(WS_X1), F.W<char>(WS_W13) + (size_t)layer * NE * 2 * DEXP * D * 2, (size_t)2 * DEXP * D * 2, (size_t)256 * D * 2, true};
            pg8::EpiMoe1 E{F.W<bf16_t>(WS_H)}; pg8::gemm_phase<pg8::EpiMoe1, MoeOrder, true>(F.lds, D, D, D, S, E); } SEAM(pb);
        if (IN(pb + 1)) { const int nu = moe_setup(F, layer, D / 256, false);
            MoeOrder S{(LAS const int*)(F.lds + UNITS_OFF), nu, F.W<char>(WS_H), F.W<char>(WS_W2) + (size_t)layer * NE * D * DEXP * 2, (size_t)D * DEXP * 2, (size_t)256 * DEXP * 2, false};
            pg8::EpiMoe2 E{F.W<bf16_t>(WS_Y)}; pg8::gemm_phase<pg8::EpiMoe2, MoeOrder, false>(F.lds, DEXP, DEXP, DEXP, S, E); } SEAM(pb + 1);
        if (IN(pb + 2)) { p_combine(F, layer); } SEAM(pb + 2);
        if (layer == 0) {
            if (IN(8)) { DenseOrder S{F.W<char>(WS_X2), F.W<char>(WS_WIN1), (size_t)256 * D * 2, (size_t)256 * D * 2, T / 256, 2 * DRNN / 256, F.G, cblk};
                pg8::EpiIn1 E{F.W<bf16_t>(WS_GY), F.W<bf16_t>(WS_XR)}; pg8::gemm_phase<pg8::EpiIn1, DenseOrder, false>(F.lds, D, D, D, S, E); } SEAM(8);
            if (IN(9)) { p_conv4(F); } SEAM(9);
            if (IN(10)) { GatesOrder S{F.W<char>(WS_XC), F.W<char>(WS_WGT), F.G, cblk};
                pg8::EpiGates E{F.W<bf16_t>(WS_XC), F.I(16), F.I(18), F.W<float>(WS_SPL), F.W<bf16_t>(WS_XR), F.W<bf16_t>(WS_BV)};
                pg8::gemm_phase<pg8::EpiGates, GatesOrder, false>(F.lds, DRNN, RBLK, RBLK, S, E); } SEAM(10);
            if (IN(11)) { p_scan1(F); } SEAM(11);
            if (IN(12)) { p_scan2(F); } SEAM(12);
            if (IN(13)) { DenseOrder S{F.W<char>(WS_GY), F.W<char>(WS_WOUT1), (size_t)256 * DRNN * 2, (size_t)256 * DRNN * 2, T / 256, D / 256, F.G, cblk};
                pg8::EpiRes<true> E{F.W<bf16_t>(WS_X2), F.W<float>(WS_YPRE1)}; pg8::gemm_phase<pg8::EpiRes<true>, DenseOrder, false>(F.lds, DRNN, DRNN, DRNN, S, E); } SEAM(13);
            if (IN(14)) { p_ln1_route(F, 1, F.W<float>(WS_YPRE1)); } SEAM(14);
        }
    }
#undef IN
#undef SEAM
}

static int g_grid = 0;
static inline bool fast_setup() {
    if (g_grid == 0) {
        int dev = 0, cus = 0, per_cu = 0;
        if (hipGetDevice(&dev) != hipSuccess || hipDeviceGetAttribute(&cus, hipDeviceAttributeMultiprocessorCount, dev) != hipSuccess) { fprintf(stderr, "kernel_launch: device query failed\n"); g_grid = -1; return false; }
        if (hipFuncSetAttribute((const void*)mega_fwd, hipFuncAttributeMaxDynamicSharedMemorySize, LDS_BYTES) != hipSuccess) { fprintf(stderr, "kernel_launch: hipFuncSetAttribute failed\n"); g_grid = -1; return false; }
        if (hipOccupancyMaxActiveBlocksPerMultiprocessor(&per_cu, (const void*)mega_fwd, NTHREADS, LDS_BYTES) != hipSuccess || per_cu < 1) { fprintf(stderr, "kernel_launch: occupancy query says %d blocks per CU\n", per_cu); (void)hipGetLastError(); per_cu = 1; }
        g_grid = cus;
        if (g_grid > 256) g_grid = 256;
    }
    return g_grid > 0;
}
static inline void fast_launch(void* const* d_in, void* d_out, void* d_ws, hipStream_t stream, int lo, int hi) {
    Args a{};
    for (int i = 0; i < 26; ++i) a.in[i] = (const float*)d_in[i];
    a.out = (float*)d_out; a.ws = (unsigned char*)d_ws; a.ph_lo = lo; a.ph_hi = hi;
    hipLaunchKernelGGL(mega_fwd, dim3(g_grid), dim3(NTHREADS), LDS_BYTES, stream, a);
}
extern "C" void kernel_launch(void* const* d_in, const int* in_sizes, int n_in, void* d_out, int out_size, void* d_ws, size_t ws_size, hipStream_t stream) {
    if (n_in != 26 || out_size != T * D || ws_size < WS_FAST_END) { fprintf(stderr, "kernel_launch: unexpected shapes (n_in %d out %d ws %zu)\n", n_in, out_size, ws_size); return; }
    if (!fast_setup()) return;
    if (hipMemsetAsync((char*)d_ws + WS_CTL, 0, CTL_ZERO_BYTES, stream) != hipSuccess) { fprintf(stderr, "kernel_launch: memset failed\n"); return; }
    if (N_LAUNCHES == 1) fast_launch(d_in, d_out, d_ws, stream, 0, NPH);
    else for (int p = 0; p < NPH; ++p) fast_launch(d_in, d_out, d_ws, stream, p, p + 1);
}
```

```cpp
#define BUILD_MODE 1
#define N_LAUNCHES 1
#include <hip/hip_runtime.h>
#include <cstdio>
#include <cstdint>
#include <cmath>
constexpr int D = 1024, BATCH = 2, SEQ = 8192, T = BATCH * SEQ, DEPTH = 2;
constexpr int DA = 512, DB = 512, DIN0 = 2 * DA + 3 * DB, CONVA = 31, CONVB = 3;
constexpr int DRNN = 1024, RBLK = 256, RHEADS = 4, CONVC = 4;
constexpr int NE = 16, NG = 4, EPG = 4, DEXP = 1024;
constexpr float LN_EPS = 1e-5f, ALPHA = 1.41421356237309515f;
#define LAS __attribute__((address_space(3)))
#define GAS __attribute__((address_space(1)))
typedef unsigned short bf16_t;
typedef short bf16x8 __attribute__((ext_vector_type(8)));
typedef float f32x4 __attribute__((ext_vector_type(4)));
typedef float f32x2 __attribute__((ext_vector_type(2)));
typedef unsigned u32x4 __attribute__((ext_vector_type(4)));
typedef unsigned u32x2 __attribute__((ext_vector_type(2)));
typedef GAS unsigned gu32;
#define RLX_AGENT __ATOMIC_RELAXED, __HIP_MEMORY_SCOPE_AGENT
#define LDS_WAIT() asm volatile("s_waitcnt lgkmcnt(0)" ::: "memory")
#define VM_WAIT() asm volatile("s_waitcnt vmcnt(0)" ::: "memory")

__device__ __forceinline__ unsigned cvt_pk_bf16(float lo, float hi) { unsigned r; asm volatile("v_cvt_pk_bf16_f32 %0, %1, %2" : "=v"(r) : "v"(lo), "v"(hi)); return r; }
__device__ __forceinline__ unsigned pack4_fp8(float a, float b, float c, float d) { int r = __builtin_amdgcn_cvt_pk_fp8_f32(a, b, 0, false); r = __builtin_amdgcn_cvt_pk_fp8_f32(c, d, r, true); return (unsigned)r; }
__device__ __forceinline__ float bf_lo(unsigned u) { return __uint_as_float(u << 16); }
__device__ __forceinline__ float bf_hi(unsigned u) { return __uint_as_float(u & 0xffff0000u); }
__device__ __forceinline__ float fsigmoid(float x) { return __builtin_amdgcn_rcpf(1.0f + __builtin_amdgcn_exp2f(-1.4426950408889634f * x)); }
__device__ __forceinline__ float fsilu(float x) { return x * fsigmoid(x); }
__device__ __forceinline__ float fgelu_tanh(float x) { return x * fsigmoid(1.5957691216057308f * (x + 0.044715f * x * x * x)); }
__device__ __forceinline__ float dpp_xor1(float v) { return __int_as_float(__builtin_amdgcn_mov_dpp(__float_as_int(v), 0xB1, 0xF, 0xF, true)); }
__device__ __forceinline__ float dpp_xor2(float v) { return __int_as_float(__builtin_amdgcn_mov_dpp(__float_as_int(v), 0x4E, 0xF, 0xF, true)); }
template <int M> __device__ __forceinline__ float swz_xor(float v) { return __int_as_float(__builtin_amdgcn_ds_swizzle(__float_as_int(v), (M << 10) | 0x1F)); }
__device__ __forceinline__ float half_sum(float v) { const auto r = __builtin_amdgcn_permlane32_swap(__float_as_uint(v), __float_as_uint(v), false, false); return __uint_as_float(r[0]) + __uint_as_float(r[1]); }
__device__ __forceinline__ float wave_sum(float v) { v += dpp_xor1(v); v += dpp_xor2(v); v += swz_xor<4>(v); v += swz_xor<8>(v); v += swz_xor<16>(v); return half_sum(v); }
__device__ __forceinline__ int lane_id_asm() { int l; asm volatile("v_mbcnt_lo_u32_b32 %0, -1, 0\n\tv_mbcnt_hi_u32_b32 %0, -1, %0" : "=v"(l)); return l; }

namespace pg8 {
constexpr int BM = 256, BK = 64, HALF = 128, HTB = HALF * BK * 2, STAGE_BYTES = 8 * HTB, NXCD = 8, WGM = 8;
__host__ __device__ __forceinline__ int lds_byte(int r, int c) { const int st = (r >> 4) * 2 + (c >> 5), rr = r & 15, cc = c & 31, ob = rr * 64 + cc * 2; return st * 1024 + (ob ^ (((ob >> 9) & 1) << 5)); }
__host__ __device__ __forceinline__ void stage_rc(int b, int& R, int& C) { const int st = b / 1024, sb = b % 1024, swz = sb ^ (((sb >> 9) & 1) << 5); R = (st >> 1) * 16 + swz / 64; C = (st & 1) * 32 + (swz % 64) / 2; }
__host__ __device__ __forceinline__ int perm32(int rho) { const int n = rho >> 4, i = rho & 15; return 8 * (i >> 2) + 4 * n + (i & 3); }

struct Unit { const char* A; const char* B; int row0, pn, e, gtab; };
__device__ __forceinline__ bool tile_of(int i, int G, int c, int nM, int nN, int& pm, int& pn) {
    const int nwg = nM * nN; const long L = (long)i * G + c; if (L >= nwg) return false;
    int wgid = (int)L; { const int q = nwg / NXCD, r = nwg % NXCD, xcd = wgid % NXCD, off = wgid / NXCD; wgid = (xcd < r ? xcd * (q + 1) : r * (q + 1) + (xcd - r) * q) + off; }
    const int nig = WGM * nN, gid = wgid / nig, fm = gid * WGM, gsz = (nM - fm) < WGM ? (nM - fm) : WGM;
    pm = fm + ((wgid % nig) % gsz); pn = (wgid % nig) / gsz; return true;
}

typedef int i32x8 __attribute__((ext_vector_type(8)));
typedef int i32x4 __attribute__((ext_vector_type(4)));
template <class Epi, class Sched, bool GATHER, int FMT = 0>
__device__ __forceinline__ void gemm_phase(LAS unsigned char* lds, const int wid_in, const int lda, const int ldb, const int KB, const Sched& S, const Epi& E, const int sclb = 0x7f7f7f7f) {
    const int lane = lane_id_asm(), wid = wid_in, tid = wid * 64 + lane, wr = wid >> 2, wc = wid & 3, fr = lane & 15, fq = lane >> 4;
    const int nt = KB / 128;
    int sclr = sclb; if constexpr (FMT == 1) asm volatile("" : "+v"(sclr));
    unsigned voffA[2], voffB[2];
#pragma unroll
    for (int i = 0; i < 2; ++i) { int R, C; stage_rc(tid * 16 + i * 8192, R, C); const int Rb = Epi::PERM ? ((R & ~31) + perm32(R & 31)) : R;
        voffA[i] = (unsigned)(R * lda + C * 2); voffB[i] = (unsigned)(Rb * ldb + C * 2); }
    const size_t kstep = (size_t)(BK * 2);
    const size_t hstepA = (size_t)HALF * lda, hstepB = (size_t)HALF * ldb;
    const unsigned ldsw = (unsigned)wid * 1024u;
    const int aoff = lds_byte(wr * 64 + fr, fq * 8), boff = lds_byte(wc * 32 + fr, fq * 8);
#define PG8_SA(b, h) (((b) * 2 + (h)) * HTB)
#define PG8_SB(b, h) ((4 + (b) * 2 + (h)) * HTB)
#define PG8_ST2(bufoff, gbase, o0, o1) do { \
        __builtin_amdgcn_global_load_lds((const unsigned*)((const char*)(gbase) + (o0)), (LAS unsigned*)(lds + (bufoff) + ldsw), 16, 0, 0); \
        __builtin_amdgcn_global_load_lds((const unsigned*)((const char*)(gbase) + (o1)), (LAS unsigned*)(lds + (bufoff) + ldsw + 8192), 16, 0, 0); } while (0)
#define PG8_STB(bufoff, gbase, h) PG8_ST2(bufoff, (gbase) + (h) * hstepB, voffB[0], voffB[1])
#define PG8_STA(bufoff, gbase, h, G0, G1) do { if constexpr (GATHER) { PG8_ST2(bufoff, gbase, G0, G1); } else { PG8_ST2(bufoff, (gbase) + (h) * hstepA, voffA[0], voffA[1]); } } while (0)
#define PG8_CAT8(l_, h_) __builtin_shufflevector(l_, h_, 0, 1, 2, 3, 4, 5, 6, 7)
#define PG8_LO4(v_) __builtin_bit_cast(bf16x8, __builtin_shufflevector(v_, v_, 0, 1, 2, 3))
#define PG8_HI4(v_) __builtin_bit_cast(bf16x8, __builtin_shufflevector(v_, v_, 4, 5, 6, 7))
#define PG8_LDA(dst, b, h) do { _Pragma("unroll") for (int m = 0; m < 4; ++m) { const i32x4 l_ = *(const LAS i32x4*)(lds + PG8_SA(b, h) + aoff + m * 2048), h_ = *(const LAS i32x4*)(lds + PG8_SA(b, h) + aoff + m * 2048 + 1024); dst[m] = PG8_CAT8(l_, h_); } } while (0)
#define PG8_LDB(dst, b, h) do { _Pragma("unroll") for (int n = 0; n < 2; ++n) { const i32x4 l_ = *(const LAS i32x4*)(lds + PG8_SB(b, h) + boff + n * 2048), h_ = *(const LAS i32x4*)(lds + PG8_SB(b, h) + boff + n * 2048 + 1024); dst[n] = PG8_CAT8(l_, h_); } } while (0)
#define PG8_MMA(ai, bj, At, Bt) do { __builtin_amdgcn_s_setprio(1); _Pragma("unroll") for (int m = 0; m < 4; ++m) _Pragma("unroll") for (int n = 0; n < 2; ++n) { \
        if constexpr (FMT == 0) { acc[ai][bj][m][n] = __builtin_amdgcn_mfma_f32_16x16x32_bf16(PG8_LO4(Bt[n]), PG8_LO4(At[m]), acc[ai][bj][m][n], 0, 0, 0); \
                                  acc[ai][bj][m][n] = __builtin_amdgcn_mfma_f32_16x16x32_bf16(PG8_HI4(Bt[n]), PG8_HI4(At[m]), acc[ai][bj][m][n], 0, 0, 0); } \
        else asm volatile("v_mfma_scale_f32_16x16x128_f8f6f4 %0, %1, %2, %0, %3, %3 op_sel_hi:[0,0,0]" : "+v"(acc[ai][bj][m][n]) : "v"(Bt[n]), "v"(At[m]), "v"(sclr)); } \
        __builtin_amdgcn_s_setprio(0); } while (0)
#define PG8_WAIT_V(n) asm volatile("s_waitcnt vmcnt(" #n ")" ::: "memory")
#define PG8_WAIT_L(n) asm volatile("s_waitcnt lgkmcnt(" #n ")" ::: "memory")
#define PG8_BAR __builtin_amdgcn_s_barrier()
#define PG8_SCHED __builtin_amdgcn_sched_barrier(0)
    Unit cur, nxt; int ui = 0;
    if (!S.next(0, cur)) return;
    f32x4 acc[2][2][4][2];
#pragma unroll
    for (int a = 0; a < 2; ++a)
#pragma unroll
        for (int b = 0; b < 2; ++b)
#pragma unroll
            for (int m = 0; m < 4; ++m)
#pragma unroll
                for (int n = 0; n < 2; ++n) acc[a][b][m][n] = (f32x4){0.f, 0.f, 0.f, 0.f};
    i32x8 At[4], B0[2], B1[2];
    unsigned gc[2][2] = {{0u, 0u}, {0u, 0u}};
    if constexpr (GATHER) {
#pragma unroll
        for (int i = 0; i < 2; ++i) { int R, C; stage_rc(tid * 16 + i * 8192, R, C);
#pragma unroll
            for (int h = 0; h < 2; ++h) gc[h][i] = *(const LAS unsigned*)(lds + cur.gtab + (h * HALF + R) * 4) + (unsigned)C * 2u; }
    }
    const char* cA = cur.A; const char* cB = cur.B;
    PG8_STB(PG8_SB(0, 0), cB, 0); PG8_STB(PG8_SB(0, 1), cB, 1); PG8_STA(PG8_SA(0, 0), cA, 0, gc[0][0], gc[0][1]); PG8_STA(PG8_SA(0, 1), cA, 1, gc[1][0], gc[1][1]);
    if (wr == 1) PG8_BAR;
    PG8_WAIT_V(2); PG8_BAR;
    PG8_STB(PG8_SB(1, 0), cB + kstep, 0); PG8_STA(PG8_SA(1, 0), cA + kstep, 0, gc[0][0], gc[0][1]); PG8_STB(PG8_SB(1, 1), cB + kstep, 1);
    PG8_WAIT_V(6); PG8_BAR;
#define PG8_KITER(a1_, a2_, b2_, G00, G01, G10, G11) do { \
            const char* a3_ = (a2_) + kstep; const char* b3_ = (b2_) + kstep; \
              \
            PG8_LDB(B0, 0, 0); PG8_LDB(B1, 0, 1); PG8_SCHED; PG8_LDA(At, 0, 0); PG8_STA(PG8_SA(1, 1), a1_, 1, gc[1][0], gc[1][1]); \
            PG8_WAIT_V(8); PG8_WAIT_L(0); PG8_BAR; PG8_MMA(0, 0, At, B0); PG8_MMA(0, 1, At, B1); PG8_BAR; PG8_SCHED; \
              \
            PG8_LDA(At, 0, 1); PG8_STB(PG8_SB(0, 0), b2_, 0); PG8_STB(PG8_SB(0, 1), b2_, 1); PG8_STA(PG8_SA(0, 0), a2_, 0, G00, G01); \
            PG8_WAIT_V(8); PG8_WAIT_L(0); PG8_BAR; PG8_MMA(1, 0, At, B0); PG8_MMA(1, 1, At, B1); PG8_BAR; PG8_SCHED; \
              \
            PG8_LDB(B0, 1, 0); PG8_LDB(B1, 1, 1); PG8_SCHED; PG8_LDA(At, 1, 0); PG8_STA(PG8_SA(0, 1), a2_, 1, G10, G11); \
            PG8_WAIT_V(8); PG8_WAIT_L(0); PG8_BAR; PG8_MMA(0, 0, At, B0); PG8_MMA(0, 1, At, B1); PG8_BAR; PG8_SCHED; \
              \
            PG8_LDA(At, 1, 1); PG8_STB(PG8_SB(1, 0), b3_, 0); PG8_STB(PG8_SB(1, 1), b3_, 1); PG8_STA(PG8_SA(1, 0), a3_, 0, G00, G01); \
            PG8_WAIT_V(8); PG8_WAIT_L(0); PG8_BAR; PG8_MMA(1, 0, At, B0); PG8_MMA(1, 1, At, B1); PG8_BAR; PG8_SCHED; } while (0)
    for (;;) {
        const bool has_next = S.next(ui + 1, nxt);
        const char* nA = has_next ? nxt.A : cA; const char* nB = has_next ? nxt.B : cB;
        if constexpr (!GATHER) {
#pragma unroll 1
            for (int t = 0; t < nt; t += 2) {
                const bool last = (t == nt - 2);
                const char* a1 = cA + (size_t)(t + 1) * kstep;
                const char* a2 = last ? nA : cA + (size_t)(t + 2) * kstep; const char* b2 = last ? nB : cB + (size_t)(t + 2) * kstep;
                PG8_KITER(a1, a2, b2, 0u, 0u, 0u, 0u);
            }
        } else {
#pragma unroll 1
            for (int t = 0; t < nt - 2; t += 2) {
                const char* a1 = cA + (size_t)(t + 1) * kstep; const char* a2 = cA + (size_t)(t + 2) * kstep; const char* b2 = cB + (size_t)(t + 2) * kstep;
                PG8_KITER(a1, a2, b2, gc[0][0], gc[0][1], gc[1][0], gc[1][1]);
            }
            unsigned gn[2][2] = {{gc[0][0], gc[0][1]}, {gc[1][0], gc[1][1]}};
            if (has_next) {
                const int tid2 = wid * 64 + lane_id_asm();
#pragma unroll
                for (int i = 0; i < 2; ++i) { int R, C; stage_rc(tid2 * 16 + i * 8192, R, C);
#pragma unroll
                    for (int h = 0; h < 2; ++h) gn[h][i] = *(const LAS unsigned*)(lds + nxt.gtab + (h * HALF + R) * 4) + (unsigned)C * 2u; } }
            const char* a1 = cA + (size_t)(nt - 1) * kstep;
            PG8_KITER(a1, nA, nB, gn[0][0], gn[0][1], gn[1][0], gn[1][1]);
            gc[0][0] = gn[0][0]; gc[0][1] = gn[0][1]; gc[1][0] = gn[1][0]; gc[1][1] = gn[1][1];
        }
        if (wr == 0) PG8_BAR;
        if constexpr (FMT == 1) asm volatile("s_nop 15\n\ts_nop 15" ::: "memory");
        if constexpr (GATHER) { int fr2 = fr, fq2 = fq; asm volatile("" : "+v"(fr2), "+v"(fq2));
            E(acc, cur, wr, wc, fr2, fq2); }
        else E(acc, cur, wr, wc, fr, fq);
        if (!has_next) break;
#pragma unroll
        for (int a = 0; a < 2; ++a)
#pragma unroll
            for (int b = 0; b < 2; ++b)
#pragma unroll
                for (int m = 0; m < 4; ++m)
#pragma unroll
                    for (int n = 0; n < 2; ++n) acc[a][b][m][n] = (f32x4){0.f, 0.f, 0.f, 0.f};
        cur = nxt; cA = nA; cB = nB; ++ui;
        if (wr == 1) PG8_BAR;
    }
    PG8_WAIT_V(0);
    PG8_BAR;
#undef PG8_SA
#undef PG8_SB
#undef PG8_ST2
#undef PG8_STB
#undef PG8_STA
#undef PG8_LDA
#undef PG8_CAT8
#undef PG8_LO4
#undef PG8_HI4
#undef PG8_LDB
#undef PG8_MMA
#undef PG8_WAIT_V
#undef PG8_WAIT_L
#undef PG8_BAR
#undef PG8_SCHED
#undef PG8_KITER
}

typedef f32x4 AccT[2][2][4][2];
__device__ __forceinline__ u32x4 pack8(const f32x4 a, const f32x4 b) { u32x4 w; w.x = cvt_pk_bf16(a[0], a[1]); w.y = cvt_pk_bf16(a[2], a[3]); w.z = cvt_pk_bf16(b[0], b[1]); w.w = cvt_pk_bf16(b[2], b[3]); return w; }
template <int ACT> __device__ __forceinline__ void store_plain(const AccT& acc, bf16_t* O, int ldo, int row0, int col0, int wr, int wc, int fr, int fq) {
#pragma unroll
    for (int ai = 0; ai < 2; ++ai)
#pragma unroll
        for (int m = 0; m < 4; ++m) { bf16_t* rowp = O + (size_t)(row0 + ai * HALF + wr * 64 + m * 16 + fr) * ldo + col0 + wc * 32 + 8 * fq;
#pragma unroll
            for (int bj = 0; bj < 2; ++bj) { f32x4 v0 = acc[ai][bj][m][0], v1 = acc[ai][bj][m][1];
                if (ACT == 1) {
#pragma unroll
                    for (int j = 0; j < 4; ++j) { v0[j] = fgelu_tanh(v0[j]); v1[j] = fgelu_tanh(v1[j]); } }
                *(u32x4*)(rowp + bj * HALF) = pack8(v0, v1); } }
}
template <int MODE> __device__ __forceinline__ void store_pair(const AccT& acc, bf16_t* O, int ldo, int row0, int col0, int wr, int wc, int fr, int fq) {
#pragma unroll
    for (int ai = 0; ai < 2; ++ai)
#pragma unroll
        for (int m = 0; m < 4; ++m) { bf16_t* rowp = O + (size_t)(row0 + ai * HALF + wr * 64 + m * 16 + fr) * ldo + col0 + wc * 32 + 8 * fq;
            f32x4 o[2];
#pragma unroll
            for (int n = 0; n < 2; ++n) { const f32x4 v = acc[ai][0][m][n], g = acc[ai][1][m][n];
#pragma unroll
                for (int j = 0; j < 4; ++j) o[n][j] = MODE == 0 ? v[j] * fsigmoid(g[j]) : (MODE == 1 ? v[j] * g[j] : fsilu(v[j]) * g[j]); }
            *(u32x4*)rowp = pack8(o[0], o[1]); }
}
struct EpiIn0 {
    static constexpr bool PERM = true; bf16_t* U0;
    __device__ __forceinline__ void operator()(const AccT& acc, const Unit& u, int wr, int wc, int fr, int fq) const {
        if (u.pn < 4) store_pair<0>(acc, U0, 1536, u.row0, 128 * u.pn, wr, wc, fr, fq);
        else if (u.pn < 8) store_pair<1>(acc, U0, 1536, u.row0, 512 + 128 * (u.pn - 4), wr, wc, fr, fq);
        else store_plain<0>(acc, U0, 1536, u.row0, 1024 + 256 * (u.pn - 8), wr, wc, fr, fq);
    }
};
struct EpiIn1 {
    static constexpr bool PERM = true; bf16_t* GY; bf16_t* XR;
    __device__ __forceinline__ void operator()(const AccT& acc, const Unit& u, int wr, int wc, int fr, int fq) const {
        if (u.pn < 4) store_plain<1>(acc, GY, D, u.row0, 256 * u.pn, wr, wc, fr, fq);
        else store_plain<0>(acc, XR, D, u.row0, 256 * (u.pn - 4), wr, wc, fr, fq);
    }
};
__device__ __forceinline__ void store_pair_fp8(const AccT& acc, unsigned char* O, int ldo, int row0, int col0, int wr, int wc, int fr, int fq) {
#pragma unroll
    for (int ai = 0; ai < 2; ++ai)
#pragma unroll
        for (int m = 0; m < 4; ++m) { unsigned char* rowp = O + (size_t)(row0 + ai * HALF + wr * 64 + m * 16 + fr) * ldo + col0 + wc * 32 + 8 * fq;
            u32x2 w;
#pragma unroll
            for (int n = 0; n < 2; ++n) { const f32x4 v = acc[ai][0][m][n], g = acc[ai][1][m][n]; float o[4];
#pragma unroll
                for (int j = 0; j < 4; ++j) o[j] = fminf(fmaxf(fsilu(v[j]) * g[j], -448.f), 448.f);
                const unsigned pk = pack4_fp8(o[0], o[1], o[2], o[3]); if (n == 0) w.x = pk; else w.y = pk; }
            *(u32x2*)rowp = w; }
}
struct EpiMoe1Q { static constexpr bool PERM = true; unsigned char* H;
    __device__ __forceinline__ void operator()(const AccT& acc, const Unit& u, int wr, int wc, int fr, int fq) const { store_pair_fp8(acc, H, DEXP, u.row0, 128 * u.pn, wr, wc, fr, fq); } };
struct EpiMoe1 { static constexpr bool PERM = true; bf16_t* H;
    __device__ __forceinline__ void operator()(const AccT& acc, const Unit& u, int wr, int wc, int fr, int fq) const { store_pair<2>(acc, H, DEXP, u.row0, 128 * u.pn, wr, wc, fr, fq); } };
struct EpiMoe2 { static constexpr bool PERM = true; bf16_t* Y;
    __device__ __forceinline__ void operator()(const AccT& acc, const Unit& u, int wr, int wc, int fr, int fq) const { store_plain<0>(acc, Y, D, u.row0, 256 * u.pn, wr, wc, fr, fq); } };
template <bool RESBF> struct EpiRes { static constexpr bool PERM = false; const void* res; float* Y;
    __device__ __forceinline__ void operator()(const AccT& acc, const Unit& u, int wr, int wc, int fr, int fq) const {
#pragma unroll
        for (int ai = 0; ai < 2; ++ai)
#pragma unroll
            for (int m = 0; m < 4; ++m) { const size_t off = (size_t)(u.row0 + ai * HALF + wr * 64 + m * 16 + fr) * D + u.pn * 256 + wc * 32 + 4 * fq;
#pragma unroll
                for (int bj = 0; bj < 2; ++bj)
#pragma unroll
                    for (int n = 0; n < 2; ++n) { const size_t o = off + bj * HALF + n * 16; f32x4 r;
                        if (RESBF) { const u32x2 w = *(const u32x2*)((const bf16_t*)res + o); r = (f32x4){bf_lo(w.x), bf_hi(w.x), bf_lo(w.y), bf_hi(w.y)}; }
                        else r = *(const f32x4*)((const float*)res + o);
                        *(f32x4*)(Y + o) = r * ALPHA + acc[ai][bj][m][n]; } }
    }
};
struct EpiGates { static constexpr bool PERM = true; const bf16_t* XC; const float* ba; const float* bx; const float* spl; bf16_t* L2A; bf16_t* BV;
    __device__ __forceinline__ void operator()(const AccT& acc, const Unit& u, int wr, int wc, int fr, int fq) const {
        const int col = 128 * u.pn + wc * 32 + 8 * fq;
#pragma unroll
        for (int ai = 0; ai < 2; ++ai)
#pragma unroll
            for (int m = 0; m < 4; ++m) { const size_t o = (size_t)(u.row0 + ai * HALF + wr * 64 + m * 16 + fr) * DRNN + col;
                const u32x4 xw = *(const u32x4*)(XC + o); const float xv[8] = {bf_lo(xw.x), bf_hi(xw.x), bf_lo(xw.y), bf_hi(xw.y), bf_lo(xw.z), bf_hi(xw.z), bf_lo(xw.w), bf_hi(xw.w)};
                f32x4 la2[2], bo[2];
#pragma unroll
                for (int n = 0; n < 2; ++n) { const f32x4 cba = *(const f32x4*)(ba + col + 4 * n), cbx = *(const f32x4*)(bx + col + 4 * n), csp = *(const f32x4*)(spl + col + 4 * n);
#pragma unroll
                    for (int j = 0; j < 4; ++j) { const float r = fsigmoid(acc[ai][0][m][n][j] + cba[j]), ig = fsigmoid(acc[ai][1][m][n][j] + cbx[j]);
                        const float l2 = -1.4426950408889634f * csp[j] * r;
                        const float a = __builtin_amdgcn_exp2f(l2); la2[n][j] = l2; bo[n][j] = __builtin_sqrtf(fmaxf(1.0f - a * a, 0.f)) * (ig * xv[4 * n + j]); } }
                *(u32x4*)(L2A + o) = pack8(la2[0], la2[1]); *(u32x4*)(BV + o) = pack8(bo[0], bo[1]);
                asm volatile("" ::: "memory"); }
    }
};
}

constexpr size_t MiB = 1u << 20;
constexpr size_t WS_CTL = 0, CTL_ZERO_BYTES = 65536;
constexpr size_t WS_WIN0 = 2 * MiB, WS_WOUT0 = 7 * MiB, WS_WIN1 = 9 * MiB, WS_WGT = 13 * MiB, WS_WOUT1 = 14 * MiB, WS_W13 = 16 * MiB, WS_W2 = 144 * MiB, WS_SPL = 208 * MiB;
constexpr size_t WS_X1 = 212 * MiB, WS_X2 = 244 * MiB;
constexpr size_t WS_R = 276 * MiB;
constexpr size_t WS_U0 = WS_R, WS_CAT0 = WS_R + 48 * MiB, WS_YPRE0 = WS_R + 80 * MiB;
constexpr size_t WS_GY = WS_R, WS_XR = WS_R + 32 * MiB, WS_XC = WS_R + 64 * MiB, WS_BV = WS_R + 96 * MiB, WS_YPRE1 = WS_R + 64 * MiB;
constexpr size_t WS_H = WS_R, WS_Y = WS_R + 72 * MiB;
constexpr size_t WS_LIST = 420 * MiB, WS_TOKSLOT = 421 * MiB, WS_TOKGATE = WS_TOKSLOT + 256 * 1024, WS_AGG = 422 * MiB, WS_X1Q = 424 * MiB  , WS_FAST_END = 440 * MiB;
#ifndef MOE_FP8
#define MOE_FP8 1
#endif
constexpr int SCL_W13 = 6, SCL_W2 = 6;
static_assert(SCL_W13 % 2 == 0 && SCL_W2 % 2 == 0, "even scales");
constexpr int NPAD_ROWS = 2 * T + NE * 256;
static_assert(WS_H + (size_t)NPAD_ROWS * DEXP * 2 <= WS_Y && WS_Y + (size_t)NPAD_ROWS * D * 2 <= WS_LIST, "H / Y fit");
constexpr int CW_TMO = 0, CW_CODE = 1, CW_GCOUNT = 256  , CW_BAR = 4096;
constexpr int RING_BYTES = 131072, LDSCTL_OFF = RING_BYTES, MISC_OFF = LDSCTL_OFF + 320, UNITS_OFF = LDSCTL_OFF + 512, MOEMETA_OFF = LDSCTL_OFF + 768, GTAB_OFF = LDSCTL_OFF + 1024, MAX_UNITS = 8;
constexpr int LDS_BYTES = 147456;
static_assert(GTAB_OFF + MAX_UNITS * 1024 <= LDS_BYTES, "LDS map");
constexpr int NWAVES = 8, NTHREADS = 512;

#define XB_TMO      128
#define XB_XCNT(j)  (256  + 64 * (j))
#define XB_XSUB(j)  (1280 + 64 * (j))
#define XB_XGEN(j)  (2304 + 64 * (j))
#define XB_TOP      3328
#define XB_TOPGEN   3392
#define XCD_BAR_WORDS 3456
#define XB_SPIN_CAP (1u << 18)
__device__ __forceinline__ unsigned xb_ld(unsigned* p)              { return __hip_atomic_load(p, __ATOMIC_RELAXED, __HIP_MEMORY_SCOPE_AGENT); }
__device__ __forceinline__ unsigned xb_add(unsigned* p, unsigned v) { return __hip_atomic_fetch_add(p, v, __ATOMIC_RELAXED, __HIP_MEMORY_SCOPE_AGENT); }
__device__ __forceinline__ unsigned xb_xcc_id() { return (unsigned)__builtin_amdgcn_s_getreg((3 << 11) | 20) & 0xFu; }
#define XB_SPIN(cond, bar) do { unsigned _sp = 0; while (cond) { __builtin_amdgcn_s_sleep(1); \
    if ((++_sp & 255u) == 0u) { if (xb_ld(&(bar)[XB_TMO])) break; if (_sp > XB_SPIN_CAP) { atomicAdd(&(bar)[XB_TMO], 1u); break; } } } } while (0)
struct XcdBarrier { unsigned* bar; unsigned x; volatile LAS unsigned* st; int wave; };
__device__ __forceinline__ XcdBarrier xcd_barrier_post(unsigned* bar, volatile LAS unsigned* st, int wave) {
    XcdBarrier b; b.bar = bar; b.x = xb_xcc_id(); b.st = st; b.wave = wave;
    if (wave == 0 && lane_id_asm() == 0) (void)xb_add(&bar[XB_XCNT(b.x)], 1u);
    return b;
}
__device__ __forceinline__ void xcd_barrier_complete(unsigned* bar, unsigned x, unsigned& nloc, unsigned& nx) {
    const unsigned G = gridDim.x * gridDim.y * gridDim.z;
    unsigned sum, cnt, mine, sp = 0u;
    for (;;) {
        sum = 0u; cnt = 0u; mine = 0u;
#pragma unroll
        for (unsigned j = 0; j < 16; ++j) { const unsigned c = xb_ld(&bar[XB_XCNT(j)]); sum += c; cnt += (c > 0u) ? 1u : 0u; mine = (j == x) ? c : mine; }
        if (sum == G) break;
        __builtin_amdgcn_s_sleep(1);
        if ((++sp & 255u) == 0u) { if (xb_ld(&bar[XB_TMO])) break; if (sp > XB_SPIN_CAP) { atomicAdd(&bar[XB_TMO], 1u); break; } }
    }
    nloc = mine > 0u ? mine : 1u; nx = cnt > 0u ? cnt : 1u;
}
__device__ __forceinline__ void xcd_barrier(const XcdBarrier& b) {
    asm volatile("s_waitcnt vmcnt(0)" ::: "memory");
    __syncthreads();
    if (b.wave == 0 && lane_id_asm() == 0) {
        unsigned* bar = b.bar;
        __builtin_amdgcn_s_waitcnt(0);
        unsigned nloc = b.st[0], nx = b.st[1];
        if (nloc == 0u) { xcd_barrier_complete(bar, b.x, nloc, nx); b.st[0] = nloc; b.st[1] = nx; }
        const unsigned old = xb_add(&bar[XB_XSUB(b.x)], 1u);
        const unsigned gen = old / nloc;
        if (old + 1u == (gen + 1u) * nloc) {
            __builtin_amdgcn_fence(__ATOMIC_RELEASE, "agent");
            asm volatile("s_waitcnt vmcnt(0)" ::: "memory");
            const unsigned og = xb_add(&bar[XB_TOP], 1u);
            const unsigned tg = og / nx;
            if (og + 1u == (tg + 1u) * nx) xb_add(&bar[XB_TOPGEN], 1u);
            else XB_SPIN(xb_ld(&bar[XB_TOPGEN]) == tg, bar);
            __builtin_amdgcn_fence(__ATOMIC_ACQUIRE, "agent");
            xb_add(&bar[XB_XGEN(b.x)], 1u);
            asm volatile("s_waitcnt vmcnt(0)" ::: "memory");
        } else {
            XB_SPIN(xb_ld(&bar[XB_XGEN(b.x)]) == gen, bar);
            __builtin_amdgcn_fence(__ATOMIC_ACQUIRE, "agent");
            asm volatile("s_waitcnt vmcnt(0)" ::: "memory");
        }
    }
    __syncthreads();
}

struct Args { const float* in[26]; float* out; unsigned char* ws; int ph_lo, ph_hi; };
struct Frame {
    LAS unsigned char* lds; unsigned char* ws; const float* const* in; float* out;
    int tid, lane, wave, vcu, G;
    template <class Tp> __device__ __forceinline__ Tp* W(size_t off) const { return (Tp*)(ws + off); }
    __device__ __forceinline__ const float* I(int i) const { return in[i]; }
    __device__ __forceinline__ unsigned* ctl() const { return (unsigned*)(ws + WS_CTL); }
    __device__ __forceinline__ void retid() { lane = lane_id_asm(); tid = wave * 64 + lane; }
};

__device__ __forceinline__ void cvt_item(const float* src, int ldsrc, int k0, int c0, bf16_t* dst, int lddst, int drow0, LAS unsigned* scr, int lane) {
    const int cg = lane & 15, rp = lane >> 4;
    const float* sp = src + (size_t)k0 * ldsrc + c0 + 4 * cg;
    f32x4 v[16];
#pragma unroll
    for (int j = 0; j < 8; ++j) { const int r = 2 * (rp + 4 * j); v[2 * j] = *(const f32x4*)(sp + (size_t)r * ldsrc); v[2 * j + 1] = *(const f32x4*)(sp + (size_t)(r + 1) * ldsrc); }
#pragma unroll
    for (int j = 0; j < 8; ++j) { const int kd = rp + 4 * j;
#pragma unroll
        for (int i = 0; i < 4; ++i) scr[(4 * cg + i) * 33 + kd] = cvt_pk_bf16(v[2 * j][i], v[2 * j + 1][i]); }
    LDS_WAIT();
    const int kc = lane & 7;
#pragma unroll
    for (int jj = 0; jj < 8; ++jj) { const int n = (lane >> 3) + 8 * jj; const LAS unsigned* s = scr + n * 33 + 4 * kc;
        u32x4 o; o.x = s[0]; o.y = s[1]; o.z = s[2]; o.w = s[3];
        *(u32x4*)(dst + (size_t)(drow0 + n) * lddst + k0 + 8 * kc) = o; }
    LDS_WAIT();
}
__device__ __forceinline__ void cvt_item8(const float* src, int ldsrc, int k0, int c0, unsigned char* dst, int lddst, int drow0, float scale, LAS unsigned* scr, int lane) {
    const int cg = lane & 15, rp = lane >> 4;
    const float* sp = src + (size_t)k0 * ldsrc + c0 + 4 * cg;
    f32x4 v[16];
#pragma unroll
    for (int j = 0; j < 4; ++j)
#pragma unroll
        for (int q = 0; q < 4; ++q) v[4 * j + q] = *(const f32x4*)(sp + (size_t)(4 * (rp + 4 * j) + q) * ldsrc);
#pragma unroll
    for (int j = 0; j < 4; ++j) { const int kq = rp + 4 * j;
#pragma unroll
        for (int i = 0; i < 4; ++i) scr[(4 * cg + i) * 17 + kq] = pack4_fp8(v[4 * j][i] * scale, v[4 * j + 1][i] * scale, v[4 * j + 2][i] * scale, v[4 * j + 3][i] * scale); }
    LDS_WAIT();
    const int c4 = lane & 3;
#pragma unroll
    for (int jj = 0; jj < 4; ++jj) { const int n = (lane >> 2) + 16 * jj; const LAS unsigned* s = scr + n * 17 + 4 * c4;
        u32x4 o; o.x = s[0]; o.y = s[1]; o.z = s[2]; o.w = s[3];
        *(u32x4*)(dst + (size_t)(drow0 + n) * lddst + k0 + 16 * c4) = o; }
    LDS_WAIT();
}
__device__ __forceinline__ void p0_prologue(Frame& F) {
    F.retid();
    LAS unsigned* scr = (LAS unsigned*)(F.lds + F.wave * 8448);
    const int gw = F.vcu * NWAVES + F.wave, NGW = F.G * NWAVES;
    constexpr int I_IN0 = 16 * 40, I_OUT0 = 16 * 16, I_IN1 = 16 * 32, I_GT = 4 * 4 * 8, I_OUT1 = 16 * 16, I_W13 = 32 * 16 * 32, I_W2 = 32 * 16 * 16;
    constexpr int NITEMS = I_IN0 + I_OUT0 + I_IN1 + I_GT + I_OUT1 + I_W13 + I_W2;
    for (int it = gw; it < NITEMS; it += NGW) {
        int r = it; const float* src; int ldsrc, k0, sc, lddst, drow0; unsigned char* dst; bool q8 = false; float scale = 1.f;
        if (r < I_IN0) { const int kb = r / 40, db = r % 40, p = db >> 2, q = db & 3;
            if (p < 4) sc = (q < 2) ? 128 * p + 64 * q : 512 + 128 * p + 64 * (q - 2);
            else if (p < 8) sc = (q < 2) ? 1536 + 128 * (p - 4) + 64 * q : 2048 + 128 * (p - 4) + 64 * (q - 2);
            else sc = 1024 + 256 * (p - 8) + 64 * q;
            src = F.I(5); ldsrc = DIN0; k0 = 64 * kb; dst = F.W<unsigned char>(WS_WIN0); lddst = D; drow0 = 64 * db; }
        else if ((r -= I_IN0) < I_OUT0) { const int kb = r / 16, db = r % 16; src = F.I(11); ldsrc = D; k0 = 64 * kb; sc = 64 * db; dst = F.W<unsigned char>(WS_WOUT0); lddst = D; drow0 = 64 * db; }
        else if ((r -= I_OUT0) < I_IN1) { const int kb = r / 32, db = r % 32; src = F.I(12); ldsrc = 2 * DRNN; k0 = 64 * kb; sc = 64 * db; dst = F.W<unsigned char>(WS_WIN1); lddst = D; drow0 = 64 * db; }
        else if ((r -= I_IN1) < I_GT) { const int h = r / 32, r2 = r % 32, kb = r2 / 8, db = r2 % 8, p = db >> 2, q = db & 3;
            src = (q < 2 ? F.I(15) : F.I(17)) + (size_t)h * RBLK * RBLK; ldsrc = RBLK; k0 = 64 * kb; sc = 128 * p + 64 * (q & 1); dst = F.W<unsigned char>(WS_WGT) + (size_t)h * 512 * RBLK * 2; lddst = RBLK; drow0 = 64 * db; }
        else if ((r -= I_GT) < I_OUT1) { const int kb = r / 16, db = r % 16; src = F.I(20); ldsrc = D; k0 = 64 * kb; sc = 64 * db; dst = F.W<unsigned char>(WS_WOUT1); lddst = DRNN; drow0 = 64 * db; }
        else if ((r -= I_OUT1) < I_W13) { const int le = r / 512, r2 = r % 512, kb = r2 / 32, db = r2 % 32, p = db >> 2, q = db & 3;
            src = (q < 2 ? F.I(23) : F.I(24)) + (size_t)le * D * DEXP; ldsrc = DEXP; k0 = 64 * kb; sc = 128 * p + 64 * (q & 1); lddst = D; drow0 = 64 * db;
            q8 = MOE_FP8; scale = (float)(1 << SCL_W13); dst = F.W<unsigned char>(WS_W13) + (size_t)le * 2 * DEXP * D * (MOE_FP8 ? 1 : 2); }
        else { r -= I_W13; const int le = r / 256, r2 = r % 256, kb = r2 / 16, db = r2 % 16;
            src = F.I(25) + (size_t)le * DEXP * D; ldsrc = D; k0 = 64 * kb; sc = 64 * db; lddst = DEXP; drow0 = 64 * db;
            q8 = MOE_FP8; scale = (float)(1 << SCL_W2); dst = F.W<unsigned char>(WS_W2) + (size_t)le * D * DEXP * (MOE_FP8 ? 1 : 2); }
        if (q8) cvt_item8(src, ldsrc, k0, sc, dst, lddst, drow0, scale, scr, F.lane);
        else cvt_item(src, ldsrc, k0, sc, (bf16_t*)dst, lddst, drow0, scr, F.lane);
    }
    { const float* x = F.I(0); bf16_t* xb = F.W<bf16_t>(WS_X2); const size_t n8 = (size_t)T * D / 8, stride = (size_t)F.G * NTHREADS;
      for (size_t i = (size_t)F.vcu * NTHREADS + F.tid; i < n8; i += stride) { const f32x4 a = *(const f32x4*)(x + i * 8), b = *(const f32x4*)(x + i * 8 + 4); *(u32x4*)(xb + i * 8) = pg8::pack8(a, b); } }
    { const int i = F.vcu * NTHREADS + F.tid; if (i < DRNN) F.W<float>(WS_SPL)[i] = 8.0f * log1pf(expf(-F.I(19)[i])); }
}

struct DenseOrder {
    const char* A; const char* B; size_t a_tile, b_tile; int nM, nN, G, c;
    __device__ __forceinline__ bool next(int i, pg8::Unit& u) const { int pm, pn; if (!pg8::tile_of(i, G, c, nM, nN, pm, pn)) return false;
        u.A = A + (size_t)pm * a_tile; u.B = B + (size_t)pn * b_tile; u.row0 = pm * 256; u.pn = pn; u.e = 0; u.gtab = 0; return true; }
};
struct GatesOrder {
    const char* XC; const char* WG; int G, c;
    __device__ __forceinline__ bool next(int i, pg8::Unit& u) const { int pm, pn; if (!pg8::tile_of(i, G, c, T / 256, 2 * RHEADS, pm, pn)) return false;
        u.A = XC + (size_t)pm * 256 * DRNN * 2 + (size_t)(pn >> 1) * RBLK * 2; u.B = WG + (size_t)pn * 256 * RBLK * 2; u.row0 = pm * 256; u.pn = pn; u.e = 0; u.gtab = 0; return true; }
};
struct MoeOrder { LAS const int* units; int nu; const char* A; const char* B; size_t b_exp, b_tile, a_tile; bool gather;
    __device__ __forceinline__ bool next(int i, pg8::Unit& u) const { if (i >= nu) return false;
        const int e = __builtin_amdgcn_readfirstlane(units[4 * i]), pm = __builtin_amdgcn_readfirstlane(units[4 * i + 1]), pn = __builtin_amdgcn_readfirstlane(units[4 * i + 2]);
        u.A = gather ? A : A + (size_t)pm * a_tile; u.B = B + (size_t)e * b_exp + (size_t)pn * b_tile; u.row0 = pm * 256; u.pn = pn; u.e = e; u.gtab = GTAB_OFF + i * 1024; return true; }
};
__device__ __forceinline__ int moe_setup(Frame& F, int layer, int nN, bool gather, unsigned rowbytes) {
    F.retid();
    LAS int* meta = (LAS int*)(F.lds + MOEMETA_OFF); LAS int* units = (LAS int*)(F.lds + UNITS_OFF); LAS unsigned* gtab = (LAS unsigned*)(F.lds + GTAB_OFF);
    const unsigned* gcount = F.ctl() + CW_GCOUNT + 32 * layer;
    if (F.tid < NE) meta[17 + F.tid] = (int)__hip_atomic_load(gcount + F.tid, RLX_AGENT);
    __syncthreads();
    if (F.tid == 0) { int acc = 0; for (int e = 0; e < NE; ++e) { meta[e] = acc; acc += (meta[17 + e] + 255) >> 8; } meta[NE] = acc; }
    __syncthreads();
    const int nM = meta[NE]; int nu = 0;
    for (int i = 0; i < MAX_UNITS; ++i) { int pm, pn; if (!pg8::tile_of(i, F.G, (int)blockIdx.x, nM, nN, pm, pn)) break;
        int e = 0;
#pragma unroll
        for (int j = 1; j < NE; ++j) e += (meta[j] <= pm) ? 1 : 0;
        if (F.tid == 0) { units[4 * i] = e; units[4 * i + 1] = pm; units[4 * i + 2] = pn; units[4 * i + 3] = 0; }
        if (gather && F.tid < 256) { const int idx = (pm - meta[e]) * 256 + F.tid; const int cnt = meta[17 + e];
            const int tok = idx < cnt ? F.W<int>(WS_LIST)[e * T + idx] : 0; gtab[i * 256 + F.tid] = (unsigned)tok * rowbytes; }
        nu = i + 1; }
    __syncthreads();
    return nu;
}

__device__ __forceinline__ void p_mix0(Frame& F) {
    F.retid();
    LAS float* wA = (LAS float*)F.lds;
    LAS float* wB = wA + CONVA * DA;
    LAS float* pb = wB + CONVB * DB;
    for (int i = F.tid; i < CONVA * DA; i += NTHREADS) wA[i] = F.I(6)[i];
    for (int i = F.tid; i < CONVB * DB; i += NTHREADS) wB[i] = F.I(10)[i];
    for (int i = F.tid; i < DA; i += NTHREADS) { pb[i] = F.I(7)[i]; pb[DA + i] = F.I(8)[i]; pb[2 * DA + i] = F.I(9)[i]; }
    __syncthreads();
    const bf16_t* U0 = F.W<bf16_t>(WS_U0); bf16_t* CAT = F.W<bf16_t>(WS_CAT0);
    const int c0 = 8 * F.lane;
    for (int tb = F.vcu * NWAVES + F.wave; tb < T / 8; tb += F.G * NWAVES) {
        for (int i = 0; i < 8; ++i) { const int t = tb * 8 + i, s = t & (SEQ - 1);
            float acc[8];
#pragma unroll
            for (int j = 0; j < 8; ++j) acc[j] = pb[c0 + j];
#pragma unroll 1
            for (int kc = 0; kc < 4; ++kc) {
#pragma unroll
                for (int kk = 0; kk < 8; ++kk) { const int k = kc * 8 + kk, kq = k < CONVA ? k : CONVA - 1; const int d = CONVA - 1 - kq; const bool ok = (k < CONVA) && (s >= d); const size_t rr = ok ? (size_t)(t - d) : (size_t)t;
                    const u32x4 w = *(const u32x4*)(U0 + rr * 1536 + c0); const f32x4 w0 = *(const LAS f32x4*)(wA + kq * DA + c0), w1 = *(const LAS f32x4*)(wA + kq * DA + c0 + 4);
                    const float m = ok ? 1.f : 0.f;
                    acc[0] += m * w0[0] * bf_lo(w.x); acc[1] += m * w0[1] * bf_hi(w.x); acc[2] += m * w0[2] * bf_lo(w.y); acc[3] += m * w0[3] * bf_hi(w.y);
                    acc[4] += m * w1[0] * bf_lo(w.z); acc[5] += m * w1[1] * bf_hi(w.z); acc[6] += m * w1[2] * bf_lo(w.w); acc[7] += m * w1[3] * bf_hi(w.w); }
            }
            float sm = 0.f;
#pragma unroll
            for (int j = 0; j < 8; ++j) sm += acc[j];
            const float mean = wave_sum(sm) * (1.0f / DA); float q = 0.f;
#pragma unroll
            for (int j = 0; j < 8; ++j) { acc[j] -= mean; q += acc[j] * acc[j]; }
            const float rstd = 1.0f / sqrtf(wave_sum(q) * (1.0f / DA) + LN_EPS);
            f32x4 o0, o1;
#pragma unroll
            for (int j = 0; j < 4; ++j) { o0[j] = fsilu(acc[j] * rstd * pb[DA + c0 + j] + pb[2 * DA + c0 + j]); o1[j] = fsilu(acc[4 + j] * rstd * pb[DA + c0 + 4 + j] + pb[2 * DA + c0 + 4 + j]); }
            *(u32x4*)(CAT + (size_t)t * D + c0) = pg8::pack8(o0, o1);
            float cb[8];
#pragma unroll
            for (int j = 0; j < 8; ++j) cb[j] = 0.f;
#pragma unroll
            for (int k = 0; k < CONVB; ++k) { const int d = CONVB - 1 - k; const bool ok = s >= d; const size_t rr = ok ? (size_t)(t - d) : (size_t)t;
                const u32x4 w = *(const u32x4*)(U0 + rr * 1536 + 512 + c0); const f32x4 w0 = *(const LAS f32x4*)(wB + k * DB + c0), w1 = *(const LAS f32x4*)(wB + k * DB + c0 + 4);
                const float m = ok ? 1.f : 0.f;
                cb[0] += m * w0[0] * bf_lo(w.x); cb[1] += m * w0[1] * bf_hi(w.x); cb[2] += m * w0[2] * bf_lo(w.y); cb[3] += m * w0[3] * bf_hi(w.y);
                cb[4] += m * w1[0] * bf_lo(w.z); cb[5] += m * w1[1] * bf_hi(w.z); cb[6] += m * w1[2] * bf_lo(w.w); cb[7] += m * w1[3] * bf_hi(w.w); }
            const u32x4 bw = *(const u32x4*)(U0 + (size_t)t * 1536 + 1024 + c0);
            const f32x4 p0 = {bf_lo(bw.x) * cb[0], bf_hi(bw.x) * cb[1], bf_lo(bw.y) * cb[2], bf_hi(bw.y) * cb[3]}, p1 = {bf_lo(bw.z) * cb[4], bf_hi(bw.z) * cb[5], bf_lo(bw.w) * cb[6], bf_hi(bw.w) * cb[7]};
            *(u32x4*)(CAT + (size_t)t * D + 512 + c0) = pg8::pack8(p0, p1);
        }
    }
    __syncthreads();
}

__device__ __forceinline__ void route16(const float (&l)[NE], int& e1, int& e2, float& g1, float& g2) {
    float mx = l[0];
#pragma unroll
    for (int e = 1; e < NE; ++e) mx = fmaxf(mx, l[e]);
    float p[NE];
#pragma unroll
    for (int e = 0; e < NE; ++e) p[e] = __expf(l[e] - mx);
    int gsel = 0; float best = -1.f, bq0 = 0.f, bq1 = 0.f, bq2 = 0.f, bq3 = 0.f;
#pragma unroll
    for (int g = 0; g < NG; ++g) { float m1 = -1.f, m2 = -1.f;
#pragma unroll
        for (int j = 0; j < EPG; ++j) { const float v = p[g * EPG + j]; if (v > m1) { m2 = m1; m1 = v; } else if (v > m2) m2 = v; }
        const float sc = m1 + m2; if (sc > best) { best = sc; gsel = g; bq0 = p[g * EPG]; bq1 = p[g * EPG + 1]; bq2 = p[g * EPG + 2]; bq3 = p[g * EPG + 3]; } }
    int i1 = 0; float p1 = bq0;
    if (bq1 > p1) { p1 = bq1; i1 = 1; } if (bq2 > p1) { p1 = bq2; i1 = 2; } if (bq3 > p1) { p1 = bq3; i1 = 3; }
    int i2 = -1; float p2 = -1.f;
    if (i1 != 0 && bq0 > p2) { p2 = bq0; i2 = 0; } if (i1 != 1 && bq1 > p2) { p2 = bq1; i2 = 1; } if (i1 != 2 && bq2 > p2) { p2 = bq2; i2 = 2; } if (i1 != 3 && bq3 > p2) { p2 = bq3; i2 = 3; }
    e1 = gsel * EPG + i1; e2 = gsel * EPG + i2; const float inv = 1.0f / (p1 + p2); g1 = p1 * inv; g2 = p2 * inv;
}
__device__ __forceinline__ void p_ln1_route(Frame& F, int layer, const float* YPRE, bool dummy = false) {
    F.retid();
    LAS float* wrT = (LAS float*)F.lds;
    LAS int* rt = (LAS int*)(F.lds + 65536);
    LAS int* re = rt; LAS int* rlp = rt + 128; LAS float* rg = (LAS float*)(rt + 256); LAS int* lcount = rt + 384; LAS int* gbase = rt + 400;
    { const float* wr = F.I(21);
      for (int idx = F.tid; idx < D * NE / 4; idx += NTHREADS) { const f32x4 v = *(const f32x4*)(wr + idx * 4); const int c = idx >> 2, e4 = (idx & 3) * 4;
          wrT[(e4 + 0) * D + c] = v[0]; wrT[(e4 + 1) * D + c] = v[1]; wrT[(e4 + 2) * D + c] = v[2]; wrT[(e4 + 3) * D + c] = v[3]; } }
    const float* g1p = F.I(1) + layer * D; const float* b1p = F.I(2) + layer * D; const float* br = F.I(22);
    bf16_t* X1 = F.W<bf16_t>(WS_X1); unsigned* gcount = F.ctl() + CW_GCOUNT + 32 * layer + (dummy ? 16 : 0);
    int* LIST = F.W<int>(WS_LIST); int* TOKSLOT = F.W<int>(WS_TOKSLOT); float* TOKGATE = F.W<float>(WS_TOKGATE); unsigned char* X1Q = F.W<unsigned char>(WS_X1Q); (void)X1Q;
    const int lane = F.lane;
    for (int tb = F.vcu; tb < T / 64; tb += F.G) {
        if (F.tid < NE) lcount[F.tid] = 0;
        __syncthreads();
        const int tok0 = tb * 64;
        f32x4 xn[4];
        { const float* yr = YPRE + (size_t)(tok0 + F.wave * 8) * D + 4 * lane;
#pragma unroll
          for (int j = 0; j < 4; ++j) xn[j] = *(const f32x4*)(yr + 256 * j); }
#pragma unroll 1
        for (int r = 0; r < 8; ++r) {
            const int rl = F.wave * 8 + r;
            f32x4 x[4]; float lg[NE];
#pragma unroll
            for (int j = 0; j < 4; ++j) x[j] = xn[j];
            if (r < 7) { const float* yr = YPRE + (size_t)(tok0 + rl + 1) * D + 4 * lane;
#pragma unroll
                for (int j = 0; j < 4; ++j) xn[j] = *(const f32x4*)(yr + 256 * j); }
            float s = 0.f;
#pragma unroll
            for (int j = 0; j < 4; ++j) s += (x[j][0] + x[j][1]) + (x[j][2] + x[j][3]);
            const float mean = wave_sum(s) * (1.0f / D); float q = 0.f;
#pragma unroll
            for (int j = 0; j < 4; ++j) { x[j] = x[j] - mean; q += (x[j][0] * x[j][0] + x[j][1] * x[j][1]) + (x[j][2] * x[j][2] + x[j][3] * x[j][3]); }
            const float rstd = 1.0f / sqrtf(wave_sum(q) * (1.0f / D) + LN_EPS);
#pragma unroll
            for (int j = 0; j < 4; ++j) { const f32x4 gg = *(const f32x4*)(g1p + 256 * j + 4 * lane), bb = *(const f32x4*)(b1p + 256 * j + 4 * lane);
                x[j] = x[j] * rstd * gg + bb;
                u32x2 w; w.x = cvt_pk_bf16(x[j][0], x[j][1]); w.y = cvt_pk_bf16(x[j][2], x[j][3]);
                *(u32x2*)(X1 + (size_t)(tok0 + rl) * D + 256 * j + 4 * lane) = w;
#if MOE_FP8
                *(unsigned*)(X1Q + (size_t)(tok0 + rl) * D + 256 * j + 4 * lane) = pack4_fp8(x[j][0], x[j][1], x[j][2], x[j][3]);
#endif
            }
#pragma unroll
            for (int e = 0; e < NE; ++e) { float a = 0.f;
#pragma unroll
                for (int j = 0; j < 4; ++j) { const f32x4 w = *(const LAS f32x4*)(wrT + e * D + 256 * j + 4 * lane);
                    a += (x[j][0] * w[0] + x[j][1] * w[1]) + (x[j][2] * w[2] + x[j][3] * w[3]); }
                lg[e] = a; }
            float a8[8], a4[4], a2[2], a1;
#pragma unroll
            for (int i = 0; i < 8; ++i) { const bool hi = lane & 1; const float send = hi ? lg[2 * i] : lg[2 * i + 1], keep = hi ? lg[2 * i + 1] : lg[2 * i]; a8[i] = keep + dpp_xor1(send); }
#pragma unroll
            for (int i = 0; i < 4; ++i) { const bool hi = lane & 2; const float send = hi ? a8[2 * i] : a8[2 * i + 1], keep = hi ? a8[2 * i + 1] : a8[2 * i]; a4[i] = keep + dpp_xor2(send); }
#pragma unroll
            for (int i = 0; i < 2; ++i) { const bool hi = lane & 4; const float send = hi ? a4[2 * i] : a4[2 * i + 1], keep = hi ? a4[2 * i + 1] : a4[2 * i]; a2[i] = keep + swz_xor<4>(send); }
            { const bool hi = lane & 8; const float send = hi ? a2[0] : a2[1], keep = hi ? a2[1] : a2[0]; a1 = keep + swz_xor<8>(send); }
            a1 += swz_xor<16>(a1); a1 = half_sum(a1);
            float l[NE];
#pragma unroll
            for (int e = 0; e < NE; ++e) l[e] = __int_as_float(__builtin_amdgcn_readlane(__float_as_int(a1), e)) + br[e];
            int e1, e2; float g1, g2; route16(l, e1, e2, g1, g2);
            if (lane == 0) {
                const int lp1 = __hip_atomic_fetch_add(lcount + e1, 1, __ATOMIC_RELAXED, __HIP_MEMORY_SCOPE_WORKGROUP), lp2 = __hip_atomic_fetch_add(lcount + e2, 1, __ATOMIC_RELAXED, __HIP_MEMORY_SCOPE_WORKGROUP);
                re[2 * rl] = e1; re[2 * rl + 1] = e2; rlp[2 * rl] = lp1; rlp[2 * rl + 1] = lp2; rg[2 * rl] = g1; rg[2 * rl + 1] = g2; }
        }
        __syncthreads();
        if (F.tid < NE) gbase[F.tid] = (int)__hip_atomic_fetch_add(gcount + F.tid, (unsigned)lcount[F.tid], RLX_AGENT);
        __syncthreads();
        if (F.tid < 128) { const int e = re[F.tid], pos = gbase[e] + rlp[F.tid], tok = tok0 + (F.tid >> 1);
            LIST[e * T + pos] = tok; TOKSLOT[tok * 2 + (F.tid & 1)] = e * T + pos; TOKGATE[tok * 2 + (F.tid & 1)] = rg[F.tid]; }
        __syncthreads();
    }
}

__device__ __forceinline__ void p_combine(Frame& F, int layer) {
    F.retid();
    const unsigned* gcount = F.ctl() + CW_GCOUNT + 32 * layer;
    const int lane = F.lane;
    int pre = 0;
#pragma unroll
    for (int j = 0; j < NE - 1; ++j) { const int cnt = (int)__builtin_amdgcn_readfirstlane(__hip_atomic_load(gcount + j, RLX_AGENT)); pre += ((lane & 15) > j) ? ((cnt + 255) >> 8) * 256 : 0; }
    const bf16_t* X1 = F.W<bf16_t>(WS_X1); const bf16_t* Y = F.W<bf16_t>(WS_Y); const int* TOKSLOT = F.W<int>(WS_TOKSLOT); const float* TOKGATE = F.W<float>(WS_TOKGATE);
    const float* g2p = F.I(3) + layer * D; const float* b2p = F.I(4) + layer * D;
    bf16_t* X2 = F.W<bf16_t>(WS_X2);
    for (int tb = F.vcu * NWAVES + F.wave; tb < T / 8; tb += F.G * NWAVES) {
#pragma unroll 2
        for (int i = 0; i < 8; ++i) { const int t = tb * 8 + i;
            const int s0 = __builtin_amdgcn_readfirstlane(TOKSLOT[2 * t]), s1 = __builtin_amdgcn_readfirstlane(TOKSLOT[2 * t + 1]);
            const float g0 = TOKGATE[2 * t], g1 = TOKGATE[2 * t + 1];
            const int r0 = __builtin_amdgcn_readlane(pre, s0 >> 14) + (s0 & (T - 1)), r1 = __builtin_amdgcn_readlane(pre, s1 >> 14) + (s1 & (T - 1));
            f32x4 v[4]; float s = 0.f;
#pragma unroll
            for (int j = 0; j < 4; ++j) { const u32x2 xw = *(const u32x2*)(X1 + (size_t)t * D + 256 * j + 4 * lane), y0 = *(const u32x2*)(Y + (size_t)r0 * D + 256 * j + 4 * lane), y1 = *(const u32x2*)(Y + (size_t)r1 * D + 256 * j + 4 * lane);
                v[j][0] = ALPHA * bf_lo(xw.x) + (g0 * bf_lo(y0.x) + g1 * bf_lo(y1.x)); v[j][1] = ALPHA * bf_hi(xw.x) + (g0 * bf_hi(y0.x) + g1 * bf_hi(y1.x));
                v[j][2] = ALPHA * bf_lo(xw.y) + (g0 * bf_lo(y0.y) + g1 * bf_lo(y1.y)); v[j][3] = ALPHA * bf_hi(xw.y) + (g0 * bf_hi(y0.y) + g1 * bf_hi(y1.y));
                s += (v[j][0] + v[j][1]) + (v[j][2] + v[j][3]); }
            const float mean = wave_sum(s) * (1.0f / D); float q = 0.f;
#pragma unroll
            for (int j = 0; j < 4; ++j) { v[j] = v[j] - mean; q += (v[j][0] * v[j][0] + v[j][1] * v[j][1]) + (v[j][2] * v[j][2] + v[j][3] * v[j][3]); }
            const float rstd = 1.0f / sqrtf(wave_sum(q) * (1.0f / D) + LN_EPS);
#pragma unroll
            for (int j = 0; j < 4; ++j) { const f32x4 gg = *(const f32x4*)(g2p + 256 * j + 4 * lane), bb = *(const f32x4*)(b2p + 256 * j + 4 * lane); const f32x4 o = v[j] * rstd * gg + bb;
                if (layer == 0) { u32x2 w; w.x = cvt_pk_bf16(o[0], o[1]); w.y = cvt_pk_bf16(o[2], o[3]); *(u32x2*)(X2 + (size_t)t * D + 256 * j + 4 * lane) = w; }
                else *(f32x4*)(F.out + (size_t)t * D + 256 * j + 4 * lane) = o; }
        }
    }
}

__device__ __forceinline__ void p_conv4(Frame& F) {
    F.retid();
    const bf16_t* XR = F.W<bf16_t>(WS_XR); bf16_t* XC = F.W<bf16_t>(WS_XC); const float* w = F.I(13); const float* bias = F.I(14);
    const int lane = F.lane;
    f32x4 wk[2][CONVC][2], bs[2][2];
#pragma unroll
    for (int hh = 0; hh < 2; ++hh) { const int c0 = 8 * lane + 512 * hh;
#pragma unroll
        for (int k = 0; k < CONVC; ++k) { wk[hh][k][0] = *(const f32x4*)(w + k * DRNN + c0); wk[hh][k][1] = *(const f32x4*)(w + k * DRNN + c0 + 4); }
        bs[hh][0] = *(const f32x4*)(bias + c0); bs[hh][1] = *(const f32x4*)(bias + c0 + 4); }
    for (int tb = F.vcu * NWAVES + F.wave; tb < T / 8; tb += F.G * NWAVES) {
#pragma unroll 2
        for (int i = 0; i < 8; ++i) { const int t = tb * 8 + i, s = t & (SEQ - 1);
#pragma unroll
            for (int hh = 0; hh < 2; ++hh) { const int c0 = 8 * lane + 512 * hh; f32x4 a0 = bs[hh][0], a1 = bs[hh][1];
#pragma unroll
                for (int k = 0; k < CONVC; ++k) { const int d = CONVC - 1 - k; const bool ok = s >= d; const size_t rr = ok ? (size_t)(t - d) : (size_t)t; const float m = ok ? 1.f : 0.f;
                    const u32x4 xw = *(const u32x4*)(XR + rr * DRNN + c0);
                    const f32x4 x0 = {bf_lo(xw.x), bf_hi(xw.x), bf_lo(xw.y), bf_hi(xw.y)}, x1 = {bf_lo(xw.z), bf_hi(xw.z), bf_lo(xw.w), bf_hi(xw.w)};
                    a0 += (wk[hh][k][0] * m) * x0; a1 += (wk[hh][k][1] * m) * x1; }
                *(u32x4*)(XC + (size_t)t * DRNN + c0) = pg8::pack8(a0, a1); }
        }
    }
}

constexpr int SCH = 64, NCHUNK = SEQ / SCH;
__device__ __forceinline__ void p_scan1(Frame& F) {
    F.retid();
    const bf16_t* L2A = F.W<bf16_t>(WS_XR); const bf16_t* BV = F.W<bf16_t>(WS_BV); float* AGG = F.W<float>(WS_AGG);
    for (int task = F.vcu * NWAVES + F.wave; task < BATCH * NCHUNK * 8; task += F.G * NWAVES) {
        const int bc = task >> 3, c = (task & 7) * 128 + 2 * F.lane; const size_t base = (size_t)bc * SCH * DRNN + c;
        float sl0 = 0.f, sl1 = 0.f, h0 = 0.f, h1 = 0.f;
#pragma unroll 16
        for (int s = 0; s < SCH; ++s) { const unsigned lw = *(const unsigned*)(L2A + base + (size_t)s * DRNN), bw = *(const unsigned*)(BV + base + (size_t)s * DRNN);
            const float l0 = bf_lo(lw), l1 = bf_hi(lw); sl0 += l0; sl1 += l1;
            h0 = __builtin_amdgcn_exp2f(l0) * h0 + bf_lo(bw); h1 = __builtin_amdgcn_exp2f(l1) * h1 + bf_hi(bw); }
        *(f32x4*)(AGG + ((size_t)bc * DRNN + c) * 2) = (f32x4){sl0, h0, sl1, h1};
    }
}
__device__ __forceinline__ void p_scan2(Frame& F, bool dummy = false) {
    F.retid();
    const bf16_t* L2A = F.W<bf16_t>(WS_XR); const bf16_t* BV = F.W<bf16_t>(WS_BV); const float* AGG = F.W<float>(WS_AGG); bf16_t* GY = F.W<bf16_t>(WS_GY); bf16_t* OUTB = dummy ? F.W<bf16_t>(WS_XC) : GY;
    for (int task = F.vcu * NWAVES + F.wave; task < BATCH * NCHUNK * 8; task += F.G * NWAVES) {
        const int bc = task >> 3, c = (task & 7) * 128 + 2 * F.lane; const int b = bc / NCHUNK, ch = bc % NCHUNK;
        float h0 = 0.f, h1 = 0.f;
#pragma unroll 8
        for (int j = 0; j < ch; ++j) { const f32x4 g = *(const f32x4*)(AGG + ((size_t)(b * NCHUNK + j) * DRNN + c) * 2);
            h0 = __builtin_amdgcn_exp2f(g[0]) * h0 + g[1]; h1 = __builtin_amdgcn_exp2f(g[2]) * h1 + g[3]; }
        const size_t base = (size_t)bc * SCH * DRNN + c;
#pragma unroll 16
        for (int s = 0; s < SCH; ++s) { const size_t o = base + (size_t)s * DRNN; const unsigned lw = *(const unsigned*)(L2A + o), bw = *(const unsigned*)(BV + o), gw = *(const unsigned*)(GY + o);
            h0 = __builtin_amdgcn_exp2f(bf_lo(lw)) * h0 + bf_lo(bw); h1 = __builtin_amdgcn_exp2f(bf_hi(lw)) * h1 + bf_hi(bw);
            *(unsigned*)(OUTB + o) = cvt_pk_bf16(bf_lo(gw) * h0, bf_hi(gw) * h1); }
    }
}

constexpr int NPH = 18;
#ifndef N_LAUNCHES
#define N_LAUNCHES 1
#endif
__global__ void __launch_bounds__(NTHREADS, 2) mega_fwd(Args args) {
    extern __shared__ __attribute__((aligned(16))) unsigned char lds_raw[];
    Frame F;
    F.lds = (LAS unsigned char*)lds_raw; F.ws = args.ws; F.in = args.in; F.out = args.out;
    F.tid = threadIdx.x; F.lane = F.tid & 63; F.wave = __builtin_amdgcn_readfirstlane(F.tid >> 6);
    F.G = gridDim.x; { const int bx = blockIdx.x; F.vcu = (F.G % 8 == 0) ? (bx % 8) * (F.G / 8) + bx / 8 : bx; }
    for (int u = F.tid; u < (LDS_BYTES - LDSCTL_OFF) / 4; u += NTHREADS) ((LAS unsigned*)(F.lds + LDSCTL_OFF))[u] = 0u;
    __syncthreads();
    XcdBarrier bar; bar.bar = F.ctl() + CW_BAR; bar.x = 0; bar.st = nullptr; bar.wave = F.wave;
    if (N_LAUNCHES == 1) bar = xcd_barrier_post(F.ctl() + CW_BAR, (volatile LAS unsigned*)(F.lds + MISC_OFF) + 8, F.wave);
    const int lo = args.ph_lo, hi = args.ph_hi;
#ifndef PH_MASK
#define PH_MASK 0x3ffff
#endif
#define IN(k) (((PH_MASK >> (k)) & 1) && lo <= (k) && (k) < hi)
#define SEAM(k) do { if (IN(k) && IN((k) + 1)) xcd_barrier(bar); } while (0)
    const int cblk = (int)blockIdx.x;

#ifndef REP_MASK
#define REP_MASK 0
#endif
#ifndef EXTRA_BARS
#define EXTRA_BARS 0
#endif
#define REPS(k) ((((REP_MASK) >> ((k) % 32)) & 1) ? 2 : 1)
#define PHASE(k, ...) do { if (IN(k)) { for (int rep_ = 0; rep_ < REPS(k); ++rep_) { __VA_ARGS__; if (rep_ + 1 < REPS(k)) xcd_barrier(bar); } } SEAM(k); } while (0)
    for (int i = 0; i < EXTRA_BARS; ++i) xcd_barrier(bar);
    PHASE(0, p0_prologue(F));
    PHASE(1, { DenseOrder S{F.W<char>(WS_X2), F.W<char>(WS_WIN0), (size_t)256 * D * 2, (size_t)256 * D * 2, T / 256, DIN0 / 256, F.G, cblk};
        pg8::EpiIn0 E{F.W<bf16_t>(WS_U0)}; pg8::gemm_phase<pg8::EpiIn0, DenseOrder, false>(F.lds, F.wave, 2 * D, 2 * D, 2 * D, S, E); });
    PHASE(2, p_mix0(F));
    PHASE(3, { DenseOrder S{F.W<char>(WS_CAT0), F.W<char>(WS_WOUT0), (size_t)256 * D * 2, (size_t)256 * D * 2, T / 256, D / 256, F.G, cblk};
        pg8::EpiRes<false> E{F.I(0), F.W<float>(WS_YPRE0)}; pg8::gemm_phase<pg8::EpiRes<false>, DenseOrder, false>(F.lds, F.wave, 2 * D, 2 * D, 2 * D, S, E); });
    PHASE(4, p_ln1_route(F, 0, F.W<float>(WS_YPRE0), rep_ + 1 < REPS(4)));
#pragma unroll 1
    for (int layer = 0; layer < 2; ++layer) {
        const int pb = layer == 0 ? 5 : 15;
#if MOE_FP8
        PHASE(pb, { const int nu = moe_setup(F, layer, 2 * DEXP / 256, true, D);
            MoeOrder S{(LAS const int*)(F.lds + UNITS_OFF), nu, F.W<char>(WS_X1Q), F.W<char>(WS_W13) + (size_t)layer * NE * 2 * DEXP * D, (size_t)2 * DEXP * D, (size_t)256 * D, 0, true};
            pg8::EpiMoe1Q E{F.W<unsigned char>(WS_H)}; pg8::gemm_phase<pg8::EpiMoe1Q, MoeOrder, true, 1>(F.lds, F.wave, D, D, D, S, E, 0x01010101 * (127 - SCL_W13 / 2)); });
        PHASE(pb + 1, { const int nu = moe_setup(F, layer, D / 256, false, 0);
            MoeOrder S{(LAS const int*)(F.lds + UNITS_OFF), nu, F.W<char>(WS_H), F.W<char>(WS_W2) + (size_t)layer * NE * D * DEXP, (size_t)D * DEXP, (size_t)256 * DEXP, (size_t)256 * DEXP, false};
            pg8::EpiMoe2 E{F.W<bf16_t>(WS_Y)}; pg8::gemm_phase<pg8::EpiMoe2, MoeOrder, false, 1>(F.lds, F.wave, DEXP, DEXP, DEXP, S, E, 0x01010101 * (127 - SCL_W2 / 2)); });
#else
        PHASE(pb, { const int nu = moe_setup(F, layer, 2 * DEXP / 256, true, 2 * D);
            MoeOrder S{(LAS const int*)(F.lds + UNITS_OFF), nu, F.W<char>(WS_X1), F.W<char>(WS_W13) + (size_t)layer * NE * 2 * DEXP * D * 2, (size_t)2 * DEXP * D * 2, (size_t)256 * D * 2, 0, true};
            pg8::EpiMoe1 E{F.W<bf16_t>(WS_H)}; pg8::gemm_phase<pg8::EpiMoe1, MoeOrder, true>(F.lds, F.wave, 2 * D, 2 * D, 2 * D, S, E); });
        PHASE(pb + 1, { const int nu = moe_setup(F, layer, D / 256, false, 0);
            MoeOrder S{(LAS const int*)(F.lds + UNITS_OFF), nu, F.W<char>(WS_H), F.W<char>(WS_W2) + (size_t)layer * NE * D * DEXP * 2, (size_t)D * DEXP * 2, (size_t)256 * DEXP * 2, (size_t)256 * DEXP * 2, false};
            pg8::EpiMoe2 E{F.W<bf16_t>(WS_Y)}; pg8::gemm_phase<pg8::EpiMoe2, MoeOrder, false>(F.lds, F.wave, 2 * DEXP, 2 * DEXP, 2 * DEXP, S, E); });
#endif
        PHASE(pb + 2, p_combine(F, layer));
        if (layer == 0) {
            PHASE(8, { DenseOrder S{F.W<char>(WS_X2), F.W<char>(WS_WIN1), (size_t)256 * D * 2, (size_t)256 * D * 2, T / 256, 2 * DRNN / 256, F.G, cblk};
                pg8::EpiIn1 E{F.W<bf16_t>(WS_GY), F.W<bf16_t>(WS_XR)}; pg8::gemm_phase<pg8::EpiIn1, DenseOrder, false>(F.lds, F.wave, 2 * D, 2 * D, 2 * D, S, E); });
            PHASE(9, p_conv4(F));
            PHASE(10, { GatesOrder S{F.W<char>(WS_XC), F.W<char>(WS_WGT), F.G, cblk};
                pg8::EpiGates E{F.W<bf16_t>(WS_XC), F.I(16), F.I(18), F.W<float>(WS_SPL), F.W<bf16_t>(WS_XR), F.W<bf16_t>(WS_BV)};
                pg8::gemm_phase<pg8::EpiGates, GatesOrder, false>(F.lds, F.wave, 2 * DRNN, 2 * RBLK, 2 * RBLK, S, E); });
            PHASE(11, p_scan1(F));
            PHASE(12, p_scan2(F, rep_ + 1 < REPS(12)));
            PHASE(13, { DenseOrder S{F.W<char>(WS_GY), F.W<char>(WS_WOUT1), (size_t)256 * DRNN * 2, (size_t)256 * DRNN * 2, T / 256, D / 256, F.G, cblk};
                pg8::EpiRes<true> E{F.W<bf16_t>(WS_X2), F.W<float>(WS_YPRE1)}; pg8::gemm_phase<pg8::EpiRes<true>, DenseOrder, false>(F.lds, F.wave, 2 * DRNN, 2 * DRNN, 2 * DRNN, S, E); });
            PHASE(14, p_ln1_route(F, 1, F.W<float>(WS_YPRE1), rep_ + 1 < REPS(14)));
        }
    }
#undef PHASE
#undef REPS
#undef IN
#undef SEAM
}

static int g_grid = 0;
static inline bool fast_setup() {
    if (g_grid == 0) {
        int dev = 0, cus = 0, per_cu = 0;
        if (hipGetDevice(&dev) != hipSuccess || hipDeviceGetAttribute(&cus, hipDeviceAttributeMultiprocessorCount, dev) != hipSuccess) { fprintf(stderr, "kernel_launch: device query failed\n"); g_grid = -1; return false; }
        if (hipFuncSetAttribute((const void*)mega_fwd, hipFuncAttributeMaxDynamicSharedMemorySize, LDS_BYTES) != hipSuccess) { fprintf(stderr, "kernel_launch: hipFuncSetAttribute failed\n"); g_grid = -1; return false; }
        if (hipOccupancyMaxActiveBlocksPerMultiprocessor(&per_cu, (const void*)mega_fwd, NTHREADS, LDS_BYTES) != hipSuccess || per_cu < 1) { fprintf(stderr, "kernel_launch: occupancy query says %d blocks per CU\n", per_cu); (void)hipGetLastError(); per_cu = 1; }
        g_grid = cus;
        if (g_grid > 256) g_grid = 256;
    }
    return g_grid > 0;
}
static inline void fast_launch(void* const* d_in, void* d_out, void* d_ws, hipStream_t stream, int lo, int hi) {
    Args a{};
    for (int i = 0; i < 26; ++i) a.in[i] = (const float*)d_in[i];
    a.out = (float*)d_out; a.ws = (unsigned char*)d_ws; a.ph_lo = lo; a.ph_hi = hi;
    hipLaunchKernelGGL(mega_fwd, dim3(g_grid), dim3(NTHREADS), LDS_BYTES, stream, a);
}
extern "C" void kernel_launch(void* const* d_in, const int* in_sizes, int n_in, void* d_out, int out_size, void* d_ws, size_t ws_size, hipStream_t stream) {
    if (n_in != 26 || out_size != T * D || ws_size < WS_FAST_END) { fprintf(stderr, "kernel_launch: unexpected shapes (n_in %d out %d ws %zu)\n", n_in, out_size, ws_size); return; }
    if (!fast_setup()) return;
    if (hipMemsetAsync((char*)d_ws + WS_CTL, 0, CTL_ZERO_BYTES, stream) != hipSuccess) { fprintf(stderr, "kernel_launch: memset failed\n"); return; }
    if (N_LAUNCHES == 1) fast_launch(d_in, d_out, d_ws, stream, 0, NPH);
    else for (int p = 0; p < NPH; ++p) fast_launch(d_in, d_out, d_ws, stream, p, p + 1);
}
```

```cpp
#define BUILD_MODE 1
#define N_LAUNCHES 1
#include <hip/hip_runtime.h>
#include <cstdio>
#include <cstdint>
#include <cmath>
constexpr int D = 1024, BATCH = 2, SEQ = 8192, T = BATCH * SEQ, DEPTH = 2;
constexpr int DA = 512, DB = 512, DIN0 = 2 * DA + 3 * DB, CONVA = 31, CONVB = 3;
constexpr int DRNN = 1024, RBLK = 256, RHEADS = 4, CONVC = 4;
constexpr int NE = 16, NG = 4, EPG = 4, DEXP = 1024;
constexpr float LN_EPS = 1e-5f, ALPHA = 1.41421356237309515f;
#define LAS __attribute__((address_space(3)))
#define GAS __attribute__((address_space(1)))
typedef unsigned short bf16_t;
typedef short bf16x8 __attribute__((ext_vector_type(8)));
typedef float f32x4 __attribute__((ext_vector_type(4)));
typedef float f32x2 __attribute__((ext_vector_type(2)));
typedef unsigned u32x4 __attribute__((ext_vector_type(4)));
typedef unsigned u32x2 __attribute__((ext_vector_type(2)));
typedef GAS unsigned gu32;
#define RLX_AGENT __ATOMIC_RELAXED, __HIP_MEMORY_SCOPE_AGENT
#define LDS_WAIT() asm volatile("s_waitcnt lgkmcnt(0)" ::: "memory")
#define VM_WAIT() asm volatile("s_waitcnt vmcnt(0)" ::: "memory")

__device__ __forceinline__ unsigned cvt_pk_bf16(float lo, float hi) { unsigned r; asm volatile("v_cvt_pk_bf16_f32 %0, %1, %2" : "=v"(r) : "v"(lo), "v"(hi)); return r; }
__device__ __forceinline__ unsigned pack4_fp8(float a, float b, float c, float d) { int r = __builtin_amdgcn_cvt_pk_fp8_f32(a, b, 0, false); r = __builtin_amdgcn_cvt_pk_fp8_f32(c, d, r, true); return (unsigned)r; }
__device__ __forceinline__ float bf_lo(unsigned u) { return __uint_as_float(u << 16); }
__device__ __forceinline__ float bf_hi(unsigned u) { return __uint_as_float(u & 0xffff0000u); }
__device__ __forceinline__ float fsigmoid(float x) { return __builtin_amdgcn_rcpf(1.0f + __builtin_amdgcn_exp2f(-1.4426950408889634f * x)); }
__device__ __forceinline__ float fsilu(float x) { return x * fsigmoid(x); }
__device__ __forceinline__ float fgelu_tanh(float x) { return x * fsigmoid(1.5957691216057308f * (x + 0.044715f * x * x * x)); }
__device__ __forceinline__ float dpp_xor1(float v) { return __int_as_float(__builtin_amdgcn_mov_dpp(__float_as_int(v), 0xB1, 0xF, 0xF, true)); }
__device__ __forceinline__ float dpp_xor2(float v) { return __int_as_float(__builtin_amdgcn_mov_dpp(__float_as_int(v), 0x4E, 0xF, 0xF, true)); }
template <int M> __device__ __forceinline__ float swz_xor(float v) { return __int_as_float(__builtin_amdgcn_ds_swizzle(__float_as_int(v), (M << 10) | 0x1F)); }
__device__ __forceinline__ float half_sum(float v) { const auto r = __builtin_amdgcn_permlane32_swap(__float_as_uint(v), __float_as_uint(v), false, false); return __uint_as_float(r[0]) + __uint_as_float(r[1]); }
__device__ __forceinline__ float wave_sum(float v) { v += dpp_xor1(v); v += dpp_xor2(v); v += swz_xor<4>(v); v += swz_xor<8>(v); v += swz_xor<16>(v); return half_sum(v); }
__device__ __forceinline__ int lane_id_asm() { int l; asm volatile("v_mbcnt_lo_u32_b32 %0, -1, 0\n\tv_mbcnt_hi_u32_b32 %0, -1, %0" : "=v"(l)); return l; }

namespace pg8 {
constexpr int BM = 256, BK = 64, HALF = 128, HTB = HALF * BK * 2, STAGE_BYTES = 8 * HTB, NXCD = 8, WGM = 8;
__host__ __device__ __forceinline__ int lds_byte(int r, int c) { const int st = (r >> 4) * 2 + (c >> 5), rr = r & 15, cc = c & 31, ob = rr * 64 + cc * 2; return st * 1024 + (ob ^ (((ob >> 9) & 1) << 5)); }
__host__ __device__ __forceinline__ void stage_rc(int b, int& R, int& C) { const int st = b / 1024, sb = b % 1024, swz = sb ^ (((sb >> 9) & 1) << 5); R = (st >> 1) * 16 + swz / 64; C = (st & 1) * 32 + (swz % 64) / 2; }
__host__ __device__ __forceinline__ int perm32(int rho) { const int n = rho >> 4, i = rho & 15; return 8 * (i >> 2) + 4 * n + (i & 3); }

struct Unit { const char* A; const char* B; int row0, pn, e, gtab; };
__device__ __forceinline__ bool tile_of(int i, int G, int c, int nM, int nN, int& pm, int& pn) {
    const int nwg = nM * nN; const long L = (long)i * G + c; if (L >= nwg) return false;
    int wgid = (int)L; { const int q = nwg / NXCD, r = nwg % NXCD, xcd = wgid % NXCD, off = wgid / NXCD; wgid = (xcd < r ? xcd * (q + 1) : r * (q + 1) + (xcd - r) * q) + off; }
    const int nig = WGM * nN, gid = wgid / nig, fm = gid * WGM, gsz = (nM - fm) < WGM ? (nM - fm) : WGM;
    pm = fm + ((wgid % nig) % gsz); pn = (wgid % nig) / gsz; return true;
}

typedef int i32x8 __attribute__((ext_vector_type(8)));
typedef int i32x4 __attribute__((ext_vector_type(4)));
template <class Epi, class Sched, bool GATHER, int FMT = 0>
__device__ __forceinline__ void gemm_phase(LAS unsigned char* lds, const int wid_in, const int lda, const int ldb, const int KB, const Sched& S, const Epi& E, const int sclb = 0x7f7f7f7f) {
    const int lane = lane_id_asm(), wid = wid_in, tid = wid * 64 + lane, wr = wid >> 2, wc = wid & 3, fr = lane & 15, fq = lane >> 4;
    const int nt = KB / 128;
    int sclr = sclb; if constexpr (FMT == 1) asm volatile("" : "+v"(sclr));
    unsigned voffA[2], voffB[2];
#pragma unroll
    for (int i = 0; i < 2; ++i) { int R, C; stage_rc(tid * 16 + i * 8192, R, C); const int Rb = Epi::PERM ? ((R & ~31) + perm32(R & 31)) : R;
        voffA[i] = (unsigned)(R * lda + C * 2); voffB[i] = (unsigned)(Rb * ldb + C * 2); }
    const size_t kstep = (size_t)(BK * 2);
    const size_t hstepA = (size_t)HALF * lda, hstepB = (size_t)HALF * ldb;
    const unsigned ldsw = (unsigned)wid * 1024u;
    const int aoff = lds_byte(wr * 64 + fr, fq * 8), boff = lds_byte(wc * 32 + fr, fq * 8);
#define PG8_SA(b, h) (((b) * 2 + (h)) * HTB)
#define PG8_SB(b, h) ((4 + (b) * 2 + (h)) * HTB)
#define PG8_ST2(bufoff, gbase, o0, o1) do { \
        __builtin_amdgcn_global_load_lds((const unsigned*)((const char*)(gbase) + (o0)), (LAS unsigned*)(lds + (bufoff) + ldsw), 16, 0, 0); \
        __builtin_amdgcn_global_load_lds((const unsigned*)((const char*)(gbase) + (o1)), (LAS unsigned*)(lds + (bufoff) + ldsw + 8192), 16, 0, 0); } while (0)
#define PG8_STB(bufoff, gbase, h) PG8_ST2(bufoff, (gbase) + (h) * hstepB, voffB[0], voffB[1])
#define PG8_STA(bufoff, gbase, h, G0, G1) do { if constexpr (GATHER) { PG8_ST2(bufoff, gbase, G0, G1); } else { PG8_ST2(bufoff, (gbase) + (h) * hstepA, voffA[0], voffA[1]); } } while (0)
#define PG8_CAT8(l_, h_) __builtin_shufflevector(l_, h_, 0, 1, 2, 3, 4, 5, 6, 7)
#define PG8_LO4(v_) __builtin_bit_cast(bf16x8, __builtin_shufflevector(v_, v_, 0, 1, 2, 3))
#define PG8_HI4(v_) __builtin_bit_cast(bf16x8, __builtin_shufflevector(v_, v_, 4, 5, 6, 7))
#define PG8_LDA(dst, b, h) do { _Pragma("unroll") for (int m = 0; m < 4; ++m) { const i32x4 l_ = *(const LAS i32x4*)(lds + PG8_SA(b, h) + aoff + m * 2048), h_ = *(const LAS i32x4*)(lds + PG8_SA(b, h) + aoff + m * 2048 + 1024); dst[m] = PG8_CAT8(l_, h_); } } while (0)
#define PG8_LDB(dst, b, h) do { _Pragma("unroll") for (int n = 0; n < 2; ++n) { const i32x4 l_ = *(const LAS i32x4*)(lds + PG8_SB(b, h) + boff + n * 2048), h_ = *(const LAS i32x4*)(lds + PG8_SB(b, h) + boff + n * 2048 + 1024); dst[n] = PG8_CAT8(l_, h_); } } while (0)
#define PG8_MMA(ai, bj, At, Bt) do { __builtin_amdgcn_s_setprio(1); _Pragma("unroll") for (int m = 0; m < 4; ++m) _Pragma("unroll") for (int n = 0; n < 2; ++n) { \
        if constexpr (FMT == 0) { acc[ai][bj][m][n] = __builtin_amdgcn_mfma_f32_16x16x32_bf16(PG8_LO4(Bt[n]), PG8_LO4(At[m]), acc[ai][bj][m][n], 0, 0, 0); \
                                  acc[ai][bj][m][n] = __builtin_amdgcn_mfma_f32_16x16x32_bf16(PG8_HI4(Bt[n]), PG8_HI4(At[m]), acc[ai][bj][m][n], 0, 0, 0); } \
        else asm volatile("v_mfma_scale_f32_16x16x128_f8f6f4 %0, %1, %2, %0, %3, %3 op_sel_hi:[0,0,0]" : "+v"(acc[ai][bj][m][n]) : "v"(Bt[n]), "v"(At[m]), "v"(sclr)); } \
        __builtin_amdgcn_s_setprio(0); } while (0)
#define PG8_WAIT_V(n) asm volatile("s_waitcnt vmcnt(" #n ")" ::: "memory")
#define PG8_WAIT_L(n) asm volatile("s_waitcnt lgkmcnt(" #n ")" ::: "memory")
#define PG8_BAR __builtin_amdgcn_s_barrier()
#define PG8_SCHED __builtin_amdgcn_sched_barrier(0)
    Unit cur, nxt; int ui = 0;
    if (!S.next(0, cur)) return;
    f32x4 acc[2][2][4][2];
#pragma unroll
    for (int a = 0; a < 2; ++a)
#pragma unroll
        for (int b = 0; b < 2; ++b)
#pragma unroll
            for (int m = 0; m < 4; ++m)
#pragma unroll
                for (int n = 0; n < 2; ++n) acc[a][b][m][n] = (f32x4){0.f, 0.f, 0.f, 0.f};
    i32x8 At[4], B0[2], B1[2];
    unsigned gc[2][2] = {{0u, 0u}, {0u, 0u}};
    if constexpr (GATHER) {
#pragma unroll
        for (int i = 0; i < 2; ++i) { int R, C; stage_rc(tid * 16 + i * 8192, R, C);
#pragma unroll
            for (int h = 0; h < 2; ++h) gc[h][i] = *(const LAS unsigned*)(lds + cur.gtab + (h * HALF + R) * 4) + (unsigned)C * 2u; }
    }
    const char* cA = cur.A; const char* cB = cur.B;
    PG8_STB(PG8_SB(0, 0), cB, 0); PG8_STB(PG8_SB(0, 1), cB, 1); PG8_STA(PG8_SA(0, 0), cA, 0, gc[0][0], gc[0][1]); PG8_STA(PG8_SA(0, 1), cA, 1, gc[1][0], gc[1][1]);
    if (wr == 1) PG8_BAR;
    PG8_WAIT_V(2); PG8_BAR;
    PG8_STB(PG8_SB(1, 0), cB + kstep, 0); PG8_STA(PG8_SA(1, 0), cA + kstep, 0, gc[0][0], gc[0][1]); PG8_STB(PG8_SB(1, 1), cB + kstep, 1);
    PG8_WAIT_V(6); PG8_BAR;
#define PG8_KITER(a1_, a2_, b2_, G00, G01, G10, G11) do { \
            const char* a3_ = (a2_) + kstep; const char* b3_ = (b2_) + kstep; \
              \
            PG8_LDB(B0, 0, 0); PG8_LDB(B1, 0, 1); PG8_SCHED; PG8_LDA(At, 0, 0); PG8_STA(PG8_SA(1, 1), a1_, 1, gc[1][0], gc[1][1]); \
            PG8_WAIT_V(8); PG8_WAIT_L(0); PG8_BAR; PG8_MMA(0, 0, At, B0); PG8_MMA(0, 1, At, B1); PG8_BAR; PG8_SCHED; \
              \
            PG8_LDA(At, 0, 1); PG8_STB(PG8_SB(0, 0), b2_, 0); PG8_STB(PG8_SB(0, 1), b2_, 1); PG8_STA(PG8_SA(0, 0), a2_, 0, G00, G01); \
            PG8_WAIT_V(8); PG8_WAIT_L(0); PG8_BAR; PG8_MMA(1, 0, At, B0); PG8_MMA(1, 1, At, B1); PG8_BAR; PG8_SCHED; \
              \
            PG8_LDB(B0, 1, 0); PG8_LDB(B1, 1, 1); PG8_SCHED; PG8_LDA(At, 1, 0); PG8_STA(PG8_SA(0, 1), a2_, 1, G10, G11); \
            PG8_WAIT_V(8); PG8_WAIT_L(0); PG8_BAR; PG8_MMA(0, 0, At, B0); PG8_MMA(0, 1, At, B1); PG8_BAR; PG8_SCHED; \
              \
            PG8_LDA(At, 1, 1); PG8_STB(PG8_SB(1, 0), b3_, 0); PG8_STB(PG8_SB(1, 1), b3_, 1); PG8_STA(PG8_SA(1, 0), a3_, 0, G00, G01); \
            PG8_WAIT_V(8); PG8_WAIT_L(0); PG8_BAR; PG8_MMA(1, 0, At, B0); PG8_MMA(1, 1, At, B1); PG8_BAR; PG8_SCHED; } while (0)
    for (;;) {
        const bool has_next = S.next(ui + 1, nxt);
        const char* nA = has_next ? nxt.A : cA; const char* nB = has_next ? nxt.B : cB;
        if constexpr (!GATHER) {
#pragma unroll 1
            for (int t = 0; t < nt; t += 2) {
                const bool last = (t == nt - 2);
                const char* a1 = cA + (size_t)(t + 1) * kstep;
                const char* a2 = last ? nA : cA + (size_t)(t + 2) * kstep; const char* b2 = last ? nB : cB + (size_t)(t + 2) * kstep;
                PG8_KITER(a1, a2, b2, 0u, 0u, 0u, 0u);
            }
        } else {
#pragma unroll 1
            for (int t = 0; t < nt - 2; t += 2) {
                const char* a1 = cA + (size_t)(t + 1) * kstep; const char* a2 = cA + (size_t)(t + 2) * kstep; const char* b2 = cB + (size_t)(t + 2) * kstep;
                PG8_KITER(a1, a2, b2, gc[0][0], gc[0][1], gc[1][0], gc[1][1]);
            }
            unsigned gn[2][2] = {{gc[0][0], gc[0][1]}, {gc[1][0], gc[1][1]}};
            if (has_next) {
                const int tid2 = wid * 64 + lane_id_asm();
#pragma unroll
                for (int i = 0; i < 2; ++i) { int R, C; stage_rc(tid2 * 16 + i * 8192, R, C);
#pragma unroll
                    for (int h = 0; h < 2; ++h) gn[h][i] = *(const LAS unsigned*)(lds + nxt.gtab + (h * HALF + R) * 4) + (unsigned)C * 2u; } }
            const char* a1 = cA + (size_t)(nt - 1) * kstep;
            PG8_KITER(a1, nA, nB, gn[0][0], gn[0][1], gn[1][0], gn[1][1]);
            gc[0][0] = gn[0][0]; gc[0][1] = gn[0][1]; gc[1][0] = gn[1][0]; gc[1][1] = gn[1][1];
        }
        if (wr == 0) PG8_BAR;
        if constexpr (FMT == 1) asm volatile("s_nop 15\n\ts_nop 15" ::: "memory");
        if constexpr (GATHER) { int fr2 = fr, fq2 = fq; asm volatile("" : "+v"(fr2), "+v"(fq2));
            E(acc, cur, wr, wc, fr2, fq2); }
        else E(acc, cur, wr, wc, fr, fq);
        if (!has_next) break;
#pragma unroll
        for (int a = 0; a < 2; ++a)
#pragma unroll
            for (int b = 0; b < 2; ++b)
#pragma unroll
                for (int m = 0; m < 4; ++m)
#pragma unroll
                    for (int n = 0; n < 2; ++n) acc[a][b][m][n] = (f32x4){0.f, 0.f, 0.f, 0.f};
        cur = nxt; cA = nA; cB = nB; ++ui;
        if (wr == 1) PG8_BAR;
    }
    PG8_WAIT_V(0);
    PG8_BAR;
#undef PG8_SA
#undef PG8_SB
#undef PG8_ST2
#undef PG8_STB
#undef PG8_STA
#undef PG8_LDA
#undef PG8_CAT8
#undef PG8_LO4
#undef PG8_HI4
#undef PG8_LDB
#undef PG8_MMA
#undef PG8_WAIT_V
#undef PG8_WAIT_L
#undef PG8_BAR
#undef PG8_SCHED
#undef PG8_KITER
}

typedef f32x4 AccT[2][2][4][2];
__device__ __forceinline__ u32x4 pack8(const f32x4 a, const f32x4 b) { u32x4 w; w.x = cvt_pk_bf16(a[0], a[1]); w.y = cvt_pk_bf16(a[2], a[3]); w.z = cvt_pk_bf16(b[0], b[1]); w.w = cvt_pk_bf16(b[2], b[3]); return w; }
template <int ACT> __device__ __forceinline__ void store_plain(const AccT& acc, bf16_t* O, int ldo, int row0, int col0, int wr, int wc, int fr, int fq) {
#pragma unroll
    for (int ai = 0; ai < 2; ++ai)
#pragma unroll
        for (int m = 0; m < 4; ++m) { bf16_t* rowp = O + (size_t)(row0 + ai * HALF + wr * 64 + m * 16 + fr) * ldo + col0 + wc * 32 + 8 * fq;
#pragma unroll
            for (int bj = 0; bj < 2; ++bj) { f32x4 v0 = acc[ai][bj][m][0], v1 = acc[ai][bj][m][1];
                if (ACT == 1) {
#pragma unroll
                    for (int j = 0; j < 4; ++j) { v0[j] = fgelu_tanh(v0[j]); v1[j] = fgelu_tanh(v1[j]); } }
                *(u32x4*)(rowp + bj * HALF) = pack8(v0, v1); } }
}
template <int MODE> __device__ __forceinline__ void store_pair(const AccT& acc, bf16_t* O, int ldo, int row0, int col0, int wr, int wc, int fr, int fq) {
#pragma unroll
    for (int ai = 0; ai < 2; ++ai)
#pragma unroll
        for (int m = 0; m < 4; ++m) { bf16_t* rowp = O + (size_t)(row0 + ai * HALF + wr * 64 + m * 16 + fr) * ldo + col0 + wc * 32 + 8 * fq;
            f32x4 o[2];
#pragma unroll
            for (int n = 0; n < 2; ++n) { const f32x4 v = acc[ai][0][m][n], g = acc[ai][1][m][n];
#pragma unroll
                for (int j = 0; j < 4; ++j) o[n][j] = MODE == 0 ? v[j] * fsigmoid(g[j]) : (MODE == 1 ? v[j] * g[j] : fsilu(v[j]) * g[j]); }
            *(u32x4*)rowp = pack8(o[0], o[1]); }
}
struct EpiIn0 {
    static constexpr bool PERM = true; bf16_t* U0;
    __device__ __forceinline__ void operator()(const AccT& acc, const Unit& u, int wr, int wc, int fr, int fq) const {
        if (u.pn < 4) store_pair<0>(acc, U0, 1536, u.row0, 128 * u.pn, wr, wc, fr, fq);
        else if (u.pn < 8) store_pair<1>(acc, U0, 1536, u.row0, 512 + 128 * (u.pn - 4), wr, wc, fr, fq);
        else store_plain<0>(acc, U0, 1536, u.row0, 1024 + 256 * (u.pn - 8), wr, wc, fr, fq);
    }
};
struct EpiIn1 {
    static constexpr bool PERM = true; bf16_t* GY; bf16_t* XR;
    __device__ __forceinline__ void operator()(const AccT& acc, const Unit& u, int wr, int wc, int fr, int fq) const {
        if (u.pn < 4) store_plain<1>(acc, GY, D, u.row0, 256 * u.pn, wr, wc, fr, fq);
        else store_plain<0>(acc, XR, D, u.row0, 256 * (u.pn - 4), wr, wc, fr, fq);
    }
};
__device__ __forceinline__ void store_pair_fp8(const AccT& acc, unsigned char* O, int ldo, int row0, int col0, int wr, int wc, int fr, int fq) {
#pragma unroll
    for (int ai = 0; ai < 2; ++ai)
#pragma unroll
        for (int m = 0; m < 4; ++m) { unsigned char* rowp = O + (size_t)(row0 + ai * HALF + wr * 64 + m * 16 + fr) * ldo + col0 + wc * 32 + 8 * fq;
            u32x2 w;
#pragma unroll
            for (int n = 0; n < 2; ++n) { const f32x4 v = acc[ai][0][m][n], g = acc[ai][1][m][n]; float o[4];
#pragma unroll
                for (int j = 0; j < 4; ++j) o[j] = fminf(fmaxf(fsilu(v[j]) * g[j], -448.f), 448.f);
                const unsigned pk = pack4_fp8(o[0], o[1], o[2], o[3]); if (n == 0) w.x = pk; else w.y = pk; }
            *(u32x2*)rowp = w; }
}
struct EpiMoe1Q { static constexpr bool PERM = true; unsigned char* H;
    __device__ __forceinline__ void operator()(const AccT& acc, const Unit& u, int wr, int wc, int fr, int fq) const { store_pair_fp8(acc, H, DEXP, u.row0, 128 * u.pn, wr, wc, fr, fq); } };
struct EpiMoe1 { static constexpr bool PERM = true; bf16_t* H;
    __device__ __forceinline__ void operator()(const AccT& acc, const Unit& u, int wr, int wc, int fr, int fq) const { store_pair<2>(acc, H, DEXP, u.row0, 128 * u.pn, wr, wc, fr, fq); } };
struct EpiMoe2 { static constexpr bool PERM = true; bf16_t* Y;
    __device__ __forceinline__ void operator()(const AccT& acc, const Unit& u, int wr, int wc, int fr, int fq) const { store_plain<0>(acc, Y, D, u.row0, 256 * u.pn, wr, wc, fr, fq); } };
template <bool RESBF> struct EpiRes { static constexpr bool PERM = false; const void* res; float* Y;
    __device__ __forceinline__ void operator()(const AccT& acc, const Unit& u, int wr, int wc, int fr, int fq) const {
#pragma unroll
        for (int ai = 0; ai < 2; ++ai)
#pragma unroll
            for (int m = 0; m < 4; ++m) { const size_t off = (size_t)(u.row0 + ai * HALF + wr * 64 + m * 16 + fr) * D + u.pn * 256 + wc * 32 + 4 * fq;
#pragma unroll
                for (int bj = 0; bj < 2; ++bj)
#pragma unroll
                    for (int n = 0; n < 2; ++n) { const size_t o = off + bj * HALF + n * 16; f32x4 r;
                        if (RESBF) { const u32x2 w = *(const u32x2*)((const bf16_t*)res + o); r = (f32x4){bf_lo(w.x), bf_hi(w.x), bf_lo(w.y), bf_hi(w.y)}; }
                        else r = *(const f32x4*)((const float*)res + o);
                        *(f32x4*)(Y + o) = r * ALPHA + acc[ai][bj][m][n]; } }
    }
};
struct EpiGates { static constexpr bool PERM = true; const bf16_t* XC; const float* ba; const float* bx; const float* spl; bf16_t* L2A; bf16_t* BV;
    __device__ __forceinline__ void operator()(const AccT& acc, const Unit& u, int wr, int wc, int fr, int fq) const {
        const int col = 128 * u.pn + wc * 32 + 8 * fq;
#pragma unroll
        for (int ai = 0; ai < 2; ++ai)
#pragma unroll
            for (int m = 0; m < 4; ++m) { const size_t o = (size_t)(u.row0 + ai * HALF + wr * 64 + m * 16 + fr) * DRNN + col;
                const u32x4 xw = *(const u32x4*)(XC + o); const float xv[8] = {bf_lo(xw.x), bf_hi(xw.x), bf_lo(xw.y), bf_hi(xw.y), bf_lo(xw.z), bf_hi(xw.z), bf_lo(xw.w), bf_hi(xw.w)};
                f32x4 la2[2], bo[2];
#pragma unroll
                for (int n = 0; n < 2; ++n) { const f32x4 cba = *(const f32x4*)(ba + col + 4 * n), cbx = *(const f32x4*)(bx + col + 4 * n), csp = *(const f32x4*)(spl + col + 4 * n);
#pragma unroll
                    for (int j = 0; j < 4; ++j) { const float r = fsigmoid(acc[ai][0][m][n][j] + cba[j]), ig = fsigmoid(acc[ai][1][m][n][j] + cbx[j]);
                        const float l2 = -1.4426950408889634f * csp[j] * r;
                        const float a = __builtin_amdgcn_exp2f(l2); la2[n][j] = l2; bo[n][j] = __builtin_sqrtf(fmaxf(1.0f - a * a, 0.f)) * (ig * xv[4 * n + j]); } }
                *(u32x4*)(L2A + o) = pack8(la2[0], la2[1]); *(u32x4*)(BV + o) = pack8(bo[0], bo[1]);
                asm volatile("" ::: "memory"); }
    }
};
}

constexpr size_t MiB = 1u << 20;
constexpr size_t WS_CTL = 0, CTL_ZERO_BYTES = 65536;
constexpr size_t WS_WIN0 = 2 * MiB, WS_WOUT0 = 7 * MiB, WS_WIN1 = 9 * MiB, WS_WGT = 13 * MiB, WS_WOUT1 = 14 * MiB, WS_W13 = 16 * MiB, WS_W2 = 144 * MiB, WS_SPL = 208 * MiB;
constexpr size_t WS_X1 = 212 * MiB, WS_X2 = 244 * MiB;
constexpr size_t WS_R = 276 * MiB;
constexpr size_t WS_U0 = WS_R, WS_CAT0 = WS_R + 48 * MiB, WS_YPRE0 = WS_R + 80 * MiB;
constexpr size_t WS_GY = WS_R, WS_XR = WS_R + 32 * MiB, WS_XC = WS_R + 64 * MiB, WS_BV = WS_R + 96 * MiB, WS_YPRE1 = WS_R + 64 * MiB;
constexpr size_t WS_H = WS_R, WS_Y = WS_R + 72 * MiB;
constexpr size_t WS_LIST = 420 * MiB, WS_TOKSLOT = 421 * MiB, WS_TOKGATE = WS_TOKSLOT + 256 * 1024, WS_AGG = 422 * MiB, WS_X1Q = 424 * MiB  , WS_FAST_END = 440 * MiB;
#ifndef MOE_FP8
#define MOE_FP8 1
#endif
constexpr int SCL_W13 = 6, SCL_W2 = 6;
static_assert(SCL_W13 % 2 == 0 && SCL_W2 % 2 == 0, "even scales");
constexpr int NPAD_ROWS = 2 * T + NE * 256;
static_assert(WS_H + (size_t)NPAD_ROWS * DEXP * 2 <= WS_Y && WS_Y + (size_t)NPAD_ROWS * D * 2 <= WS_LIST, "H / Y fit");
constexpr int CW_TMO = 0, CW_CODE = 1, CW_GCOUNT = 256  , CW_BAR = 4096;
constexpr int RING_BYTES = 131072, LDSCTL_OFF = RING_BYTES, MISC_OFF = LDSCTL_OFF + 320, UNITS_OFF = LDSCTL_OFF + 512, MOEMETA_OFF = LDSCTL_OFF + 768, GTAB_OFF = LDSCTL_OFF + 1024, MAX_UNITS = 8;
constexpr int LDS_BYTES = 147456;
static_assert(GTAB_OFF + MAX_UNITS * 1024 <= LDS_BYTES, "LDS map");
constexpr int NWAVES = 8, NTHREADS = 512;

#define XB_TMO      128
#define XB_XCNT(j)  (256  + 64 * (j))
#define XB_XSUB(j)  (1280 + 64 * (j))
#define XB_XGEN(j)  (2304 + 64 * (j))
#define XB_TOP      3328
#define XB_TOPGEN   3392
#define XCD_BAR_WORDS 3456
#define XB_SPIN_CAP (1u << 18)
__device__ __forceinline__ unsigned xb_ld(unsigned* p)              { return __hip_atomic_load(p, __ATOMIC_RELAXED, __HIP_MEMORY_SCOPE_AGENT); }
__device__ __forceinline__ unsigned xb_add(unsigned* p, unsigned v) { return __hip_atomic_fetch_add(p, v, __ATOMIC_RELAXED, __HIP_MEMORY_SCOPE_AGENT); }
__device__ __forceinline__ unsigned xb_xcc_id() { return (unsigned)__builtin_amdgcn_s_getreg((3 << 11) | 20) & 0xFu; }
#define XB_SPIN(cond, bar) do { unsigned _sp = 0; while (cond) { __builtin_amdgcn_s_sleep(1); \
    if ((++_sp & 255u) == 0u) { if (xb_ld(&(bar)[XB_TMO])) break; if (_sp > XB_SPIN_CAP) { atomicAdd(&(bar)[XB_TMO], 1u); break; } } } } while (0)
struct XcdBarrier { unsigned* bar; unsigned x; volatile LAS unsigned* st; int wave; };
__device__ __forceinline__ XcdBarrier xcd_barrier_post(unsigned* bar, volatile LAS unsigned* st, int wave) {
    XcdBarrier b; b.bar = bar; b.x = xb_xcc_id(); b.st = st; b.wave = wave;
    if (wave == 0 && lane_id_asm() == 0) (void)xb_add(&bar[XB_XCNT(b.x)], 1u);
    return b;
}
__device__ __forceinline__ void xcd_barrier_complete(unsigned* bar, unsigned x, unsigned& nloc, unsigned& nx) {
    const unsigned G = gridDim.x * gridDim.y * gridDim.z;
    unsigned sum, cnt, mine, sp = 0u;
    for (;;) {
        sum = 0u; cnt = 0u; mine = 0u;
#pragma unroll
        for (unsigned j = 0; j < 16; ++j) { const unsigned c = xb_ld(&bar[XB_XCNT(j)]); sum += c; cnt += (c > 0u) ? 1u : 0u; mine = (j == x) ? c : mine; }
        if (sum == G) break;
        __builtin_amdgcn_s_sleep(1);
        if ((++sp & 255u) == 0u) { if (xb_ld(&bar[XB_TMO])) break; if (sp > XB_SPIN_CAP) { atomicAdd(&bar[XB_TMO], 1u); break; } }
    }
    nloc = mine > 0u ? mine : 1u; nx = cnt > 0u ? cnt : 1u;
}
__device__ __forceinline__ void xcd_barrier(const XcdBarrier& b) {
    asm volatile("s_waitcnt vmcnt(0)" ::: "memory");
    __syncthreads();
    if (b.wave == 0 && lane_id_asm() == 0) {
        unsigned* bar = b.bar;
        __builtin_amdgcn_s_waitcnt(0);
        unsigned nloc = b.st[0], nx = b.st[1];
        if (nloc == 0u) { xcd_barrier_complete(bar, b.x, nloc, nx); b.st[0] = nloc; b.st[1] = nx; }
        const unsigned old = xb_add(&bar[XB_XSUB(b.x)], 1u);
        const unsigned gen = old / nloc;
        if (old + 1u == (gen + 1u) * nloc) {
            __builtin_amdgcn_fence(__ATOMIC_RELEASE, "agent");
            asm volatile("s_waitcnt vmcnt(0)" ::: "memory");
            const unsigned og = xb_add(&bar[XB_TOP], 1u);
            const unsigned tg = og / nx;
            if (og + 1u == (tg + 1u) * nx) xb_add(&bar[XB_TOPGEN], 1u);
            else XB_SPIN(xb_ld(&bar[XB_TOPGEN]) == tg, bar);
            __builtin_amdgcn_fence(__ATOMIC_ACQUIRE, "agent");
            xb_add(&bar[XB_XGEN(b.x)], 1u);
            asm volatile("s_waitcnt vmcnt(0)" ::: "memory");
        } else {
            XB_SPIN(xb_ld(&bar[XB_XGEN(b.x)]) == gen, bar);
            __builtin_amdgcn_fence(__ATOMIC_ACQUIRE, "agent");
            asm volatile("s_waitcnt vmcnt(0)" ::: "memory");
        }
    }
    __syncthreads();
}

struct Args { const float* in[26]; float* out; unsigned char* ws; int ph_lo, ph_hi; };
struct Frame {
    LAS unsigned char* lds; unsigned char* ws; const float* const* in; float* out;
    int tid, lane, wave, vcu, G;
    template <class Tp> __device__ __forceinline__ Tp* W(size_t off) const { return (Tp*)(ws + off); }
    __device__ __forceinline__ const float* I(int i) const { return in[i]; }
    __device__ __forceinline__ unsigned* ctl() const { return (unsigned*)(ws + WS_CTL); }
    __device__ __forceinline__ void retid() { lane = lane_id_asm(); tid = wave * 64 + lane; }
};

__device__ __forceinline__ void cvt_item(const float* src, int ldsrc, int k0, int c0, bf16_t* dst, int lddst, int drow0, LAS unsigned* scr, int lane) {
    const int cg = lane & 15, rp = lane >> 4;
    const float* sp = src + (size_t)k0 * ldsrc + c0 + 4 * cg;
    f32x4 v[16];
#pragma unroll
    for (int j = 0; j < 8; ++j) { const int r = 2 * (rp + 4 * j); v[2 * j] = *(const f32x4*)(sp + (size_t)r * ldsrc); v[2 * j + 1] = *(const f32x4*)(sp + (size_t)(r + 1) * ldsrc); }
#pragma unroll
    for (int j = 0; j < 8; ++j) { const int kd = rp + 4 * j;
#pragma unroll
        for (int i = 0; i < 4; ++i) scr[(4 * cg + i) * 33 + kd] = cvt_pk_bf16(v[2 * j][i], v[2 * j + 1][i]); }
    LDS_WAIT();
    const int kc = lane & 7;
#pragma unroll
    for (int jj = 0; jj < 8; ++jj) { const int n = (lane >> 3) + 8 * jj; const LAS unsigned* s = scr + n * 33 + 4 * kc;
        u32x4 o; o.x = s[0]; o.y = s[1]; o.z = s[2]; o.w = s[3];
        *(u32x4*)(dst + (size_t)(drow0 + n) * lddst + k0 + 8 * kc) = o; }
    LDS_WAIT();
}
__device__ __forceinline__ void cvt_item8(const float* src, int ldsrc, int k0, int c0, unsigned char* dst, int lddst, int drow0, float scale, LAS unsigned* scr, int lane) {
    const int cg = lane & 15, rp = lane >> 4;
    const float* sp = src + (size_t)k0 * ldsrc + c0 + 4 * cg;
    f32x4 v[16];
#pragma unroll
    for (int j = 0; j < 4; ++j)
#pragma unroll
        for (int q = 0; q < 4; ++q) v[4 * j + q] = *(const f32x4*)(sp + (size_t)(4 * (rp + 4 * j) + q) * ldsrc);
#pragma unroll
    for (int j = 0; j < 4; ++j) { const int kq = rp + 4 * j;
#pragma unroll
        for (int i = 0; i < 4; ++i) scr[(4 * cg + i) * 17 + kq] = pack4_fp8(v[4 * j][i] * scale, v[4 * j + 1][i] * scale, v[4 * j + 2][i] * scale, v[4 * j + 3][i] * scale); }
    LDS_WAIT();
    const int c4 = lane & 3;
#pragma unroll
    for (int jj = 0; jj < 4; ++jj) { const int n = (lane >> 2) + 16 * jj; const LAS unsigned* s = scr + n * 17 + 4 * c4;
        u32x4 o; o.x = s[0]; o.y = s[1]; o.z = s[2]; o.w = s[3];
        *(u32x4*)(dst + (size_t)(drow0 + n) * lddst + k0 + 16 * c4) = o; }
    LDS_WAIT();
}
__device__ __forceinline__ void p0_prologue(Frame& F) {
    F.retid();
    LAS unsigned* scr = (LAS unsigned*)(F.lds + F.wave * 8448);
    const int gw = F.vcu * NWAVES + F.wave, NGW = F.G * NWAVES;
    constexpr int I_IN0 = 16 * 40, I_OUT0 = 16 * 16, I_IN1 = 16 * 32, I_GT = 4 * 4 * 8, I_OUT1 = 16 * 16, I_W13 = 32 * 16 * 32, I_W2 = 32 * 16 * 16;
    constexpr int NITEMS = I_IN0 + I_OUT0 + I_IN1 + I_GT + I_OUT1 + I_W13 + I_W2;
    for (int it = gw; it < NITEMS; it += NGW) {
        int r = it; const float* src; int ldsrc, k0, sc, lddst, drow0; unsigned char* dst; bool q8 = false; float scale = 1.f;
        if (r < I_IN0) { const int kb = r / 40, db = r % 40, p = db >> 2, q = db & 3;
            if (p < 4) sc = (q < 2) ? 128 * p + 64 * q : 512 + 128 * p + 64 * (q - 2);
            else if (p < 8) sc = (q < 2) ? 1536 + 128 * (p - 4) + 64 * q : 2048 + 128 * (p - 4) + 64 * (q - 2);
            else sc = 1024 + 256 * (p - 8) + 64 * q;
            src = F.I(5); ldsrc = DIN0; k0 = 64 * kb; dst = F.W<unsigned char>(WS_WIN0); lddst = D; drow0 = 64 * db; }
        else if ((r -= I_IN0) < I_OUT0) { const int kb = r / 16, db = r % 16; src = F.I(11); ldsrc = D; k0 = 64 * kb; sc = 64 * db; dst = F.W<unsigned char>(WS_WOUT0); lddst = D; drow0 = 64 * db; }
        else if ((r -= I_OUT0) < I_IN1) { const int kb = r / 32, db = r % 32; src = F.I(12); ldsrc = 2 * DRNN; k0 = 64 * kb; sc = 64 * db; dst = F.W<unsigned char>(WS_WIN1); lddst = D; drow0 = 64 * db; }
        else if ((r -= I_IN1) < I_GT) { const int h = r / 32, r2 = r % 32, kb = r2 / 8, db = r2 % 8, p = db >> 2, q = db & 3;
            src = (q < 2 ? F.I(15) : F.I(17)) + (size_t)h * RBLK * RBLK; ldsrc = RBLK; k0 = 64 * kb; sc = 128 * p + 64 * (q & 1); dst = F.W<unsigned char>(WS_WGT) + (size_t)h * 512 * RBLK * 2; lddst = RBLK; drow0 = 64 * db; }
        else if ((r -= I_GT) < I_OUT1) { const int kb = r / 16, db = r % 16; src = F.I(20); ldsrc = D; k0 = 64 * kb; sc = 64 * db; dst = F.W<unsigned char>(WS_WOUT1); lddst = DRNN; drow0 = 64 * db; }
        else if ((r -= I_OUT1) < I_W13) { const int le = r / 512, r2 = r % 512, kb = r2 / 32, db = r2 % 32, p = db >> 2, q = db & 3;
            src = (q < 2 ? F.I(23) : F.I(24)) + (size_t)le * D * DEXP; ldsrc = DEXP; k0 = 64 * kb; sc = 128 * p + 64 * (q & 1); lddst = D; drow0 = 64 * db;
            q8 = MOE_FP8; scale = (float)(1 << SCL_W13); dst = F.W<unsigned char>(WS_W13) + (size_t)le * 2 * DEXP * D * (MOE_FP8 ? 1 : 2); }
        else { r -= I_W13; const int le = r / 256, r2 = r % 256, kb = r2 / 16, db = r2 % 16;
            src = F.I(25) + (size_t)le * DEXP * D; ldsrc = D; k0 = 64 * kb; sc = 64 * db; lddst = DEXP; drow0 = 64 * db;
            q8 = MOE_FP8; scale = (float)(1 << SCL_W2); dst = F.W<unsigned char>(WS_W2) + (size_t)le * D * DEXP * (MOE_FP8 ? 1 : 2); }
        if (q8) cvt_item8(src, ldsrc, k0, sc, dst, lddst, drow0, scale, scr, F.lane);
        else cvt_item(src, ldsrc, k0, sc, (bf16_t*)dst, lddst, drow0, scr, F.lane);
    }
    { const float* x = F.I(0); bf16_t* xb = F.W<bf16_t>(WS_X2); const size_t n8 = (size_t)T * D / 8, stride = (size_t)F.G * NTHREADS;
      for (size_t i = (size_t)F.vcu * NTHREADS + F.tid; i < n8; i += stride) { const f32x4 a = *(const f32x4*)(x + i * 8), b = *(const f32x4*)(x + i * 8 + 4); *(u32x4*)(xb + i * 8) = pg8::pack8(a, b); } }
    { const int i = F.vcu * NTHREADS + F.tid; if (i < DRNN) F.W<float>(WS_SPL)[i] = 8.0f * log1pf(expf(-F.I(19)[i])); }
}

struct DenseOrder {
    const char* A; const char* B; size_t a_tile, b_tile; int nM, nN, G, c;
    __device__ __forceinline__ bool next(int i, pg8::Unit& u) const { int pm, pn; if (!pg8::tile_of(i, G, c, nM, nN, pm, pn)) return false;
        u.A = A + (size_t)pm * a_tile; u.B = B + (size_t)pn * b_tile; u.row0 = pm * 256; u.pn = pn; u.e = 0; u.gtab = 0; return true; }
};
struct GatesOrder {
    const char* XC; const char* WG; int G, c;
    __device__ __forceinline__ bool next(int i, pg8::Unit& u) const { int pm, pn; if (!pg8::tile_of(i, G, c, T / 256, 2 * RHEADS, pm, pn)) return false;
        u.A = XC + (size_t)pm * 256 * DRNN * 2 + (size_t)(pn >> 1) * RBLK * 2; u.B = WG + (size_t)pn * 256 * RBLK * 2; u.row0 = pm * 256; u.pn = pn; u.e = 0; u.gtab = 0; return true; }
};
struct MoeOrder { LAS const int* units; int nu; const char* A; const char* B; size_t b_exp, b_tile, a_tile; bool gather;
    __device__ __forceinline__ bool next(int i, pg8::Unit& u) const { if (i >= nu) return false;
        const int e = __builtin_amdgcn_readfirstlane(units[4 * i]), pm = __builtin_amdgcn_readfirstlane(units[4 * i + 1]), pn = __builtin_amdgcn_readfirstlane(units[4 * i + 2]);
        u.A = gather ? A : A + (size_t)pm * a_tile; u.B = B + (size_t)e * b_exp + (size_t)pn * b_tile; u.row0 = pm * 256; u.pn = pn; u.e = e; u.gtab = GTAB_OFF + i * 1024; return true; }
};
__device__ __forceinline__ int moe_setup(Frame& F, int layer, int nN, bool gather, unsigned rowbytes) {
    F.retid();
    LAS int* meta = (LAS int*)(F.lds + MOEMETA_OFF); LAS int* units = (LAS int*)(F.lds + UNITS_OFF); LAS unsigned* gtab = (LAS unsigned*)(F.lds + GTAB_OFF);
    const unsigned* gcount = F.ctl() + CW_GCOUNT + 32 * layer;
    if (F.tid < NE) meta[17 + F.tid] = (int)__hip_atomic_load(gcount + F.tid, RLX_AGENT);
    __syncthreads();
    if (F.tid == 0) { int acc = 0; for (int e = 0; e < NE; ++e) { meta[e] = acc; acc += (meta[17 + e] + 255) >> 8; } meta[NE] = acc; }
    __syncthreads();
    const int nM = meta[NE]; int nu = 0;
    for (int i = 0; i < MAX_UNITS; ++i) { int pm, pn; if (!pg8::tile_of(i, F.G, (int)blockIdx.x, nM, nN, pm, pn)) break;
        int e = 0;
#pragma unroll
        for (int j = 1; j < NE; ++j) e += (meta[j] <= pm) ? 1 : 0;
        if (F.tid == 0) { units[4 * i] = e; units[4 * i + 1] = pm; units[4 * i + 2] = pn; units[4 * i + 3] = 0; }
        if (gather && F.tid < 256) { const int idx = (pm - meta[e]) * 256 + F.tid; const int cnt = meta[17 + e];
            const int tok = idx < cnt ? F.W<int>(WS_LIST)[e * T + idx] : 0; gtab[i * 256 + F.tid] = (unsigned)tok * rowbytes; }
        nu = i + 1; }
    __syncthreads();
    return nu;
}

__device__ __forceinline__ void p_mix0(Frame& F) {
    F.retid();
    LAS float* wA = (LAS float*)F.lds;
    LAS float* wB = wA + CONVA * DA;
    LAS float* pb = wB + CONVB * DB;
    for (int i = F.tid; i < CONVA * DA; i += NTHREADS) wA[i] = F.I(6)[i];
    for (int i = F.tid; i < CONVB * DB; i += NTHREADS) wB[i] = F.I(10)[i];
    for (int i = F.tid; i < DA; i += NTHREADS) { pb[i] = F.I(7)[i]; pb[DA + i] = F.I(8)[i]; pb[2 * DA + i] = F.I(9)[i]; }
    __syncthreads();
    const bf16_t* U0 = F.W<bf16_t>(WS_U0); bf16_t* CAT = F.W<bf16_t>(WS_CAT0);
    const int c0 = 8 * F.lane;
#pragma unroll 1
    for (int tb = F.vcu * NWAVES + F.wave; tb < T / 8; tb += F.G * NWAVES) {
        const int t0 = tb * 8, s0 = t0 & (SEQ - 1);
        float acc[8][8];
        { const f32x4 b0 = *(const LAS f32x4*)(pb + c0), b1 = *(const LAS f32x4*)(pb + c0 + 4);
#pragma unroll
          for (int r = 0; r < 8; ++r) { acc[r][0] = b0[0]; acc[r][1] = b0[1]; acc[r][2] = b0[2]; acc[r][3] = b0[3]; acc[r][4] = b1[0]; acc[r][5] = b1[1]; acc[r][6] = b1[2]; acc[r][7] = b1[3]; } }
#pragma unroll
        for (int jb = 0; jb < 5; ++jb) {
            u32x4 in[8];
#pragma unroll
            for (int jj = 0; jj < 8; ++jj) { const int j = jb * 8 + jj; const int d = 30 - j;
                const bool ok = (j < 38) && (s0 - d >= 0); const size_t rr = ok ? (size_t)(t0 - d) : (size_t)t0;
                in[jj] = *(const u32x4*)(U0 + rr * 1536 + c0); if (!ok) in[jj] = (u32x4){0u, 0u, 0u, 0u}; }
#pragma unroll
            for (int jj = 0; jj < 8; ++jj) { const int j = jb * 8 + jj;
                const float x0 = bf_lo(in[jj].x), x1 = bf_hi(in[jj].x), x2 = bf_lo(in[jj].y), x3 = bf_hi(in[jj].y), x4 = bf_lo(in[jj].z), x5 = bf_hi(in[jj].z), x6 = bf_lo(in[jj].w), x7 = bf_hi(in[jj].w);
#pragma unroll
                for (int r = 0; r < 8; ++r) { const int k = j - r; if (k < 0 || k >= CONVA) continue;
                    const f32x4 w0 = *(const LAS f32x4*)(wA + k * DA + c0), w1 = *(const LAS f32x4*)(wA + k * DA + c0 + 4);
                    acc[r][0] += w0[0] * x0; acc[r][1] += w0[1] * x1; acc[r][2] += w0[2] * x2; acc[r][3] += w0[3] * x3;
                    acc[r][4] += w1[0] * x4; acc[r][5] += w1[1] * x5; acc[r][6] += w1[2] * x6; acc[r][7] += w1[3] * x7; } }
        }
        float mean[8], rstd[8];
#pragma unroll
        for (int r = 0; r < 8; ++r) { float sm = 0.f;
#pragma unroll
            for (int j = 0; j < 8; ++j) sm += acc[r][j];
            mean[r] = sm; }
#pragma unroll
        for (int r = 0; r < 8; ++r) mean[r] = wave_sum(mean[r]) * (1.0f / DA);
#pragma unroll
        for (int r = 0; r < 8; ++r) { float q = 0.f;
#pragma unroll
            for (int j = 0; j < 8; ++j) { acc[r][j] -= mean[r]; q += acc[r][j] * acc[r][j]; }
            rstd[r] = q; }
#pragma unroll
        for (int r = 0; r < 8; ++r) rstd[r] = 1.0f / sqrtf(wave_sum(rstd[r]) * (1.0f / DA) + LN_EPS);
        { const f32x4 g0 = *(const LAS f32x4*)(pb + DA + c0), g1 = *(const LAS f32x4*)(pb + DA + c0 + 4), e0 = *(const LAS f32x4*)(pb + 2 * DA + c0), e1 = *(const LAS f32x4*)(pb + 2 * DA + c0 + 4);
#pragma unroll
          for (int r = 0; r < 8; ++r) { f32x4 o0, o1;
#pragma unroll
              for (int j = 0; j < 4; ++j) { o0[j] = fsilu(acc[r][j] * rstd[r] * g0[j] + e0[j]); o1[j] = fsilu(acc[r][4 + j] * rstd[r] * g1[j] + e1[j]); }
              *(u32x4*)(CAT + (size_t)(t0 + r) * D + c0) = pg8::pack8(o0, o1); } }
        { u32x4 cx[10], bbv[8];
#pragma unroll
          for (int j = 0; j < 10; ++j) { const int d = 2 - j; const bool ok = (s0 - d >= 0); const size_t rr = ok ? (size_t)(t0 - d) : (size_t)t0;
              cx[j] = *(const u32x4*)(U0 + rr * 1536 + 512 + c0); if (!ok) cx[j] = (u32x4){0u, 0u, 0u, 0u}; }
#pragma unroll
          for (int r = 0; r < 8; ++r) bbv[r] = *(const u32x4*)(U0 + (size_t)(t0 + r) * 1536 + 1024 + c0);
          f32x4 wv[3][2];
#pragma unroll
          for (int k = 0; k < 3; ++k) { wv[k][0] = *(const LAS f32x4*)(wB + k * DB + c0); wv[k][1] = *(const LAS f32x4*)(wB + k * DB + c0 + 4); }
#pragma unroll
          for (int r = 0; r < 8; ++r) { f32x4 a0 = {0.f, 0.f, 0.f, 0.f}, a1 = {0.f, 0.f, 0.f, 0.f};
#pragma unroll
              for (int k = 0; k < 3; ++k) { const u32x4 w = cx[r + k];
                  a0 += wv[k][0] * (f32x4){bf_lo(w.x), bf_hi(w.x), bf_lo(w.y), bf_hi(w.y)}; a1 += wv[k][1] * (f32x4){bf_lo(w.z), bf_hi(w.z), bf_lo(w.w), bf_hi(w.w)}; }
              const u32x4 bw = bbv[r];
              const f32x4 p0 = a0 * (f32x4){bf_lo(bw.x), bf_hi(bw.x), bf_lo(bw.y), bf_hi(bw.y)}, p1 = a1 * (f32x4){bf_lo(bw.z), bf_hi(bw.z), bf_lo(bw.w), bf_hi(bw.w)};
              *(u32x4*)(CAT + (size_t)(t0 + r) * D + 512 + c0) = pg8::pack8(p0, p1); } }
    }
    __syncthreads();
}

__device__ __forceinline__ void route16(const float (&l)[NE], int& e1, int& e2, float& g1, float& g2) {
    float mx = l[0];
#pragma unroll
    for (int e = 1; e < NE; ++e) mx = fmaxf(mx, l[e]);
    float p[NE];
#pragma unroll
    for (int e = 0; e < NE; ++e) p[e] = __expf(l[e] - mx);
    int gsel = 0; float best = -1.f, bq0 = 0.f, bq1 = 0.f, bq2 = 0.f, bq3 = 0.f;
#pragma unroll
    for (int g = 0; g < NG; ++g) { float m1 = -1.f, m2 = -1.f;
#pragma unroll
        for (int j = 0; j < EPG; ++j) { const float v = p[g * EPG + j]; if (v > m1) { m2 = m1; m1 = v; } else if (v > m2) m2 = v; }
        const float sc = m1 + m2; if (sc > best) { best = sc; gsel = g; bq0 = p[g * EPG]; bq1 = p[g * EPG + 1]; bq2 = p[g * EPG + 2]; bq3 = p[g * EPG + 3]; } }
    int i1 = 0; float p1 = bq0;
    if (bq1 > p1) { p1 = bq1; i1 = 1; } if (bq2 > p1) { p1 = bq2; i1 = 2; } if (bq3 > p1) { p1 = bq3; i1 = 3; }
    int i2 = -1; float p2 = -1.f;
    if (i1 != 0 && bq0 > p2) { p2 = bq0; i2 = 0; } if (i1 != 1 && bq1 > p2) { p2 = bq1; i2 = 1; } if (i1 != 2 && bq2 > p2) { p2 = bq2; i2 = 2; } if (i1 != 3 && bq3 > p2) { p2 = bq3; i2 = 3; }
    e1 = gsel * EPG + i1; e2 = gsel * EPG + i2; const float inv = 1.0f / (p1 + p2); g1 = p1 * inv; g2 = p2 * inv;
}
__device__ __forceinline__ void p_ln1_route(Frame& F, int layer, const float* YPRE, bool dummy = false) {
    F.retid();
    LAS float* wrT = (LAS float*)F.lds;
    LAS int* rt = (LAS int*)(F.lds + 65536);
    LAS int* re = rt; LAS int* rlp = rt + 128; LAS float* rg = (LAS float*)(rt + 256); LAS int* lcount = rt + 384; LAS int* gbase = rt + 400;
    { const float* wr = F.I(21);
      for (int idx = F.tid; idx < D * NE / 4; idx += NTHREADS) { const f32x4 v = *(const f32x4*)(wr + idx * 4); const int c = idx >> 2, e4 = (idx & 3) * 4;
          wrT[(e4 + 0) * D + c] = v[0]; wrT[(e4 + 1) * D + c] = v[1]; wrT[(e4 + 2) * D + c] = v[2]; wrT[(e4 + 3) * D + c] = v[3]; } }
    const float* g1p = F.I(1) + layer * D; const float* b1p = F.I(2) + layer * D; const float* br = F.I(22);
    bf16_t* X1 = F.W<bf16_t>(WS_X1); unsigned* gcount = F.ctl() + CW_GCOUNT + 32 * layer + (dummy ? 16 : 0);
    int* LIST = F.W<int>(WS_LIST); int* TOKSLOT = F.W<int>(WS_TOKSLOT); float* TOKGATE = F.W<float>(WS_TOKGATE); unsigned char* X1Q = F.W<unsigned char>(WS_X1Q); (void)X1Q;
    const int lane = F.lane;
    for (int tb = F.vcu; tb < T / 64; tb += F.G) {
        if (F.tid < NE) lcount[F.tid] = 0;
        __syncthreads();
        const int tok0 = tb * 64;
        f32x4 xn[4];
        { const float* yr = YPRE + (size_t)(tok0 + F.wave * 8) * D + 4 * lane;
#pragma unroll
          for (int j = 0; j < 4; ++j) xn[j] = *(const f32x4*)(yr + 256 * j); }
#pragma unroll 1
        for (int r = 0; r < 8; ++r) {
            const int rl = F.wave * 8 + r;
            f32x4 x[4]; float lg[NE];
#pragma unroll
            for (int j = 0; j < 4; ++j) x[j] = xn[j];
            if (r < 7) { const float* yr = YPRE + (size_t)(tok0 + rl + 1) * D + 4 * lane;
#pragma unroll
                for (int j = 0; j < 4; ++j) xn[j] = *(const f32x4*)(yr + 256 * j); }
            float s = 0.f;
#pragma unroll
            for (int j = 0; j < 4; ++j) s += (x[j][0] + x[j][1]) + (x[j][2] + x[j][3]);
            const float mean = wave_sum(s) * (1.0f / D); float q = 0.f;
#pragma unroll
            for (int j = 0; j < 4; ++j) { x[j] = x[j] - mean; q += (x[j][0] * x[j][0] + x[j][1] * x[j][1]) + (x[j][2] * x[j][2] + x[j][3] * x[j][3]); }
            const float rstd = 1.0f / sqrtf(wave_sum(q) * (1.0f / D) + LN_EPS);
#pragma unroll
            for (int j = 0; j < 4; ++j) { const f32x4 gg = *(const f32x4*)(g1p + 256 * j + 4 * lane), bb = *(const f32x4*)(b1p + 256 * j + 4 * lane);
                x[j] = x[j] * rstd * gg + bb;
                u32x2 w; w.x = cvt_pk_bf16(x[j][0], x[j][1]); w.y = cvt_pk_bf16(x[j][2], x[j][3]);
                *(u32x2*)(X1 + (size_t)(tok0 + rl) * D + 256 * j + 4 * lane) = w;
#if MOE_FP8
                *(unsigned*)(X1Q + (size_t)(tok0 + rl) * D + 256 * j + 4 * lane) = pack4_fp8(x[j][0], x[j][1], x[j][2], x[j][3]);
#endif
            }
#pragma unroll
            for (int e = 0; e < NE; ++e) { float a = 0.f;
#pragma unroll
                for (int j = 0; j < 4; ++j) { const f32x4 w = *(const LAS f32x4*)(wrT + e * D + 256 * j + 4 * lane);
                    a += (x[j][0] * w[0] + x[j][1] * w[1]) + (x[j][2] * w[2] + x[j][3] * w[3]); }
                lg[e] = a; }
            float a8[8], a4[4], a2[2], a1;
#pragma unroll
            for (int i = 0; i < 8; ++i) { const bool hi = lane & 1; const float send = hi ? lg[2 * i] : lg[2 * i + 1], keep = hi ? lg[2 * i + 1] : lg[2 * i]; a8[i] = keep + dpp_xor1(send); }
#pragma unroll
            for (int i = 0; i < 4; ++i) { const bool hi = lane & 2; const float send = hi ? a8[2 * i] : a8[2 * i + 1], keep = hi ? a8[2 * i + 1] : a8[2 * i]; a4[i] = keep + dpp_xor2(send); }
#pragma unroll
            for (int i = 0; i < 2; ++i) { const bool hi = lane & 4; const float send = hi ? a4[2 * i] : a4[2 * i + 1], keep = hi ? a4[2 * i + 1] : a4[2 * i]; a2[i] = keep + swz_xor<4>(send); }
            { const bool hi = lane & 8; const float send = hi ? a2[0] : a2[1], keep = hi ? a2[1] : a2[0]; a1 = keep + swz_xor<8>(send); }
            a1 += swz_xor<16>(a1); a1 = half_sum(a1);
            float l[NE];
#pragma unroll
            for (int e = 0; e < NE; ++e) l[e] = __int_as_float(__builtin_amdgcn_readlane(__float_as_int(a1), e)) + br[e];
            int e1, e2; float g1, g2; route16(l, e1, e2, g1, g2);
            if (lane == 0) {
                const int lp1 = __hip_atomic_fetch_add(lcount + e1, 1, __ATOMIC_RELAXED, __HIP_MEMORY_SCOPE_WORKGROUP), lp2 = __hip_atomic_fetch_add(lcount + e2, 1, __ATOMIC_RELAXED, __HIP_MEMORY_SCOPE_WORKGROUP);
                re[2 * rl] = e1; re[2 * rl + 1] = e2; rlp[2 * rl] = lp1; rlp[2 * rl + 1] = lp2; rg[2 * rl] = g1; rg[2 * rl + 1] = g2; }
        }
        __syncthreads();
        if (F.tid < NE) gbase[F.tid] = (int)__hip_atomic_fetch_add(gcount + F.tid, (unsigned)lcount[F.tid], RLX_AGENT);
        __syncthreads();
        if (F.tid < 128) { const int e = re[F.tid], pos = gbase[e] + rlp[F.tid], tok = tok0 + (F.tid >> 1);
            LIST[e * T + pos] = tok; TOKSLOT[tok * 2 + (F.tid & 1)] = e * T + pos; TOKGATE[tok * 2 + (F.tid & 1)] = rg[F.tid]; }
        __syncthreads();
    }
}

__device__ __forceinline__ void p_combine(Frame& F, int layer) {
    F.retid();
    const unsigned* gcount = F.ctl() + CW_GCOUNT + 32 * layer;
    const int lane = F.lane;
    int pre = 0;
#pragma unroll
    for (int j = 0; j < NE - 1; ++j) { const int cnt = (int)__builtin_amdgcn_readfirstlane(__hip_atomic_load(gcount + j, RLX_AGENT)); pre += ((lane & 15) > j) ? ((cnt + 255) >> 8) * 256 : 0; }
    const bf16_t* X1 = F.W<bf16_t>(WS_X1); const bf16_t* Y = F.W<bf16_t>(WS_Y); const int* TOKSLOT = F.W<int>(WS_TOKSLOT); const float* TOKGATE = F.W<float>(WS_TOKGATE);
    const float* g2p = F.I(3) + layer * D; const float* b2p = F.I(4) + layer * D;
    bf16_t* X2 = F.W<bf16_t>(WS_X2);
    for (int tb = F.vcu * NWAVES + F.wave; tb < T / 8; tb += F.G * NWAVES) {
#pragma unroll 2
        for (int i = 0; i < 8; ++i) { const int t = tb * 8 + i;
            const int s0 = __builtin_amdgcn_readfirstlane(TOKSLOT[2 * t]), s1 = __builtin_amdgcn_readfirstlane(TOKSLOT[2 * t + 1]);
            const float g0 = TOKGATE[2 * t], g1 = TOKGATE[2 * t + 1];
            const int r0 = __builtin_amdgcn_readlane(pre, s0 >> 14) + (s0 & (T - 1)), r1 = __builtin_amdgcn_readlane(pre, s1 >> 14) + (s1 & (T - 1));
            f32x4 v[4]; float s = 0.f;
#pragma unroll
            for (int j = 0; j < 4; ++j) { const u32x2 xw = *(const u32x2*)(X1 + (size_t)t * D + 256 * j + 4 * lane), y0 = *(const u32x2*)(Y + (size_t)r0 * D + 256 * j + 4 * lane), y1 = *(const u32x2*)(Y + (size_t)r1 * D + 256 * j + 4 * lane);
                v[j][0] = ALPHA * bf_lo(xw.x) + (g0 * bf_lo(y0.x) + g1 * bf_lo(y1.x)); v[j][1] = ALPHA * bf_hi(xw.x) + (g0 * bf_hi(y0.x) + g1 * bf_hi(y1.x));
                v[j][2] = ALPHA * bf_lo(xw.y) + (g0 * bf_lo(y0.y) + g1 * bf_lo(y1.y)); v[j][3] = ALPHA * bf_hi(xw.y) + (g0 * bf_hi(y0.y) + g1 * bf_hi(y1.y));
                s += (v[j][0] + v[j][1]) + (v[j][2] + v[j][3]); }
            const float mean = wave_sum(s) * (1.0f / D); float q = 0.f;
#pragma unroll
            for (int j = 0; j < 4; ++j) { v[j] = v[j] - mean; q += (v[j][0] * v[j][0] + v[j][1] * v[j][1]) + (v[j][2] * v[j][2] + v[j][3] * v[j][3]); }
            const float rstd = 1.0f / sqrtf(wave_sum(q) * (1.0f / D) + LN_EPS);
#pragma unroll
            for (int j = 0; j < 4; ++j) { const f32x4 gg = *(const f32x4*)(g2p + 256 * j + 4 * lane), bb = *(const f32x4*)(b2p + 256 * j + 4 * lane); const f32x4 o = v[j] * rstd * gg + bb;
                if (layer == 0) { u32x2 w; w.x = cvt_pk_bf16(o[0], o[1]); w.y = cvt_pk_bf16(o[2], o[3]); *(u32x2*)(X2 + (size_t)t * D + 256 * j + 4 * lane) = w; }
                else *(f32x4*)(F.out + (size_t)t * D + 256 * j + 4 * lane) = o; }
        }
    }
}

__device__ __forceinline__ void p_conv4(Frame& F) {
    F.retid();
    const bf16_t* XR = F.W<bf16_t>(WS_XR); bf16_t* XC = F.W<bf16_t>(WS_XC); const float* w = F.I(13); const float* bias = F.I(14);
    const int lane = F.lane;
#pragma unroll 1
    for (int it = F.vcu * NWAVES + F.wave; it < (T / 8) * 2; it += F.G * NWAVES) {
        const int tb = it >> 1, c0 = 8 * lane + 512 * (it & 1), t0 = tb * 8, s0 = t0 & (SEQ - 1);
        f32x4 wk[CONVC][2], bs[2];
#pragma unroll
        for (int k = 0; k < CONVC; ++k) { wk[k][0] = *(const f32x4*)(w + k * DRNN + c0); wk[k][1] = *(const f32x4*)(w + k * DRNN + c0 + 4); }
        bs[0] = *(const f32x4*)(bias + c0); bs[1] = *(const f32x4*)(bias + c0 + 4);
        u32x4 in[11];
#pragma unroll
        for (int j = 0; j < 11; ++j) { const int d = 3 - j; const bool ok = (s0 - d >= 0); const size_t rr = ok ? (size_t)(t0 - d) : (size_t)t0;
            in[j] = *(const u32x4*)(XR + rr * DRNN + c0); if (!ok) in[j] = (u32x4){0u, 0u, 0u, 0u}; }
#pragma unroll
        for (int r = 0; r < 8; ++r) { f32x4 a0 = bs[0], a1 = bs[1];
#pragma unroll
            for (int k = 0; k < CONVC; ++k) { const u32x4 xw = in[r + k];
                a0 += wk[k][0] * (f32x4){bf_lo(xw.x), bf_hi(xw.x), bf_lo(xw.y), bf_hi(xw.y)}; a1 += wk[k][1] * (f32x4){bf_lo(xw.z), bf_hi(xw.z), bf_lo(xw.w), bf_hi(xw.w)}; }
            *(u32x4*)(XC + (size_t)(t0 + r) * DRNN + c0) = pg8::pack8(a0, a1); }
    }
}

constexpr int SCH = 64, NCHUNK = SEQ / SCH;
__device__ __forceinline__ void p_scan1(Frame& F) {
    F.retid();
    const bf16_t* L2A = F.W<bf16_t>(WS_XR); const bf16_t* BV = F.W<bf16_t>(WS_BV); float* AGG = F.W<float>(WS_AGG);
    for (int task = F.vcu * NWAVES + F.wave; task < BATCH * NCHUNK * 8; task += F.G * NWAVES) {
        const int bc = task >> 3, c = (task & 7) * 128 + 2 * F.lane; const size_t base = (size_t)bc * SCH * DRNN + c;
        float sl0 = 0.f, sl1 = 0.f, h0 = 0.f, h1 = 0.f;
#pragma unroll 16
        for (int s = 0; s < SCH; ++s) { const unsigned lw = *(const unsigned*)(L2A + base + (size_t)s * DRNN), bw = *(const unsigned*)(BV + base + (size_t)s * DRNN);
            const float l0 = bf_lo(lw), l1 = bf_hi(lw); sl0 += l0; sl1 += l1;
            h0 = __builtin_amdgcn_exp2f(l0) * h0 + bf_lo(bw); h1 = __builtin_amdgcn_exp2f(l1) * h1 + bf_hi(bw); }
        *(f32x4*)(AGG + ((size_t)bc * DRNN + c) * 2) = (f32x4){sl0, h0, sl1, h1};
    }
}
__device__ __forceinline__ void p_scan2(Frame& F, bool dummy = false) {
    F.retid();
    const bf16_t* L2A = F.W<bf16_t>(WS_XR); const bf16_t* BV = F.W<bf16_t>(WS_BV); const float* AGG = F.W<float>(WS_AGG); bf16_t* GY = F.W<bf16_t>(WS_GY); bf16_t* OUTB = dummy ? F.W<bf16_t>(WS_XC) : GY;
#pragma unroll 1
    for (int task = F.vcu * NWAVES + F.wave; task < BATCH * NCHUNK * 8; task += F.G * NWAVES) {
        const int bc = task >> 3, c = (task & 7) * 128 + 2 * F.lane; const int b = bc / NCHUNK, ch = bc % NCHUNK;
        float h0 = 0.f, h1 = 0.f;
#pragma unroll 1
        for (int j0 = 0; j0 < ch; j0 += 16) { f32x4 g[16];
#pragma unroll
            for (int i = 0; i < 16; ++i) { const int j = j0 + i; const int jc = j < ch ? j : ch - 1; g[i] = *(const f32x4*)(AGG + ((size_t)(b * NCHUNK + jc) * DRNN + c) * 2); if (j >= ch) g[i] = (f32x4){0.f, 0.f, 0.f, 0.f}; }
#pragma unroll
            for (int i = 0; i < 16; ++i) { h0 = __builtin_amdgcn_exp2f(g[i][0]) * h0 + g[i][1]; h1 = __builtin_amdgcn_exp2f(g[i][2]) * h1 + g[i][3]; } }
        const size_t base = (size_t)bc * SCH * DRNN + c;
#pragma unroll 1
        for (int s0 = 0; s0 < SCH; s0 += 16) { unsigned lw[16], bw[16], gw[16];
#pragma unroll
            for (int i = 0; i < 16; ++i) { const size_t o = base + (size_t)(s0 + i) * DRNN; lw[i] = *(const unsigned*)(L2A + o); bw[i] = *(const unsigned*)(BV + o); gw[i] = *(const unsigned*)(GY + o); }
#pragma unroll
            for (int i = 0; i < 16; ++i) { h0 = __builtin_amdgcn_exp2f(bf_lo(lw[i])) * h0 + bf_lo(bw[i]); h1 = __builtin_amdgcn_exp2f(bf_hi(lw[i])) * h1 + bf_hi(bw[i]);
                gw[i] = cvt_pk_bf16(bf_lo(gw[i]) * h0, bf_hi(gw[i]) * h1); }
#pragma unroll
            for (int i = 0; i < 16; ++i) *(unsigned*)(OUTB + base + (size_t)(s0 + i) * DRNN) = gw[i]; }
    }
}

constexpr int NPH = 18;
#ifndef N_LAUNCHES
#define N_LAUNCHES 1
#endif
__global__ void __launch_bounds__(NTHREADS, 2) mega_fwd(Args args) {
    extern __shared__ __attribute__((aligned(16))) unsigned char lds_raw[];
    Frame F;
    F.lds = (LAS unsigned char*)lds_raw; F.ws = args.ws; F.in = args.in; F.out = args.out;
    F.tid = threadIdx.x; F.lane = F.tid & 63; F.wave = __builtin_amdgcn_readfirstlane(F.tid >> 6);
    F.G = gridDim.x; { const int bx = blockIdx.x; F.vcu = (F.G % 8 == 0) ? (bx % 8) * (F.G / 8) + bx / 8 : bx; }
    for (int u = F.tid; u < (LDS_BYTES - LDSCTL_OFF) / 4; u += NTHREADS) ((LAS unsigned*)(F.lds + LDSCTL_OFF))[u] = 0u;
    __syncthreads();
    XcdBarrier bar; bar.bar = F.ctl() + CW_BAR; bar.x = 0; bar.st = nullptr; bar.wave = F.wave;
    if (N_LAUNCHES == 1) bar = xcd_barrier_post(F.ctl() + CW_BAR, (volatile LAS unsigned*)(F.lds + MISC_OFF) + 8, F.wave);
    const int lo = args.ph_lo, hi = args.ph_hi;
#ifndef PH_MASK
#define PH_MASK 0x3ffff
#endif
#define IN(k) (((PH_MASK >> (k)) & 1) && lo <= (k) && (k) < hi)
#define SEAM(k) do { if (IN(k) && IN((k) + 1)) xcd_barrier(bar); } while (0)
    const int cblk = (int)blockIdx.x;

#ifndef REP_MASK
#define REP_MASK 0
#endif
#ifndef EXTRA_BARS
#define EXTRA_BARS 0
#endif
#define REPS(k) ((((REP_MASK) >> ((k) % 32)) & 1) ? 2 : 1)
#define PHASE(k, ...) do { if (IN(k)) { for (int rep_ = 0; rep_ < REPS(k); ++rep_) { __VA_ARGS__; if (rep_ + 1 < REPS(k)) xcd_barrier(bar); } } SEAM(k); } while (0)
    for (int i = 0; i < EXTRA_BARS; ++i) xcd_barrier(bar);
    PHASE(0, p0_prologue(F));
    PHASE(1, { DenseOrder S{F.W<char>(WS_X2), F.W<char>(WS_WIN0), (size_t)256 * D * 2, (size_t)256 * D * 2, T / 256, DIN0 / 256, F.G, cblk};
        pg8::EpiIn0 E{F.W<bf16_t>(WS_U0)}; pg8::gemm_phase<pg8::EpiIn0, DenseOrder, false>(F.lds, F.wave, 2 * D, 2 * D, 2 * D, S, E); });
    PHASE(2, p_mix0(F));
    PHASE(3, { DenseOrder S{F.W<char>(WS_CAT0), F.W<char>(WS_WOUT0), (size_t)256 * D * 2, (size_t)256 * D * 2, T / 256, D / 256, F.G, cblk};
        pg8::EpiRes<false> E{F.I(0), F.W<float>(WS_YPRE0)}; pg8::gemm_phase<pg8::EpiRes<false>, DenseOrder, false>(F.lds, F.wave, 2 * D, 2 * D, 2 * D, S, E); });
    PHASE(4, p_ln1_route(F, 0, F.W<float>(WS_YPRE0), rep_ + 1 < REPS(4)));
#pragma unroll 1
    for (int layer = 0; layer < 2; ++layer) {
        const int pb = layer == 0 ? 5 : 15;
#if MOE_FP8
        PHASE(pb, { const int nu = moe_setup(F, layer, 2 * DEXP / 256, true, D);
            MoeOrder S{(LAS const int*)(F.lds + UNITS_OFF), nu, F.W<char>(WS_X1Q), F.W<char>(WS_W13) + (size_t)layer * NE * 2 * DEXP * D, (size_t)2 * DEXP * D, (size_t)256 * D, 0, true};
            pg8::EpiMoe1Q E{F.W<unsigned char>(WS_H)}; pg8::gemm_phase<pg8::EpiMoe1Q, MoeOrder, true, 1>(F.lds, F.wave, D, D, D, S, E, 0x01010101 * (127 - SCL_W13 / 2)); });
        PHASE(pb + 1, { const int nu = moe_setup(F, layer, D / 256, false, 0);
            MoeOrder S{(LAS const int*)(F.lds + UNITS_OFF), nu, F.W<char>(WS_H), F.W<char>(WS_W2) + (size_t)layer * NE * D * DEXP, (size_t)D * DEXP, (size_t)256 * DEXP, (size_t)256 * DEXP, false};
            pg8::EpiMoe2 E{F.W<bf16_t>(WS_Y)}; pg8::gemm_phase<pg8::EpiMoe2, MoeOrder, false, 1>(F.lds, F.wave, DEXP, DEXP, DEXP, S, E, 0x01010101 * (127 - SCL_W2 / 2)); });
#else
        PHASE(pb, { const int nu = moe_setup(F, layer, 2 * DEXP / 256, true, 2 * D);
            MoeOrder S{(LAS const int*)(F.lds + UNITS_OFF), nu, F.W<char>(WS_X1), F.W<char>(WS_W13) + (size_t)layer * NE * 2 * DEXP * D * 2, (size_t)2 * DEXP * D * 2, (size_t)256 * D * 2, 0, true};
            pg8::EpiMoe1 E{F.W<bf16_t>(WS_H)}; pg8::gemm_phase<pg8::EpiMoe1, MoeOrder, true>(F.lds, F.wave, 2 * D, 2 * D, 2 * D, S, E); });
        PHASE(pb + 1, { const int nu = moe_setup(F, layer, D / 256, false, 0);
            MoeOrder S{(LAS const int*)(F.lds + UNITS_OFF), nu, F.W<char>(WS_H), F.W<char>(WS_W2) + (size_t)layer * NE * D * DEXP * 2, (size_t)D * DEXP * 2, (size_t)256 * DEXP * 2, (size_t)256 * DEXP * 2, false};
            pg8::EpiMoe2 E{F.W<bf16_t>(WS_Y)}; pg8::gemm_phase<pg8::EpiMoe2, MoeOrder, false>(F.lds, F.wave, 2 * DEXP, 2 * DEXP, 2 * DEXP, S, E); });
#endif
        PHASE(pb + 2, p_combine(F, layer));
        if (layer == 0) {
            PHASE(8, { DenseOrder S{F.W<char>(WS_X2), F.W<char>(WS_WIN1), (size_t)256 * D * 2, (size_t)256 * D * 2, T / 256, 2 * DRNN / 256, F.G, cblk};
                pg8::EpiIn1 E{F.W<bf16_t>(WS_GY), F.W<bf16_t>(WS_XR)}; pg8::gemm_phase<pg8::EpiIn1, DenseOrder, false>(F.lds, F.wave, 2 * D, 2 * D, 2 * D, S, E); });
            PHASE(9, p_conv4(F));
            PHASE(10, { GatesOrder S{F.W<char>(WS_XC), F.W<char>(WS_WGT), F.G, cblk};
                pg8::EpiGates E{F.W<bf16_t>(WS_XC), F.I(16), F.I(18), F.W<float>(WS_SPL), F.W<bf16_t>(WS_XR), F.W<bf16_t>(WS_BV)};
                pg8::gemm_phase<pg8::EpiGates, GatesOrder, false>(F.lds, F.wave, 2 * DRNN, 2 * RBLK, 2 * RBLK, S, E); });
            PHASE(11, p_scan1(F));
            PHASE(12, p_scan2(F, rep_ + 1 < REPS(12)));
            PHASE(13, { DenseOrder S{F.W<char>(WS_GY), F.W<char>(WS_WOUT1), (size_t)256 * DRNN * 2, (size_t)256 * DRNN * 2, T / 256, D / 256, F.G, cblk};
                pg8::EpiRes<true> E{F.W<bf16_t>(WS_X2), F.W<float>(WS_YPRE1)}; pg8::gemm_phase<pg8::EpiRes<true>, DenseOrder, false>(F.lds, F.wave, 2 * DRNN, 2 * DRNN, 2 * DRNN, S, E); });
            PHASE(14, p_ln1_route(F, 1, F.W<float>(WS_YPRE1), rep_ + 1 < REPS(14)));
        }
    }
#undef PHASE
#undef REPS
#undef IN
#undef SEAM
}

static int g_grid = 0;
static inline bool fast_setup() {
    if (g_grid == 0) {
        int dev = 0, cus = 0, per_cu = 0;
        if (hipGetDevice(&dev) != hipSuccess || hipDeviceGetAttribute(&cus, hipDeviceAttributeMultiprocessorCount, dev) != hipSuccess) { fprintf(stderr, "kernel_launch: device query failed\n"); g_grid = -1; return false; }
        if (hipFuncSetAttribute((const void*)mega_fwd, hipFuncAttributeMaxDynamicSharedMemorySize, LDS_BYTES) != hipSuccess) { fprintf(stderr, "kernel_launch: hipFuncSetAttribute failed\n"); g_grid = -1; return false; }
        if (hipOccupancyMaxActiveBlocksPerMultiprocessor(&per_cu, (const void*)mega_fwd, NTHREADS, LDS_BYTES) != hipSuccess || per_cu < 1) { fprintf(stderr, "kernel_launch: occupancy query says %d blocks per CU\n", per_cu); (void)hipGetLastError(); per_cu = 1; }
        g_grid = cus;
        if (g_grid > 256) g_grid = 256;
    }
    return g_grid > 0;
}
static inline void fast_launch(void* const* d_in, void* d_out, void* d_ws, hipStream_t stream, int lo, int hi) {
    Args a{};
    for (int i = 0; i < 26; ++i) a.in[i] = (const float*)d_in[i];
    a.out = (float*)d_out; a.ws = (unsigned char*)d_ws; a.ph_lo = lo; a.ph_hi = hi;
    hipLaunchKernelGGL(mega_fwd, dim3(g_grid), dim3(NTHREADS), LDS_BYTES, stream, a);
}
extern "C" void kernel_launch(void* const* d_in, const int* in_sizes, int n_in, void* d_out, int out_size, void* d_ws, size_t ws_size, hipStream_t stream) {
    if (n_in != 26 || out_size != T * D || ws_size < WS_FAST_END) { fprintf(stderr, "kernel_launch: unexpected shapes (n_in %d out %d ws %zu)\n", n_in, out_size, ws_size); return; }
    if (!fast_setup()) return;
    if (hipMemsetAsync((char*)d_ws + WS_CTL, 0, CTL_ZERO_BYTES, stream) != hipSuccess) { fprintf(stderr, "kernel_launch: memset failed\n"); return; }
    if (N_LAUNCHES == 1) fast_launch(d_in, d_out, d_ws, stream, 0, NPH);
    else for (int p = 0; p < NPH; ++p) fast_launch(d_in, d_out, d_ws, stream, p, p + 1);
}
```

```cpp
#define BUILD_MODE 1
#define N_LAUNCHES 1
#include <hip/hip_runtime.h>
#include <cstdio>
#include <cstdint>
#include <cmath>
constexpr int D = 1024, BATCH = 2, SEQ = 8192, T = BATCH * SEQ, DEPTH = 2;
constexpr int DA = 512, DB = 512, DIN0 = 2 * DA + 3 * DB, CONVA = 31, CONVB = 3;
constexpr int DRNN = 1024, RBLK = 256, RHEADS = 4, CONVC = 4;
constexpr int NE = 16, NG = 4, EPG = 4, DEXP = 1024;
constexpr float LN_EPS = 1e-5f, ALPHA = 1.41421356237309515f;
#define LAS __attribute__((address_space(3)))
#define GAS __attribute__((address_space(1)))
typedef unsigned short bf16_t;
typedef short bf16x8 __attribute__((ext_vector_type(8)));
typedef float f32x4 __attribute__((ext_vector_type(4)));
typedef float f32x2 __attribute__((ext_vector_type(2)));
typedef unsigned u32x4 __attribute__((ext_vector_type(4)));
typedef unsigned u32x2 __attribute__((ext_vector_type(2)));
typedef GAS unsigned gu32;
#define RLX_AGENT __ATOMIC_RELAXED, __HIP_MEMORY_SCOPE_AGENT
#define LDS_WAIT() asm volatile("s_waitcnt lgkmcnt(0)" ::: "memory")
#define VM_WAIT() asm volatile("s_waitcnt vmcnt(0)" ::: "memory")

__device__ __forceinline__ unsigned cvt_pk_bf16(float lo, float hi) { unsigned r; asm volatile("v_cvt_pk_bf16_f32 %0, %1, %2" : "=v"(r) : "v"(lo), "v"(hi)); return r; }
__device__ __forceinline__ unsigned pack4_fp8(float a, float b, float c, float d) { int r = __builtin_amdgcn_cvt_pk_fp8_f32(a, b, 0, false); r = __builtin_amdgcn_cvt_pk_fp8_f32(c, d, r, true); return (unsigned)r; }
__device__ __forceinline__ float bf_lo(unsigned u) { return __uint_as_float(u << 16); }
__device__ __forceinline__ float bf_hi(unsigned u) { return __uint_as_float(u & 0xffff0000u); }
__device__ __forceinline__ float fsigmoid(float x) { return __builtin_amdgcn_rcpf(1.0f + __builtin_amdgcn_exp2f(-1.4426950408889634f * x)); }
__device__ __forceinline__ float fsilu(float x) { return x * fsigmoid(x); }
__device__ __forceinline__ float fgelu_tanh(float x) { return x * fsigmoid(1.5957691216057308f * (x + 0.044715f * x * x * x)); }
__device__ __forceinline__ float dpp_xor1(float v) { return __int_as_float(__builtin_amdgcn_mov_dpp(__float_as_int(v), 0xB1, 0xF, 0xF, true)); }
__device__ __forceinline__ float dpp_xor2(float v) { return __int_as_float(__builtin_amdgcn_mov_dpp(__float_as_int(v), 0x4E, 0xF, 0xF, true)); }
template <int M> __device__ __forceinline__ float swz_xor(float v) { return __int_as_float(__builtin_amdgcn_ds_swizzle(__float_as_int(v), (M << 10) | 0x1F)); }
__device__ __forceinline__ float half_sum(float v) { const auto r = __builtin_amdgcn_permlane32_swap(__float_as_uint(v), __float_as_uint(v), false, false); return __uint_as_float(r[0]) + __uint_as_float(r[1]); }
__device__ __forceinline__ float wave_sum(float v) { v += dpp_xor1(v); v += dpp_xor2(v); v += swz_xor<4>(v); v += swz_xor<8>(v); v += swz_xor<16>(v); return half_sum(v); }
__device__ __forceinline__ int lane_id_asm() { int l; asm volatile("v_mbcnt_lo_u32_b32 %0, -1, 0\n\tv_mbcnt_hi_u32_b32 %0, -1, %0" : "=v"(l)); return l; }

namespace pg8 {
constexpr int BM = 256, BK = 64, HALF = 128, HTB = HALF * BK * 2, STAGE_BYTES = 8 * HTB, NXCD = 8, WGM = 8;
__host__ __device__ __forceinline__ int lds_byte(int r, int c) { const int st = (r >> 4) * 2 + (c >> 5), rr = r & 15, cc = c & 31, ob = rr * 64 + cc * 2; return st * 1024 + (ob ^ (((ob >> 9) & 1) << 5)); }
__host__ __device__ __forceinline__ void stage_rc(int b, int& R, int& C) { const int st = b / 1024, sb = b % 1024, swz = sb ^ (((sb >> 9) & 1) << 5); R = (st >> 1) * 16 + swz / 64; C = (st & 1) * 32 + (swz % 64) / 2; }
__host__ __device__ __forceinline__ int perm32(int rho) { const int n = rho >> 4, i = rho & 15; return 8 * (i >> 2) + 4 * n + (i & 3); }

struct Unit { const char* A; const char* B; int row0, pn, e, gtab; };
__device__ __forceinline__ bool tile_of(int i, int G, int c, int nM, int nN, int& pm, int& pn) {
    const int nwg = nM * nN; const long L = (long)i * G + c; if (L >= nwg) return false;
    int wgid = (int)L; { const int q = nwg / NXCD, r = nwg % NXCD, xcd = wgid % NXCD, off = wgid / NXCD; wgid = (xcd < r ? xcd * (q + 1) : r * (q + 1) + (xcd - r) * q) + off; }
    const int nig = WGM * nN, gid = wgid / nig, fm = gid * WGM, gsz = (nM - fm) < WGM ? (nM - fm) : WGM;
    pm = fm + ((wgid % nig) % gsz); pn = (wgid % nig) / gsz; return true;
}

typedef int i32x8 __attribute__((ext_vector_type(8)));
typedef int i32x4 __attribute__((ext_vector_type(4)));
template <class Epi, class Sched, bool GATHER, int FMT = 0>
__device__ __forceinline__ void gemm_phase(LAS unsigned char* lds, const int wid_in, const int lda, const int ldb, const int KB, const Sched& S, const Epi& E, const int sclb = 0x7f7f7f7f) {
    const int lane = lane_id_asm(), wid = wid_in, tid = wid * 64 + lane, wr = wid >> 2, wc = wid & 3, fr = lane & 15, fq = lane >> 4;
    const int nt = KB / 128;
    int sclr = sclb; if constexpr (FMT == 1) asm volatile("" : "+v"(sclr));
    unsigned voffA[2], voffB[2];
#pragma unroll
    for (int i = 0; i < 2; ++i) { int R, C; stage_rc(tid * 16 + i * 8192, R, C); const int Rb = Epi::PERM ? ((R & ~31) + perm32(R & 31)) : R;
        voffA[i] = (unsigned)(R * lda + C * 2); voffB[i] = (unsigned)(Rb * ldb + C * 2); }
    const size_t kstep = (size_t)(BK * 2);
    const size_t hstepA = (size_t)HALF * lda, hstepB = (size_t)HALF * ldb;
    const unsigned ldsw = (unsigned)wid * 1024u;
    const int aoff = lds_byte(wr * 64 + fr, fq * 8), boff = lds_byte(wc * 32 + fr, fq * 8);
#define PG8_SA(b, h) (((b) * 2 + (h)) * HTB)
#define PG8_SB(b, h) ((4 + (b) * 2 + (h)) * HTB)
#define PG8_ST2(bufoff, gbase, o0, o1) do { \
        __builtin_amdgcn_global_load_lds((const unsigned*)((const char*)(gbase) + (o0)), (LAS unsigned*)(lds + (bufoff) + ldsw), 16, 0, 0); \
        __builtin_amdgcn_global_load_lds((const unsigned*)((const char*)(gbase) + (o1)), (LAS unsigned*)(lds + (bufoff) + ldsw + 8192), 16, 0, 0); } while (0)
#define PG8_STB(bufoff, gbase, h) PG8_ST2(bufoff, (gbase) + (h) * hstepB, voffB[0], voffB[1])
#define PG8_STA(bufoff, gbase, h, G0, G1) do { if constexpr (GATHER) { PG8_ST2(bufoff, gbase, G0, G1); } else { PG8_ST2(bufoff, (gbase) + (h) * hstepA, voffA[0], voffA[1]); } } while (0)
#define PG8_CAT8(l_, h_) __builtin_shufflevector(l_, h_, 0, 1, 2, 3, 4, 5, 6, 7)
#define PG8_LO4(v_) __builtin_bit_cast(bf16x8, __builtin_shufflevector(v_, v_, 0, 1, 2, 3))
#define PG8_HI4(v_) __builtin_bit_cast(bf16x8, __builtin_shufflevector(v_, v_, 4, 5, 6, 7))
#define PG8_LDA(dst, b, h) do { _Pragma("unroll") for (int m = 0; m < 4; ++m) { const i32x4 l_ = *(const LAS i32x4*)(lds + PG8_SA(b, h) + aoff + m * 2048), h_ = *(const LAS i32x4*)(lds + PG8_SA(b, h) + aoff + m * 2048 + 1024); dst[m] = PG8_CAT8(l_, h_); } } while (0)
#define PG8_LDB(dst, b, h) do { _Pragma("unroll") for (int n = 0; n < 2; ++n) { const i32x4 l_ = *(const LAS i32x4*)(lds + PG8_SB(b, h) + boff + n * 2048), h_ = *(const LAS i32x4*)(lds + PG8_SB(b, h) + boff + n * 2048 + 1024); dst[n] = PG8_CAT8(l_, h_); } } while (0)
#define PG8_MMA(ai, bj, At, Bt) do { __builtin_amdgcn_s_setprio(1); _Pragma("unroll") for (int m = 0; m < 4; ++m) _Pragma("unroll") for (int n = 0; n < 2; ++n) { \
        if constexpr (FMT == 0) { acc[ai][bj][m][n] = __builtin_amdgcn_mfma_f32_16x16x32_bf16(PG8_LO4(Bt[n]), PG8_LO4(At[m]), acc[ai][bj][m][n], 0, 0, 0); \
                                  acc[ai][bj][m][n] = __builtin_amdgcn_mfma_f32_16x16x32_bf16(PG8_HI4(Bt[n]), PG8_HI4(At[m]), acc[ai][bj][m][n], 0, 0, 0); } \
        else asm volatile("v_mfma_scale_f32_16x16x128_f8f6f4 %0, %1, %2, %0, %3, %3 op_sel_hi:[0,0,0]" : "+v"(acc[ai][bj][m][n]) : "v"(Bt[n]), "v"(At[m]), "v"(sclr)); } \
        __builtin_amdgcn_s_setprio(0); } while (0)
#define PG8_WAIT_V(n) asm volatile("s_waitcnt vmcnt(" #n ")" ::: "memory")
#define PG8_WAIT_L(n) asm volatile("s_waitcnt lgkmcnt(" #n ")" ::: "memory")
#define PG8_BAR __builtin_amdgcn_s_barrier()
#define PG8_SCHED __builtin_amdgcn_sched_barrier(0)
    Unit cur, nxt; int ui = 0;
    if (!S.next(0, cur)) return;
    f32x4 acc[2][2][4][2];
#pragma unroll
    for (int a = 0; a < 2; ++a)
#pragma unroll
        for (int b = 0; b < 2; ++b)
#pragma unroll
            for (int m = 0; m < 4; ++m)
#pragma unroll
                for (int n = 0; n < 2; ++n) acc[a][b][m][n] = (f32x4){0.f, 0.f, 0.f, 0.f};
    i32x8 At[4], B0[2], B1[2];
    unsigned gc[2][2] = {{0u, 0u}, {0u, 0u}};
    if constexpr (GATHER) {
#pragma unroll
        for (int i = 0; i < 2; ++i) { int R, C; stage_rc(tid * 16 + i * 8192, R, C);
#pragma unroll
            for (int h = 0; h < 2; ++h) gc[h][i] = *(const LAS unsigned*)(lds + cur.gtab + (h * HALF + R) * 4) + (unsigned)C * 2u; }
    }
    const char* cA = cur.A; const char* cB = cur.B;
    PG8_STB(PG8_SB(0, 0), cB, 0); PG8_STB(PG8_SB(0, 1), cB, 1); PG8_STA(PG8_SA(0, 0), cA, 0, gc[0][0], gc[0][1]); PG8_STA(PG8_SA(0, 1), cA, 1, gc[1][0], gc[1][1]);
    if (wr == 1) PG8_BAR;
    PG8_WAIT_V(2); PG8_BAR;
    PG8_STB(PG8_SB(1, 0), cB + kstep, 0); PG8_STA(PG8_SA(1, 0), cA + kstep, 0, gc[0][0], gc[0][1]); PG8_STB(PG8_SB(1, 1), cB + kstep, 1);
    PG8_WAIT_V(6); PG8_BAR;
#define PG8_KITER(a1_, a2_, b2_, G00, G01, G10, G11) do { \
            const char* a3_ = (a2_) + kstep; const char* b3_ = (b2_) + kstep; \
              \
            PG8_LDB(B0, 0, 0); PG8_LDB(B1, 0, 1); PG8_SCHED; PG8_LDA(At, 0, 0); PG8_STA(PG8_SA(1, 1), a1_, 1, gc[1][0], gc[1][1]); \
            PG8_WAIT_V(8); PG8_WAIT_L(0); PG8_BAR; PG8_MMA(0, 0, At, B0); PG8_MMA(0, 1, At, B1); PG8_BAR; PG8_SCHED; \
              \
            PG8_LDA(At, 0, 1); PG8_STB(PG8_SB(0, 0), b2_, 0); PG8_STB(PG8_SB(0, 1), b2_, 1); PG8_STA(PG8_SA(0, 0), a2_, 0, G00, G01); \
            PG8_WAIT_V(8); PG8_WAIT_L(0); PG8_BAR; PG8_MMA(1, 0, At, B0); PG8_MMA(1, 1, At, B1); PG8_BAR; PG8_SCHED; \
              \
            PG8_LDB(B0, 1, 0); PG8_LDB(B1, 1, 1); PG8_SCHED; PG8_LDA(At, 1, 0); PG8_STA(PG8_SA(0, 1), a2_, 1, G10, G11); \
            PG8_WAIT_V(8); PG8_WAIT_L(0); PG8_BAR; PG8_MMA(0, 0, At, B0); PG8_MMA(0, 1, At, B1); PG8_BAR; PG8_SCHED; \
              \
            PG8_LDA(At, 1, 1); PG8_STB(PG8_SB(1, 0), b3_, 0); PG8_STB(PG8_SB(1, 1), b3_, 1); PG8_STA(PG8_SA(1, 0), a3_, 0, G00, G01); \
            PG8_WAIT_V(8); PG8_WAIT_L(0); PG8_BAR; PG8_MMA(1, 0, At, B0); PG8_MMA(1, 1, At, B1); PG8_BAR; PG8_SCHED; } while (0)
    for (;;) {
        const bool has_next = S.next(ui + 1, nxt);
        const char* nA = has_next ? nxt.A : cA; const char* nB = has_next ? nxt.B : cB;
        if constexpr (!GATHER) {
#pragma unroll 1
            for (int t = 0; t < nt; t += 2) {
                const bool last = (t == nt - 2);
                const char* a1 = cA + (size_t)(t + 1) * kstep;
                const char* a2 = last ? nA : cA + (size_t)(t + 2) * kstep; const char* b2 = last ? nB : cB + (size_t)(t + 2) * kstep;
                PG8_KITER(a1, a2, b2, 0u, 0u, 0u, 0u);
            }
        } else {
#pragma unroll 1
            for (int t = 0; t < nt - 2; t += 2) {
                const char* a1 = cA + (size_t)(t + 1) * kstep; const char* a2 = cA + (size_t)(t + 2) * kstep; const char* b2 = cB + (size_t)(t + 2) * kstep;
                PG8_KITER(a1, a2, b2, gc[0][0], gc[0][1], gc[1][0], gc[1][1]);
            }
            unsigned gn[2][2] = {{gc[0][0], gc[0][1]}, {gc[1][0], gc[1][1]}};
            if (has_next) {
                const int tid2 = wid * 64 + lane_id_asm();
#pragma unroll
                for (int i = 0; i < 2; ++i) { int R, C; stage_rc(tid2 * 16 + i * 8192, R, C);
#pragma unroll
                    for (int h = 0; h < 2; ++h) gn[h][i] = *(const LAS unsigned*)(lds + nxt.gtab + (h * HALF + R) * 4) + (unsigned)C * 2u; } }
            const char* a1 = cA + (size_t)(nt - 1) * kstep;
            PG8_KITER(a1, nA, nB, gn[0][0], gn[0][1], gn[1][0], gn[1][1]);
            gc[0][0] = gn[0][0]; gc[0][1] = gn[0][1]; gc[1][0] = gn[1][0]; gc[1][1] = gn[1][1];
        }
        if (wr == 0) PG8_BAR;
        if constexpr (FMT == 1) asm volatile("s_nop 15\n\ts_nop 15" ::: "memory");
        if constexpr (GATHER) { int fr2 = fr, fq2 = fq; asm volatile("" : "+v"(fr2), "+v"(fq2));
            E(acc, cur, wr, wc, fr2, fq2); }
        else E(acc, cur, wr, wc, fr, fq);
        if (!has_next) break;
#pragma unroll
        for (int a = 0; a < 2; ++a)
#pragma unroll
            for (int b = 0; b < 2; ++b)
#pragma unroll
                for (int m = 0; m < 4; ++m)
#pragma unroll
                    for (int n = 0; n < 2; ++n) acc[a][b][m][n] = (f32x4){0.f, 0.f, 0.f, 0.f};
        cur = nxt; cA = nA; cB = nB; ++ui;
        if (wr == 1) PG8_BAR;
    }
    PG8_WAIT_V(0);
    PG8_BAR;
#undef PG8_SA
#undef PG8_SB
#undef PG8_ST2
#undef PG8_STB
#undef PG8_STA
#undef PG8_LDA
#undef PG8_CAT8
#undef PG8_LO4
#undef PG8_HI4
#undef PG8_LDB
#undef PG8_MMA
#undef PG8_WAIT_V
#undef PG8_WAIT_L
#undef PG8_BAR
#undef PG8_SCHED
#undef PG8_KITER
}

typedef f32x4 AccT[2][2][4][2];
__device__ __forceinline__ u32x4 pack8(const f32x4 a, const f32x4 b) { u32x4 w; w.x = cvt_pk_bf16(a[0], a[1]); w.y = cvt_pk_bf16(a[2], a[3]); w.z = cvt_pk_bf16(b[0], b[1]); w.w = cvt_pk_bf16(b[2], b[3]); return w; }
template <int ACT> __device__ __forceinline__ void store_plain(const AccT& acc, bf16_t* O, int ldo, int row0, int col0, int wr, int wc, int fr, int fq) {
#pragma unroll
    for (int ai = 0; ai < 2; ++ai)
#pragma unroll
        for (int m = 0; m < 4; ++m) { bf16_t* rowp = O + (size_t)(row0 + ai * HALF + wr * 64 + m * 16 + fr) * ldo + col0 + wc * 32 + 8 * fq;
#pragma unroll
            for (int bj = 0; bj < 2; ++bj) { f32x4 v0 = acc[ai][bj][m][0], v1 = acc[ai][bj][m][1];
                if (ACT == 1) {
#pragma unroll
                    for (int j = 0; j < 4; ++j) { v0[j] = fgelu_tanh(v0[j]); v1[j] = fgelu_tanh(v1[j]); } }
                *(u32x4*)(rowp + bj * HALF) = pack8(v0, v1); } }
}
template <int MODE> __device__ __forceinline__ void store_pair(const AccT& acc, bf16_t* O, int ldo, int row0, int col0, int wr, int wc, int fr, int fq) {
#pragma unroll
    for (int ai = 0; ai < 2; ++ai)
#pragma unroll
        for (int m = 0; m < 4; ++m) { bf16_t* rowp = O + (size_t)(row0 + ai * HALF + wr * 64 + m * 16 + fr) * ldo + col0 + wc * 32 + 8 * fq;
            f32x4 o[2];
#pragma unroll
            for (int n = 0; n < 2; ++n) { const f32x4 v = acc[ai][0][m][n], g = acc[ai][1][m][n];
#pragma unroll
                for (int j = 0; j < 4; ++j) o[n][j] = MODE == 0 ? v[j] * fsigmoid(g[j]) : (MODE == 1 ? v[j] * g[j] : fsilu(v[j]) * g[j]); }
            *(u32x4*)rowp = pack8(o[0], o[1]); }
}
struct EpiIn0 {
    static constexpr bool PERM = true; bf16_t* U0;
    __device__ __forceinline__ void operator()(const AccT& acc, const Unit& u, int wr, int wc, int fr, int fq) const {
        if (u.pn < 4) store_pair<0>(acc, U0, 1536, u.row0, 128 * u.pn, wr, wc, fr, fq);
        else if (u.pn < 8) store_pair<1>(acc, U0, 1536, u.row0, 512 + 128 * (u.pn - 4), wr, wc, fr, fq);
        else store_plain<0>(acc, U0, 1536, u.row0, 1024 + 256 * (u.pn - 8), wr, wc, fr, fq);
    }
};
struct EpiIn1 {
    static constexpr bool PERM = true; bf16_t* GY; bf16_t* XR;
    __device__ __forceinline__ void operator()(const AccT& acc, const Unit& u, int wr, int wc, int fr, int fq) const {
        if (u.pn < 4) store_plain<1>(acc, GY, D, u.row0, 256 * u.pn, wr, wc, fr, fq);
        else store_plain<0>(acc, XR, D, u.row0, 256 * (u.pn - 4), wr, wc, fr, fq);
    }
};
__device__ __forceinline__ void store_pair_fp8(const AccT& acc, unsigned char* O, int ldo, int row0, int col0, int wr, int wc, int fr, int fq) {
#pragma unroll
    for (int ai = 0; ai < 2; ++ai)
#pragma unroll
        for (int m = 0; m < 4; ++m) { unsigned char* rowp = O + (size_t)(row0 + ai * HALF + wr * 64 + m * 16 + fr) * ldo + col0 + wc * 32 + 8 * fq;
            u32x2 w;
#pragma unroll
            for (int n = 0; n < 2; ++n) { const f32x4 v = acc[ai][0][m][n], g = acc[ai][1][m][n]; float o[4];
#pragma unroll
                for (int j = 0; j < 4; ++j) o[j] = fminf(fmaxf(fsilu(v[j]) * g[j], -448.f), 448.f);
                const unsigned pk = pack4_fp8(o[0], o[1], o[2], o[3]); if (n == 0) w.x = pk; else w.y = pk; }
            *(u32x2*)rowp = w; }
}
struct EpiMoe1Q { static constexpr bool PERM = true; unsigned char* H;
    __device__ __forceinline__ void operator()(const AccT& acc, const Unit& u, int wr, int wc, int fr, int fq) const { store_pair_fp8(acc, H, DEXP, u.row0, 128 * u.pn, wr, wc, fr, fq); } };
struct EpiMoe1 { static constexpr bool PERM = true; bf16_t* H;
    __device__ __forceinline__ void operator()(const AccT& acc, const Unit& u, int wr, int wc, int fr, int fq) const { store_pair<2>(acc, H, DEXP, u.row0, 128 * u.pn, wr, wc, fr, fq); } };
struct EpiMoe2 { static constexpr bool PERM = true; bf16_t* Y;
    __device__ __forceinline__ void operator()(const AccT& acc, const Unit& u, int wr, int wc, int fr, int fq) const { store_plain<0>(acc, Y, D, u.row0, 256 * u.pn, wr, wc, fr, fq); } };
template <bool RESBF> struct EpiRes { static constexpr bool PERM = false; const void* res; float* Y;
    __device__ __forceinline__ void operator()(const AccT& acc, const Unit& u, int wr, int wc, int fr, int fq) const {
#pragma unroll
        for (int ai = 0; ai < 2; ++ai)
#pragma unroll
            for (int m = 0; m < 4; ++m) { const size_t off = (size_t)(u.row0 + ai * HALF + wr * 64 + m * 16 + fr) * D + u.pn * 256 + wc * 32 + 4 * fq;
#pragma unroll
                for (int bj = 0; bj < 2; ++bj)
#pragma unroll
                    for (int n = 0; n < 2; ++n) { const size_t o = off + bj * HALF + n * 16; f32x4 r;
                        if (RESBF) { const u32x2 w = *(const u32x2*)((const bf16_t*)res + o); r = (f32x4){bf_lo(w.x), bf_hi(w.x), bf_lo(w.y), bf_hi(w.y)}; }
                        else r = *(const f32x4*)((const float*)res + o);
                        *(f32x4*)(Y + o) = r * ALPHA + acc[ai][bj][m][n]; } }
    }
};
struct EpiGates { static constexpr bool PERM = true; const bf16_t* XC; const float* ba; const float* bx; const float* spl; bf16_t* L2A; bf16_t* BV;
    __device__ __forceinline__ void operator()(const AccT& acc, const Unit& u, int wr, int wc, int fr, int fq) const {
        const int col = 128 * u.pn + wc * 32 + 8 * fq;
#pragma unroll
        for (int ai = 0; ai < 2; ++ai)
#pragma unroll
            for (int m = 0; m < 4; ++m) { const size_t o = (size_t)(u.row0 + ai * HALF + wr * 64 + m * 16 + fr) * DRNN + col;
                const u32x4 xw = *(const u32x4*)(XC + o); const float xv[8] = {bf_lo(xw.x), bf_hi(xw.x), bf_lo(xw.y), bf_hi(xw.y), bf_lo(xw.z), bf_hi(xw.z), bf_lo(xw.w), bf_hi(xw.w)};
                f32x4 la2[2], bo[2];
#pragma unroll
                for (int n = 0; n < 2; ++n) { const f32x4 cba = *(const f32x4*)(ba + col + 4 * n), cbx = *(const f32x4*)(bx + col + 4 * n), csp = *(const f32x4*)(spl + col + 4 * n);
#pragma unroll
                    for (int j = 0; j < 4; ++j) { const float r = fsigmoid(acc[ai][0][m][n][j] + cba[j]), ig = fsigmoid(acc[ai][1][m][n][j] + cbx[j]);
                        const float l2 = -1.4426950408889634f * csp[j] * r;
                        const float a = __builtin_amdgcn_exp2f(l2); la2[n][j] = l2; bo[n][j] = __builtin_sqrtf(fmaxf(1.0f - a * a, 0.f)) * (ig * xv[4 * n + j]); } }
                *(u32x4*)(L2A + o) = pack8(la2[0], la2[1]); *(u32x4*)(BV + o) = pack8(bo[0], bo[1]);
                asm volatile("" ::: "memory"); }
    }
};
}

constexpr size_t MiB = 1u << 20;
constexpr size_t WS_CTL = 0, CTL_ZERO_BYTES = 65536;
constexpr size_t WS_WIN0 = 2 * MiB, WS_WOUT0 = 7 * MiB, WS_WIN1 = 9 * MiB, WS_WGT = 13 * MiB, WS_WOUT1 = 14 * MiB, WS_W13 = 16 * MiB, WS_W2 = 144 * MiB, WS_SPL = 208 * MiB;
constexpr size_t WS_X1 = 212 * MiB, WS_X2 = 244 * MiB;
constexpr size_t WS_R = 276 * MiB;
constexpr size_t WS_U0 = WS_R, WS_CAT0 = WS_R + 48 * MiB, WS_YPRE0 = WS_R + 80 * MiB;
constexpr size_t WS_GY = WS_R, WS_XR = WS_R + 32 * MiB, WS_XC = WS_R + 64 * MiB, WS_BV = WS_R + 96 * MiB, WS_YPRE1 = WS_R + 64 * MiB;
constexpr size_t WS_H = WS_R, WS_Y = WS_R + 72 * MiB;
constexpr size_t WS_LIST = 420 * MiB, WS_TOKSLOT = 421 * MiB, WS_TOKGATE = WS_TOKSLOT + 256 * 1024, WS_AGG = 422 * MiB, WS_X1Q = 424 * MiB  , WS_FAST_END = 440 * MiB;
#ifndef MOE_FP8
#define MOE_FP8 1
#endif
constexpr int SCL_W13 = 6, SCL_W2 = 6;
static_assert(SCL_W13 % 2 == 0 && SCL_W2 % 2 == 0, "even scales");
constexpr int NPAD_ROWS = 2 * T + NE * 256;
static_assert(WS_H + (size_t)NPAD_ROWS * DEXP * 2 <= WS_Y && WS_Y + (size_t)NPAD_ROWS * D * 2 <= WS_LIST, "H / Y fit");
constexpr int CW_TMO = 0, CW_CODE = 1, CW_GCOUNT = 256  , CW_BAR = 4096;
constexpr int RING_BYTES = 131072, LDSCTL_OFF = RING_BYTES, MISC_OFF = LDSCTL_OFF + 320, UNITS_OFF = LDSCTL_OFF + 512, MOEMETA_OFF = LDSCTL_OFF + 768, GTAB_OFF = LDSCTL_OFF + 1024, MAX_UNITS = 8;
constexpr int LDS_BYTES = 147456;
static_assert(GTAB_OFF + MAX_UNITS * 1024 <= LDS_BYTES, "LDS map");
constexpr int NWAVES = 8, NTHREADS = 512;

#define XB_TMO      128
#define XB_XCNT(j)  (256  + 64 * (j))
#define XB_XSUB(j)  (1280 + 64 * (j))
#define XB_XGEN(j)  (2304 + 64 * (j))
#define XB_TOP      3328
#define XB_TOPGEN   3392
#define XCD_BAR_WORDS 3456
#define XB_SPIN_CAP (1u << 18)
__device__ __forceinline__ unsigned xb_ld(unsigned* p)              { return __hip_atomic_load(p, __ATOMIC_RELAXED, __HIP_MEMORY_SCOPE_AGENT); }
__device__ __forceinline__ unsigned xb_add(unsigned* p, unsigned v) { return __hip_atomic_fetch_add(p, v, __ATOMIC_RELAXED, __HIP_MEMORY_SCOPE_AGENT); }
__device__ __forceinline__ unsigned xb_xcc_id() { return (unsigned)__builtin_amdgcn_s_getreg((3 << 11) | 20) & 0xFu; }
#define XB_SPIN(cond, bar) do { unsigned _sp = 0; while (cond) { __builtin_amdgcn_s_sleep(1); \
    if ((++_sp & 255u) == 0u) { if (xb_ld(&(bar)[XB_TMO])) break; if (_sp > XB_SPIN_CAP) { atomicAdd(&(bar)[XB_TMO], 1u); break; } } } } while (0)
struct XcdBarrier { unsigned* bar; unsigned x; volatile LAS unsigned* st; int wave; };
__device__ __forceinline__ XcdBarrier xcd_barrier_post(unsigned* bar, volatile LAS unsigned* st, int wave) {
    XcdBarrier b; b.bar = bar; b.x = xb_xcc_id(); b.st = st; b.wave = wave;
    if (wave == 0 && lane_id_asm() == 0) (void)xb_add(&bar[XB_XCNT(b.x)], 1u);
    return b;
}
__device__ __forceinline__ void xcd_barrier_complete(unsigned* bar, unsigned x, unsigned& nloc, unsigned& nx) {
    const unsigned G = gridDim.x * gridDim.y * gridDim.z;
    unsigned sum, cnt, mine, sp = 0u;
    for (;;) {
        sum = 0u; cnt = 0u; mine = 0u;
#pragma unroll
        for (unsigned j = 0; j < 16; ++j) { const unsigned c = xb_ld(&bar[XB_XCNT(j)]); sum += c; cnt += (c > 0u) ? 1u : 0u; mine = (j == x) ? c : mine; }
        if (sum == G) break;
        __builtin_amdgcn_s_sleep(1);
        if ((++sp & 255u) == 0u) { if (xb_ld(&bar[XB_TMO])) break; if (sp > XB_SPIN_CAP) { atomicAdd(&bar[XB_TMO], 1u); break; } }
    }
    nloc = mine > 0u ? mine : 1u; nx = cnt > 0u ? cnt : 1u;
}
__device__ __forceinline__ void xcd_barrier(const XcdBarrier& b) {
    asm volatile("s_waitcnt vmcnt(0)" ::: "memory");
    __syncthreads();
    if (b.wave == 0 && lane_id_asm() == 0) {
        unsigned* bar = b.bar;
        __builtin_amdgcn_s_waitcnt(0);
        unsigned nloc = b.st[0], nx = b.st[1];
        if (nloc == 0u) { xcd_barrier_complete(bar, b.x, nloc, nx); b.st[0] = nloc; b.st[1] = nx; }
        const unsigned old = xb_add(&bar[XB_XSUB(b.x)], 1u);
        const unsigned gen = old / nloc;
        if (old + 1u == (gen + 1u) * nloc) {
            __builtin_amdgcn_fence(__ATOMIC_RELEASE, "agent");
            asm volatile("s_waitcnt vmcnt(0)" ::: "memory");
            const unsigned og = xb_add(&bar[XB_TOP], 1u);
            const unsigned tg = og / nx;
            if (og + 1u == (tg + 1u) * nx) xb_add(&bar[XB_TOPGEN], 1u);
            else XB_SPIN(xb_ld(&bar[XB_TOPGEN]) == tg, bar);
            __builtin_amdgcn_fence(__ATOMIC_ACQUIRE, "agent");
            xb_add(&bar[XB_XGEN(b.x)], 1u);
            asm volatile("s_waitcnt vmcnt(0)" ::: "memory");
        } else {
            XB_SPIN(xb_ld(&bar[XB_XGEN(b.x)]) == gen, bar);
            __builtin_amdgcn_fence(__ATOMIC_ACQUIRE, "agent");
            asm volatile("s_waitcnt vmcnt(0)" ::: "memory");
        }
    }
    __syncthreads();
}

struct Args { const float* in[26]; float* out; unsigned char* ws; int ph_lo, ph_hi; };
struct Frame {
    LAS unsigned char* lds; unsigned char* ws; const float* const* in; float* out;
    int tid, lane, wave, vcu, G;
    template <class Tp> __device__ __forceinline__ Tp* W(size_t off) const { return (Tp*)(ws + off); }
    __device__ __forceinline__ const float* I(int i) const { return in[i]; }
    __device__ __forceinline__ unsigned* ctl() const { return (unsigned*)(ws + WS_CTL); }
    __device__ __forceinline__ void retid() { lane = lane_id_asm(); tid = wave * 64 + lane; }
};

__device__ __forceinline__ void cvt_item(const float* src, int ldsrc, int k0, int c0, bf16_t* dst, int lddst, int drow0, LAS unsigned* scr, int lane) {
    const int cg = lane & 15, rp = lane >> 4;
    const float* sp = src + (size_t)k0 * ldsrc + c0 + 4 * cg;
    f32x4 v[16];
#pragma unroll
    for (int j = 0; j < 8; ++j) { const int r = 2 * (rp + 4 * j); v[2 * j] = *(const f32x4*)(sp + (size_t)r * ldsrc); v[2 * j + 1] = *(const f32x4*)(sp + (size_t)(r + 1) * ldsrc); }
#pragma unroll
    for (int j = 0; j < 8; ++j) { const int kd = rp + 4 * j;
#pragma unroll
        for (int i = 0; i < 4; ++i) scr[(4 * cg + i) * 33 + kd] = cvt_pk_bf16(v[2 * j][i], v[2 * j + 1][i]); }
    LDS_WAIT();
    const int kc = lane & 7;
#pragma unroll
    for (int jj = 0; jj < 8; ++jj) { const int n = (lane >> 3) + 8 * jj; const LAS unsigned* s = scr + n * 33 + 4 * kc;
        u32x4 o; o.x = s[0]; o.y = s[1]; o.z = s[2]; o.w = s[3];
        *(u32x4*)(dst + (size_t)(drow0 + n) * lddst + k0 + 8 * kc) = o; }
    LDS_WAIT();
}
__device__ __forceinline__ void cvt_item8(const float* src, int ldsrc, int k0, int c0, unsigned char* dst, int lddst, int drow0, float scale, LAS unsigned* scr, int lane) {
    const int cg = lane & 15, rp = lane >> 4;
    const float* sp = src + (size_t)k0 * ldsrc + c0 + 4 * cg;
    f32x4 v[16];
#pragma unroll
    for (int j = 0; j < 4; ++j)
#pragma unroll
        for (int q = 0; q < 4; ++q) v[4 * j + q] = *(const f32x4*)(sp + (size_t)(4 * (rp + 4 * j) + q) * ldsrc);
#pragma unroll
    for (int j = 0; j < 4; ++j) { const int kq = rp + 4 * j;
#pragma unroll
        for (int i = 0; i < 4; ++i) scr[(4 * cg + i) * 17 + kq] = pack4_fp8(v[4 * j][i] * scale, v[4 * j + 1][i] * scale, v[4 * j + 2][i] * scale, v[4 * j + 3][i] * scale); }
    LDS_WAIT();
    const int c4 = lane & 3;
#pragma unroll
    for (int jj = 0; jj < 4; ++jj) { const int n = (lane >> 2) + 16 * jj; const LAS unsigned* s = scr + n * 17 + 4 * c4;
        u32x4 o; o.x = s[0]; o.y = s[1]; o.z = s[2]; o.w = s[3];
        *(u32x4*)(dst + (size_t)(drow0 + n) * lddst + k0 + 16 * c4) = o; }
    LDS_WAIT();
}
__device__ __forceinline__ void p0_prologue(Frame& F) {
    F.retid();
    LAS unsigned* scr = (LAS unsigned*)(F.lds + F.wave * 8448);
    const int gw = F.vcu * NWAVES + F.wave, NGW = F.G * NWAVES;
    constexpr int I_IN0 = 16 * 40, I_OUT0 = 16 * 16, I_IN1 = 16 * 32, I_GT = 4 * 4 * 8, I_OUT1 = 16 * 16, I_W13 = 32 * 16 * 32, I_W2 = 32 * 16 * 16;
    constexpr int NITEMS = I_IN0 + I_OUT0 + I_IN1 + I_GT + I_OUT1 + I_W13 + I_W2;
    for (int it = gw; it < NITEMS; it += NGW) {
        int r = it; const float* src; int ldsrc, k0, sc, lddst, drow0; unsigned char* dst; bool q8 = false; float scale = 1.f;
        if (r < I_IN0) { const int kb = r / 40, db = r % 40, p = db >> 2, q = db & 3;
            if (p < 4) sc = (q < 2) ? 128 * p + 64 * q : 512 + 128 * p + 64 * (q - 2);
            else if (p < 8) sc = (q < 2) ? 1536 + 128 * (p - 4) + 64 * q : 2048 + 128 * (p - 4) + 64 * (q - 2);
            else sc = 1024 + 256 * (p - 8) + 64 * q;
            src = F.I(5); ldsrc = DIN0; k0 = 64 * kb; dst = F.W<unsigned char>(WS_WIN0); lddst = D; drow0 = 64 * db; }
        else if ((r -= I_IN0) < I_OUT0) { const int kb = r / 16, db = r % 16; src = F.I(11); ldsrc = D; k0 = 64 * kb; sc = 64 * db; dst = F.W<unsigned char>(WS_WOUT0); lddst = D; drow0 = 64 * db; }
        else if ((r -= I_OUT0) < I_IN1) { const int kb = r / 32, db = r % 32; src = F.I(12); ldsrc = 2 * DRNN; k0 = 64 * kb; sc = 64 * db; dst = F.W<unsigned char>(WS_WIN1); lddst = D; drow0 = 64 * db; }
        else if ((r -= I_IN1) < I_GT) { const int h = r / 32, r2 = r % 32, kb = r2 / 8, db = r2 % 8, p = db >> 2, q = db & 3;
            src = (q < 2 ? F.I(15) : F.I(17)) + (size_t)h * RBLK * RBLK; ldsrc = RBLK; k0 = 64 * kb; sc = 128 * p + 64 * (q & 1); dst = F.W<unsigned char>(WS_WGT) + (size_t)h * 512 * RBLK * 2; lddst = RBLK; drow0 = 64 * db; }
        else if ((r -= I_GT) < I_OUT1) { const int kb = r / 16, db = r % 16; src = F.I(20); ldsrc = D; k0 = 64 * kb; sc = 64 * db; dst = F.W<unsigned char>(WS_WOUT1); lddst = DRNN; drow0 = 64 * db; }
        else if ((r -= I_OUT1) < I_W13) { const int le = r / 512, r2 = r % 512, kb = r2 / 32, db = r2 % 32, p = db >> 2, q = db & 3;
            src = (q < 2 ? F.I(23) : F.I(24)) + (size_t)le * D * DEXP; ldsrc = DEXP; k0 = 64 * kb; sc = 128 * p + 64 * (q & 1); lddst = D; drow0 = 64 * db;
            q8 = MOE_FP8; scale = (float)(1 << SCL_W13); dst = F.W<unsigned char>(WS_W13) + (size_t)le * 2 * DEXP * D * (MOE_FP8 ? 1 : 2); }
        else { r -= I_W13; const int le = r / 256, r2 = r % 256, kb = r2 / 16, db = r2 % 16;
            src = F.I(25) + (size_t)le * DEXP * D; ldsrc = D; k0 = 64 * kb; sc = 64 * db; lddst = DEXP; drow0 = 64 * db;
            q8 = MOE_FP8; scale = (float)(1 << SCL_W2); dst = F.W<unsigned char>(WS_W2) + (size_t)le * D * DEXP * (MOE_FP8 ? 1 : 2); }
        if (q8) cvt_item8(src, ldsrc, k0, sc, dst, lddst, drow0, scale, scr, F.lane);
        else cvt_item(src, ldsrc, k0, sc, (bf16_t*)dst, lddst, drow0, scr, F.lane);
    }
    { const float* x = F.I(0); bf16_t* xb = F.W<bf16_t>(WS_X2); const size_t n8 = (size_t)T * D / 8, stride = (size_t)F.G * NTHREADS;
      for (size_t i = (size_t)F.vcu * NTHREADS + F.tid; i < n8; i += stride) { const f32x4 a = *(const f32x4*)(x + i * 8), b = *(const f32x4*)(x + i * 8 + 4); *(u32x4*)(xb + i * 8) = pg8::pack8(a, b); } }
    { const int i = F.vcu * NTHREADS + F.tid; if (i < DRNN) F.W<float>(WS_SPL)[i] = 8.0f * log1pf(expf(-F.I(19)[i])); }
}

struct DenseOrder {
    const char* A; const char* B; size_t a_tile, b_tile; int nM, nN, G, c;
    __device__ __forceinline__ bool next(int i, pg8::Unit& u) const { int pm, pn; if (!pg8::tile_of(i, G, c, nM, nN, pm, pn)) return false;
        u.A = A + (size_t)pm * a_tile; u.B = B + (size_t)pn * b_tile; u.row0 = pm * 256; u.pn = pn; u.e = 0; u.gtab = 0; return true; }
};
struct GatesOrder {
    const char* XC; const char* WG; int G, c;
    __device__ __forceinline__ bool next(int i, pg8::Unit& u) const { int pm, pn; if (!pg8::tile_of(i, G, c, T / 256, 2 * RHEADS, pm, pn)) return false;
        u.A = XC + (size_t)pm * 256 * DRNN * 2 + (size_t)(pn >> 1) * RBLK * 2; u.B = WG + (size_t)pn * 256 * RBLK * 2; u.row0 = pm * 256; u.pn = pn; u.e = 0; u.gtab = 0; return true; }
};
struct MoeOrder { LAS const int* units; int nu; const char* A; const char* B; size_t b_exp, b_tile, a_tile; bool gather;
    __device__ __forceinline__ bool next(int i, pg8::Unit& u) const { if (i >= nu) return false;
        const int e = __builtin_amdgcn_readfirstlane(units[4 * i]), pm = __builtin_amdgcn_readfirstlane(units[4 * i + 1]), pn = __builtin_amdgcn_readfirstlane(units[4 * i + 2]);
        u.A = gather ? A : A + (size_t)pm * a_tile; u.B = B + (size_t)e * b_exp + (size_t)pn * b_tile; u.row0 = pm * 256; u.pn = pn; u.e = e; u.gtab = GTAB_OFF + i * 1024; return true; }
};
__device__ __forceinline__ int moe_setup(Frame& F, int layer, int nN, bool gather, unsigned rowbytes) {
    F.retid();
    LAS int* meta = (LAS int*)(F.lds + MOEMETA_OFF); LAS int* units = (LAS int*)(F.lds + UNITS_OFF); LAS unsigned* gtab = (LAS unsigned*)(F.lds + GTAB_OFF);
    const unsigned* gcount = F.ctl() + CW_GCOUNT + 32 * layer;
    if (F.tid < NE) meta[17 + F.tid] = (int)__hip_atomic_load(gcount + F.tid, RLX_AGENT);
    __syncthreads();
    if (F.tid == 0) { int acc = 0; for (int e = 0; e < NE; ++e) { meta[e] = acc; acc += (meta[17 + e] + 255) >> 8; } meta[NE] = acc; }
    __syncthreads();
    const int nM = meta[NE]; int nu = 0;
    for (int i = 0; i < MAX_UNITS; ++i) { int pm, pn; if (!pg8::tile_of(i, F.G, (int)blockIdx.x, nM, nN, pm, pn)) break;
        int e = 0;
#pragma unroll
        for (int j = 1; j < NE; ++j) e += (meta[j] <= pm) ? 1 : 0;
        if (F.tid == 0) { units[4 * i] = e; units[4 * i + 1] = pm; units[4 * i + 2] = pn; units[4 * i + 3] = 0; }
        if (gather && F.tid < 256) { const int idx = (pm - meta[e]) * 256 + F.tid; const int cnt = meta[17 + e];
            const int tok = idx < cnt ? F.W<int>(WS_LIST)[e * T + idx] : 0; gtab[i * 256 + F.tid] = (unsigned)tok * rowbytes; }
        nu = i + 1; }
    __syncthreads();
    return nu;
}

__device__ __forceinline__ void p_mix0(Frame& F) {
    F.retid();
    LAS float* wA = (LAS float*)F.lds;
    LAS float* wB = wA + CONVA * DA;
    LAS float* pb = wB + CONVB * DB;
    for (int i = F.tid; i < CONVA * DA; i += NTHREADS) wA[i] = F.I(6)[i];
    for (int i = F.tid; i < CONVB * DB; i += NTHREADS) wB[i] = F.I(10)[i];
    for (int i = F.tid; i < DA; i += NTHREADS) { pb[i] = F.I(7)[i]; pb[DA + i] = F.I(8)[i]; pb[2 * DA + i] = F.I(9)[i]; }
    __syncthreads();
    const bf16_t* U0 = F.W<bf16_t>(WS_U0); bf16_t* CAT = F.W<bf16_t>(WS_CAT0);
    const int c0 = 8 * F.lane;
#pragma unroll 1
    for (int tb = F.vcu * NWAVES + F.wave; tb < T / 8; tb += F.G * NWAVES) {
        const int t0 = tb * 8, s0 = t0 & (SEQ - 1);
        float acc[8][8];
        { const f32x4 b0 = *(const LAS f32x4*)(pb + c0), b1 = *(const LAS f32x4*)(pb + c0 + 4);
#pragma unroll
          for (int r = 0; r < 8; ++r) { acc[r][0] = b0[0]; acc[r][1] = b0[1]; acc[r][2] = b0[2]; acc[r][3] = b0[3]; acc[r][4] = b1[0]; acc[r][5] = b1[1]; acc[r][6] = b1[2]; acc[r][7] = b1[3]; } }
#pragma unroll
        for (int jb = 0; jb < 5; ++jb) {
            u32x4 in[8];
#pragma unroll
            for (int jj = 0; jj < 8; ++jj) { const int j = jb * 8 + jj; const int d = 30 - j;
                const bool ok = (j < 38) && (s0 - d >= 0); const size_t rr = ok ? (size_t)(t0 - d) : (size_t)t0;
                in[jj] = *(const u32x4*)(U0 + rr * 1536 + c0); if (!ok) in[jj] = (u32x4){0u, 0u, 0u, 0u}; }
#pragma unroll
            for (int jj = 0; jj < 8; ++jj) { const int j = jb * 8 + jj;
                const float x0 = bf_lo(in[jj].x), x1 = bf_hi(in[jj].x), x2 = bf_lo(in[jj].y), x3 = bf_hi(in[jj].y), x4 = bf_lo(in[jj].z), x5 = bf_hi(in[jj].z), x6 = bf_lo(in[jj].w), x7 = bf_hi(in[jj].w);
#pragma unroll
                for (int r = 0; r < 8; ++r) { const int k = j - r; if (k < 0 || k >= CONVA) continue;
                    const f32x4 w0 = *(const LAS f32x4*)(wA + k * DA + c0), w1 = *(const LAS f32x4*)(wA + k * DA + c0 + 4);
                    acc[r][0] += w0[0] * x0; acc[r][1] += w0[1] * x1; acc[r][2] += w0[2] * x2; acc[r][3] += w0[3] * x3;
                    acc[r][4] += w1[0] * x4; acc[r][5] += w1[1] * x5; acc[r][6] += w1[2] * x6; acc[r][7] += w1[3] * x7; } }
        }
        float mean[8], rstd[8];
#pragma unroll
        for (int r = 0; r < 8; ++r) { float sm = 0.f;
#pragma unroll
            for (int j = 0; j < 8; ++j) sm += acc[r][j];
            mean[r] = sm; }
#pragma unroll
        for (int r = 0; r < 8; ++r) mean[r] = wave_sum(mean[r]) * (1.0f / DA);
#pragma unroll
        for (int r = 0; r < 8; ++r) { float q = 0.f;
#pragma unroll
            for (int j = 0; j < 8; ++j) { acc[r][j] -= mean[r]; q += acc[r][j] * acc[r][j]; }
            rstd[r] = q; }
#pragma unroll
        for (int r = 0; r < 8; ++r) rstd[r] = 1.0f / sqrtf(wave_sum(rstd[r]) * (1.0f / DA) + LN_EPS);
        { const f32x4 g0 = *(const LAS f32x4*)(pb + DA + c0), g1 = *(const LAS f32x4*)(pb + DA + c0 + 4), e0 = *(const LAS f32x4*)(pb + 2 * DA + c0), e1 = *(const LAS f32x4*)(pb + 2 * DA + c0 + 4);
#pragma unroll
          for (int r = 0; r < 8; ++r) { f32x4 o0, o1;
#pragma unroll
              for (int j = 0; j < 4; ++j) { o0[j] = fsilu(acc[r][j] * rstd[r] * g0[j] + e0[j]); o1[j] = fsilu(acc[r][4 + j] * rstd[r] * g1[j] + e1[j]); }
              *(u32x4*)(CAT + (size_t)(t0 + r) * D + c0) = pg8::pack8(o0, o1); } }
        { u32x4 cx[10], bbv[8];
#pragma unroll
          for (int j = 0; j < 10; ++j) { const int d = 2 - j; const bool ok = (s0 - d >= 0); const size_t rr = ok ? (size_t)(t0 - d) : (size_t)t0;
              cx[j] = *(const u32x4*)(U0 + rr * 1536 + 512 + c0); if (!ok) cx[j] = (u32x4){0u, 0u, 0u, 0u}; }
#pragma unroll
          for (int r = 0; r < 8; ++r) bbv[r] = *(const u32x4*)(U0 + (size_t)(t0 + r) * 1536 + 1024 + c0);
          f32x4 wv[3][2];
#pragma unroll
          for (int k = 0; k < 3; ++k) { wv[k][0] = *(const LAS f32x4*)(wB + k * DB + c0); wv[k][1] = *(const LAS f32x4*)(wB + k * DB + c0 + 4); }
#pragma unroll
          for (int r = 0; r < 8; ++r) { f32x4 a0 = {0.f, 0.f, 0.f, 0.f}, a1 = {0.f, 0.f, 0.f, 0.f};
#pragma unroll
              for (int k = 0; k < 3; ++k) { const u32x4 w = cx[r + k];
                  a0 += wv[k][0] * (f32x4){bf_lo(w.x), bf_hi(w.x), bf_lo(w.y), bf_hi(w.y)}; a1 += wv[k][1] * (f32x4){bf_lo(w.z), bf_hi(w.z), bf_lo(w.w), bf_hi(w.w)}; }
              const u32x4 bw = bbv[r];
              const f32x4 p0 = a0 * (f32x4){bf_lo(bw.x), bf_hi(bw.x), bf_lo(bw.y), bf_hi(bw.y)}, p1 = a1 * (f32x4){bf_lo(bw.z), bf_hi(bw.z), bf_lo(bw.w), bf_hi(bw.w)};
              *(u32x4*)(CAT + (size_t)(t0 + r) * D + 512 + c0) = pg8::pack8(p0, p1); } }
    }
    __syncthreads();
}

__device__ __forceinline__ void route16(const float (&l)[NE], int& e1, int& e2, float& g1, float& g2) {
    float mx = l[0];
#pragma unroll
    for (int e = 1; e < NE; ++e) mx = fmaxf(mx, l[e]);
    float p[NE];
#pragma unroll
    for (int e = 0; e < NE; ++e) p[e] = __expf(l[e] - mx);
    int gsel = 0; float best = -1.f, bq0 = 0.f, bq1 = 0.f, bq2 = 0.f, bq3 = 0.f;
#pragma unroll
    for (int g = 0; g < NG; ++g) { float m1 = -1.f, m2 = -1.f;
#pragma unroll
        for (int j = 0; j < EPG; ++j) { const float v = p[g * EPG + j]; if (v > m1) { m2 = m1; m1 = v; } else if (v > m2) m2 = v; }
        const float sc = m1 + m2; if (sc > best) { best = sc; gsel = g; bq0 = p[g * EPG]; bq1 = p[g * EPG + 1]; bq2 = p[g * EPG + 2]; bq3 = p[g * EPG + 3]; } }
    int i1 = 0; float p1 = bq0;
    if (bq1 > p1) { p1 = bq1; i1 = 1; } if (bq2 > p1) { p1 = bq2; i1 = 2; } if (bq3 > p1) { p1 = bq3; i1 = 3; }
    int i2 = -1; float p2 = -1.f;
    if (i1 != 0 && bq0 > p2) { p2 = bq0; i2 = 0; } if (i1 != 1 && bq1 > p2) { p2 = bq1; i2 = 1; } if (i1 != 2 && bq2 > p2) { p2 = bq2; i2 = 2; } if (i1 != 3 && bq3 > p2) { p2 = bq3; i2 = 3; }
    e1 = gsel * EPG + i1; e2 = gsel * EPG + i2; const float inv = 1.0f / (p1 + p2); g1 = p1 * inv; g2 = p2 * inv;
}
#ifndef P4_VAR
#define P4_VAR 0
#endif
__device__ __forceinline__ void p_ln1_route(Frame& F, int layer, const float* YPRE, bool dummy = false) {
    const int var = dummy ? P4_VAR : 0;
    F.retid();
    LAS float* wrT = (LAS float*)F.lds;
    LAS int* rt = (LAS int*)(F.lds + 65536);
    LAS int* re = rt; LAS int* rlp = rt + 128; LAS float* rg = (LAS float*)(rt + 256); LAS int* lcount = rt + 384; LAS int* gbase = rt + 400;
    { const float* wr = F.I(21);
      for (int idx = F.tid; idx < D * NE / 4; idx += NTHREADS) { const f32x4 v = *(const f32x4*)(wr + idx * 4); const int c = idx >> 2, e4 = (idx & 3) * 4;
          wrT[(e4 + 0) * D + c] = v[0]; wrT[(e4 + 1) * D + c] = v[1]; wrT[(e4 + 2) * D + c] = v[2]; wrT[(e4 + 3) * D + c] = v[3]; } }
    const float* g1p = F.I(1) + layer * D; const float* b1p = F.I(2) + layer * D; const float* br = F.I(22);
    bf16_t* X1 = F.W<bf16_t>(WS_X1); unsigned* gcount = F.ctl() + CW_GCOUNT + 32 * layer + (dummy ? 16 : 0);
    int* LIST = F.W<int>(WS_LIST); int* TOKSLOT = F.W<int>(WS_TOKSLOT); float* TOKGATE = F.W<float>(WS_TOKGATE); unsigned char* X1Q = F.W<unsigned char>(WS_X1Q); (void)X1Q;
    const int lane = F.lane;
    for (int tb = F.vcu; tb < T / 64; tb += F.G) {
        if (F.tid < NE) lcount[F.tid] = 0;
        __syncthreads();
        const int tok0 = tb * 64;
        const float brl = br[lane & 15];
#pragma unroll 1
        for (int grp = 0; grp < 2; ++grp) {
            const int rl0 = F.wave * 8 + grp * 4;
            f32x4 x[4][4]; float st[4];
#pragma unroll
            for (int r = 0; r < 4; ++r) { const float* yr = YPRE + (size_t)(tok0 + rl0 + r) * D + 4 * lane;
#pragma unroll
                for (int j = 0; j < 4; ++j) x[r][j] = *(const f32x4*)(yr + 256 * j); }
#pragma unroll
            for (int r = 0; r < 4; ++r) { float s_ = 0.f;
#pragma unroll
                for (int j = 0; j < 4; ++j) s_ += (x[r][j][0] + x[r][j][1]) + (x[r][j][2] + x[r][j][3]);
                st[r] = s_; }
#pragma unroll
            for (int r = 0; r < 4; ++r) st[r] = wave_sum(st[r]) * (1.0f / D);
#pragma unroll
            for (int r = 0; r < 4; ++r) { float q = 0.f;
#pragma unroll
                for (int j = 0; j < 4; ++j) { x[r][j] = x[r][j] - st[r]; q += (x[r][j][0] * x[r][j][0] + x[r][j][1] * x[r][j][1]) + (x[r][j][2] * x[r][j][2] + x[r][j][3] * x[r][j][3]); }
                st[r] = q; }
#pragma unroll
            for (int r = 0; r < 4; ++r) st[r] = 1.0f / sqrtf(wave_sum(st[r]) * (1.0f / D) + LN_EPS);
#pragma unroll
            for (int j = 0; j < 4; ++j) { const f32x4 gg = *(const f32x4*)(g1p + 256 * j + 4 * lane), bb = *(const f32x4*)(b1p + 256 * j + 4 * lane);
#pragma unroll
                for (int r = 0; r < 4; ++r) { x[r][j] = x[r][j] * st[r] * gg + bb;
                    u32x2 w; w.x = cvt_pk_bf16(x[r][j][0], x[r][j][1]); w.y = cvt_pk_bf16(x[r][j][2], x[r][j][3]);
                    *(u32x2*)(X1 + (size_t)(tok0 + rl0 + r) * D + 256 * j + 4 * lane) = w;
#if MOE_FP8
                    *(unsigned*)(X1Q + (size_t)(tok0 + rl0 + r) * D + 256 * j + 4 * lane) = pack4_fp8(x[r][j][0], x[r][j][1], x[r][j][2], x[r][j][3]);
#endif
                } }
            if (var == 1) { asm volatile("" :: "v"(x[0][0][0])); continue; }
            int zoff = 0; asm volatile("" : "+v"(zoff));
            const LAS float* wl = wrT + zoff + 4 * lane;
            float pr[4];
            {
                float lg[4][NE];
#pragma unroll
                for (int e = 0; e < NE; ++e) {
#pragma unroll
                    for (int r = 0; r < 4; ++r) lg[r][e] = 0.f;
#pragma unroll
                    for (int j = 0; j < 4; ++j) { const f32x4 w = *(const LAS f32x4*)(wl + e * D + 256 * j);
#pragma unroll
                        for (int r = 0; r < 4; ++r) lg[r][e] += (x[r][j][0] * w[0] + x[r][j][1] * w[1]) + (x[r][j][2] * w[2] + x[r][j][3] * w[3]); } }
                if (var == 2) {
#pragma unroll
                    for (int e = 0; e < NE; ++e) asm volatile("" :: "v"(lg[0][e]), "v"(lg[1][e]), "v"(lg[2][e]), "v"(lg[3][e]));
                    continue; }
#pragma unroll
                for (int r = 0; r < 4; ++r) { float a8[8], a4[4], a2[2];
#pragma unroll
                    for (int i = 0; i < 8; ++i) { const bool hi = lane & 1; const float send = hi ? lg[r][2 * i] : lg[r][2 * i + 1], keep = hi ? lg[r][2 * i + 1] : lg[r][2 * i]; a8[i] = keep + dpp_xor1(send); }
#pragma unroll
                    for (int i = 0; i < 4; ++i) { const bool hi = lane & 2; const float send = hi ? a8[2 * i] : a8[2 * i + 1], keep = hi ? a8[2 * i + 1] : a8[2 * i]; a4[i] = keep + dpp_xor2(send); }
#pragma unroll
                    for (int i = 0; i < 2; ++i) { const bool hi = lane & 4; const float send = hi ? a4[2 * i] : a4[2 * i + 1], keep = hi ? a4[2 * i + 1] : a4[2 * i]; a2[i] = keep + swz_xor<4>(send); }
                    { const bool hi = lane & 8; const float send = hi ? a2[0] : a2[1], keep = hi ? a2[1] : a2[0]; pr[r] = keep + swz_xor<8>(send); } }
            }
            float L;
            { const bool h16 = lane & 16, h32 = lane & 32;
              const float k0 = h16 ? pr[1] : pr[0], s0_ = h16 ? pr[0] : pr[1], k1 = h16 ? pr[3] : pr[2], s1_ = h16 ? pr[2] : pr[3];
              const float u0 = k0 + swz_xor<16>(s0_), u1 = k1 + swz_xor<16>(s1_);
              const float kk = h32 ? u1 : u0, ss = h32 ? u0 : u1;
              L = kk + __int_as_float(__builtin_amdgcn_ds_bpermute((lane ^ 32) << 2, __float_as_int(ss))) + brl; }
            float mx = L; mx = fmaxf(mx, dpp_xor1(mx)); mx = fmaxf(mx, dpp_xor2(mx)); mx = fmaxf(mx, swz_xor<4>(mx)); mx = fmaxf(mx, swz_xor<8>(mx));
            const float p = __expf(L - mx);
            const float q0 = __int_as_float(__builtin_amdgcn_mov_dpp(__float_as_int(p), 0x00, 0xF, 0xF, true)), q1 = __int_as_float(__builtin_amdgcn_mov_dpp(__float_as_int(p), 0x55, 0xF, 0xF, true)),
                        q2 = __int_as_float(__builtin_amdgcn_mov_dpp(__float_as_int(p), 0xAA, 0xF, 0xF, true)), q3 = __int_as_float(__builtin_amdgcn_mov_dpp(__float_as_int(p), 0xFF, 0xF, 0xF, true));
            int i1 = 0; float p1 = q0;
            if (q1 > p1) { p1 = q1; i1 = 1; } if (q2 > p1) { p1 = q2; i1 = 2; } if (q3 > p1) { p1 = q3; i1 = 3; }
            int i2 = -1; float p2 = -1.f;
            if (i1 != 0 && q0 > p2) { p2 = q0; i2 = 0; } if (i1 != 1 && q1 > p2) { p2 = q1; i2 = 1; } if (i1 != 2 && q2 > p2) { p2 = q2; i2 = 2; } if (i1 != 3 && q3 > p2) { p2 = q3; i2 = 3; }
            const int g = (lane >> 2) & 3;
            float bs_ = p1 + p2; int bg = g;
            { const float os = swz_xor<4>(bs_); const int og = __builtin_amdgcn_ds_swizzle(bg, (4 << 10) | 0x1F); if (os > bs_ || (os == bs_ && og < bg)) { bs_ = os; bg = og; } }
            { const float os = swz_xor<8>(bs_); const int og = __builtin_amdgcn_ds_swizzle(bg, (8 << 10) | 0x1F); if (os > bs_ || (os == bs_ && og < bg)) { bs_ = os; bg = og; } }
            if (var == 3) { asm volatile("" :: "v"(bg), "v"(i1), "v"(i2), "v"(p1), "v"(p2)); continue; }
            if (g == bg && (lane & 3) == 0) {
                const int rl = rl0 + (lane >> 4), e1 = 4 * g + i1, e2 = 4 * g + i2; const float inv = 1.0f / (p1 + p2);
                const int lp1 = __hip_atomic_fetch_add(lcount + e1, 1, __ATOMIC_RELAXED, __HIP_MEMORY_SCOPE_WORKGROUP), lp2 = __hip_atomic_fetch_add(lcount + e2, 1, __ATOMIC_RELAXED, __HIP_MEMORY_SCOPE_WORKGROUP);
                re[2 * rl] = e1; re[2 * rl + 1] = e2; rlp[2 * rl] = lp1; rlp[2 * rl + 1] = lp2; rg[2 * rl] = p1 * inv; rg[2 * rl + 1] = p2 * inv; }
        }
        __syncthreads();
        if (var != 0) continue;
        if (F.tid < NE) gbase[F.tid] = (int)__hip_atomic_fetch_add(gcount + F.tid, (unsigned)lcount[F.tid], RLX_AGENT);
        __syncthreads();
        if (F.tid < 128) { const int e = re[F.tid], pos = gbase[e] + rlp[F.tid], tok = tok0 + (F.tid >> 1);
            LIST[e * T + pos] = tok; TOKSLOT[tok * 2 + (F.tid & 1)] = e * T + pos; TOKGATE[tok * 2 + (F.tid & 1)] = rg[F.tid]; }
        __syncthreads();
    }
}

__device__ __forceinline__ void p_combine(Frame& F, int layer) {
    F.retid();
    const unsigned* gcount = F.ctl() + CW_GCOUNT + 32 * layer;
    const int lane = F.lane;
    int pre = 0;
#pragma unroll
    for (int j = 0; j < NE - 1; ++j) { const int cnt = (int)__builtin_amdgcn_readfirstlane(__hip_atomic_load(gcount + j, RLX_AGENT)); pre += ((lane & 15) > j) ? ((cnt + 255) >> 8) * 256 : 0; }
    const bf16_t* X1 = F.W<bf16_t>(WS_X1); const bf16_t* Y = F.W<bf16_t>(WS_Y); const int* TOKSLOT = F.W<int>(WS_TOKSLOT); const float* TOKGATE = F.W<float>(WS_TOKGATE);
    const float* g2p = F.I(3) + layer * D; const float* b2p = F.I(4) + layer * D;
    bf16_t* X2 = F.W<bf16_t>(WS_X2);
    for (int tb = F.vcu * NWAVES + F.wave; tb < T / 8; tb += F.G * NWAVES) {
#pragma unroll 2
        for (int i = 0; i < 8; ++i) { const int t = tb * 8 + i;
            const int s0 = __builtin_amdgcn_readfirstlane(TOKSLOT[2 * t]), s1 = __builtin_amdgcn_readfirstlane(TOKSLOT[2 * t + 1]);
            const float g0 = TOKGATE[2 * t], g1 = TOKGATE[2 * t + 1];
            const int r0 = __builtin_amdgcn_readlane(pre, s0 >> 14) + (s0 & (T - 1)), r1 = __builtin_amdgcn_readlane(pre, s1 >> 14) + (s1 & (T - 1));
            f32x4 v[4]; float s = 0.f;
#pragma unroll
            for (int j = 0; j < 4; ++j) { const u32x2 xw = *(const u32x2*)(X1 + (size_t)t * D + 256 * j + 4 * lane), y0 = *(const u32x2*)(Y + (size_t)r0 * D + 256 * j + 4 * lane), y1 = *(const u32x2*)(Y + (size_t)r1 * D + 256 * j + 4 * lane);
                v[j][0] = ALPHA * bf_lo(xw.x) + (g0 * bf_lo(y0.x) + g1 * bf_lo(y1.x)); v[j][1] = ALPHA * bf_hi(xw.x) + (g0 * bf_hi(y0.x) + g1 * bf_hi(y1.x));
                v[j][2] = ALPHA * bf_lo(xw.y) + (g0 * bf_lo(y0.y) + g1 * bf_lo(y1.y)); v[j][3] = ALPHA * bf_hi(xw.y) + (g0 * bf_hi(y0.y) + g1 * bf_hi(y1.y));
                s += (v[j][0] + v[j][1]) + (v[j][2] + v[j][3]); }
            const float mean = wave_sum(s) * (1.0f / D); float q = 0.f;
#pragma unroll
            for (int j = 0; j < 4; ++j) { v[j] = v[j] - mean; q += (v[j][0] * v[j][0] + v[j][1] * v[j][1]) + (v[j][2] * v[j][2] + v[j][3] * v[j][3]); }
            const float rstd = 1.0f / sqrtf(wave_sum(q) * (1.0f / D) + LN_EPS);
#pragma unroll
            for (int j = 0; j < 4; ++j) { const f32x4 gg = *(const f32x4*)(g2p + 256 * j + 4 * lane), bb = *(const f32x4*)(b2p + 256 * j + 4 * lane); const f32x4 o = v[j] * rstd * gg + bb;
                if (layer == 0) { u32x2 w; w.x = cvt_pk_bf16(o[0], o[1]); w.y = cvt_pk_bf16(o[2], o[3]); *(u32x2*)(X2 + (size_t)t * D + 256 * j + 4 * lane) = w; }
                else *(f32x4*)(F.out + (size_t)t * D + 256 * j + 4 * lane) = o; }
        }
    }
}

__device__ __forceinline__ void p_conv4(Frame& F) {
    F.retid();
    const bf16_t* XR = F.W<bf16_t>(WS_XR); bf16_t* XC = F.W<bf16_t>(WS_XC); const float* w = F.I(13); const float* bias = F.I(14);
    const int lane = F.lane;
#pragma unroll 1
    for (int it = F.vcu * NWAVES + F.wave; it < (T / 8) * 2; it += F.G * NWAVES) {
        const int tb = it >> 1, c0 = 8 * lane + 512 * (it & 1), t0 = tb * 8, s0 = t0 & (SEQ - 1);
        f32x4 wk[CONVC][2], bs[2];
#pragma unroll
        for (int k = 0; k < CONVC; ++k) { wk[k][0] = *(const f32x4*)(w + k * DRNN + c0); wk[k][1] = *(const f32x4*)(w + k * DRNN + c0 + 4); }
        bs[0] = *(const f32x4*)(bias + c0); bs[1] = *(const f32x4*)(bias + c0 + 4);
        u32x4 in[11];
#pragma unroll
        for (int j = 0; j < 11; ++j) { const int d = 3 - j; const bool ok = (s0 - d >= 0); const size_t rr = ok ? (size_t)(t0 - d) : (size_t)t0;
            in[j] = *(const u32x4*)(XR + rr * DRNN + c0); if (!ok) in[j] = (u32x4){0u, 0u, 0u, 0u}; }
#pragma unroll
        for (int r = 0; r < 8; ++r) { f32x4 a0 = bs[0], a1 = bs[1];
#pragma unroll
            for (int k = 0; k < CONVC; ++k) { const u32x4 xw = in[r + k];
                a0 += wk[k][0] * (f32x4){bf_lo(xw.x), bf_hi(xw.x), bf_lo(xw.y), bf_hi(xw.y)}; a1 += wk[k][1] * (f32x4){bf_lo(xw.z), bf_hi(xw.z), bf_lo(xw.w), bf_hi(xw.w)}; }
            *(u32x4*)(XC + (size_t)(t0 + r) * DRNN + c0) = pg8::pack8(a0, a1); }
    }
}

constexpr int SCH = 64, NCHUNK = SEQ / SCH;
__device__ __forceinline__ void p_scan1(Frame& F) {
    F.retid();
    const bf16_t* L2A = F.W<bf16_t>(WS_XR); const bf16_t* BV = F.W<bf16_t>(WS_BV); float* AGG = F.W<float>(WS_AGG);
    for (int task = F.vcu * NWAVES + F.wave; task < BATCH * NCHUNK * 8; task += F.G * NWAVES) {
        const int bc = task >> 3, c = (task & 7) * 128 + 2 * F.lane; const size_t base = (size_t)bc * SCH * DRNN + c;
        float sl0 = 0.f, sl1 = 0.f, h0 = 0.f, h1 = 0.f;
#pragma unroll 16
        for (int s = 0; s < SCH; ++s) { const unsigned lw = *(const unsigned*)(L2A + base + (size_t)s * DRNN), bw = *(const unsigned*)(BV + base + (size_t)s * DRNN);
            const float l0 = bf_lo(lw), l1 = bf_hi(lw); sl0 += l0; sl1 += l1;
            h0 = __builtin_amdgcn_exp2f(l0) * h0 + bf_lo(bw); h1 = __builtin_amdgcn_exp2f(l1) * h1 + bf_hi(bw); }
        *(f32x4*)(AGG + ((size_t)bc * DRNN + c) * 2) = (f32x4){sl0, h0, sl1, h1};
    }
}
__device__ __forceinline__ void p_scan2(Frame& F, bool dummy = false) {
    F.retid();
    const bf16_t* L2A = F.W<bf16_t>(WS_XR); const bf16_t* BV = F.W<bf16_t>(WS_BV); const float* AGG = F.W<float>(WS_AGG); bf16_t* GY = F.W<bf16_t>(WS_GY); bf16_t* OUTB = dummy ? F.W<bf16_t>(WS_XC) : GY;
#pragma unroll 1
    for (int task = F.vcu * NWAVES + F.wave; task < BATCH * NCHUNK * 8; task += F.G * NWAVES) {
        const int bc = task >> 3, c = (task & 7) * 128 + 2 * F.lane; const int b = bc / NCHUNK, ch = bc % NCHUNK;
        float h0 = 0.f, h1 = 0.f;
#pragma unroll 1
        for (int j0 = 0; j0 < ch; j0 += 16) { f32x4 g[16];
#pragma unroll
            for (int i = 0; i < 16; ++i) { const int j = j0 + i; const int jc = j < ch ? j : ch - 1; g[i] = *(const f32x4*)(AGG + ((size_t)(b * NCHUNK + jc) * DRNN + c) * 2); if (j >= ch) g[i] = (f32x4){0.f, 0.f, 0.f, 0.f}; }
#pragma unroll
            for (int i = 0; i < 16; ++i) { h0 = __builtin_amdgcn_exp2f(g[i][0]) * h0 + g[i][1]; h1 = __builtin_amdgcn_exp2f(g[i][2]) * h1 + g[i][3]; } }
        const size_t base = (size_t)bc * SCH * DRNN + c;
#pragma unroll 1
        for (int s0 = 0; s0 < SCH; s0 += 16) { unsigned lw[16], bw[16], gw[16];
#pragma unroll
            for (int i = 0; i < 16; ++i) { const size_t o = base + (size_t)(s0 + i) * DRNN; lw[i] = *(const unsigned*)(L2A + o); bw[i] = *(const unsigned*)(BV + o); gw[i] = *(const unsigned*)(GY + o); }
#pragma unroll
            for (int i = 0; i < 16; ++i) { h0 = __builtin_amdgcn_exp2f(bf_lo(lw[i])) * h0 + bf_lo(bw[i]); h1 = __builtin_amdgcn_exp2f(bf_hi(lw[i])) * h1 + bf_hi(bw[i]);
                gw[i] = cvt_pk_bf16(bf_lo(gw[i]) * h0, bf_hi(gw[i]) * h1); }
#pragma unroll
            for (int i = 0; i < 16; ++i) *(unsigned*)(OUTB + base + (size_t)(s0 + i) * DRNN) = gw[i]; }
    }
}

constexpr int NPH = 18;
#ifndef N_LAUNCHES
#define N_LAUNCHES 1
#endif
__global__ void __launch_bounds__(NTHREADS, 2) mega_fwd(Args args) {
    extern __shared__ __attribute__((aligned(16))) unsigned char lds_raw[];
    Frame F;
    F.lds = (LAS unsigned char*)lds_raw; F.ws = args.ws; F.in = args.in; F.out = args.out;
    F.tid = threadIdx.x; F.lane = F.tid & 63; F.wave = __builtin_amdgcn_readfirstlane(F.tid >> 6);
    F.G = gridDim.x; { const int bx = blockIdx.x; F.vcu = (F.G % 8 == 0) ? (bx % 8) * (F.G / 8) + bx / 8 : bx; }
    for (int u = F.tid; u < (LDS_BYTES - LDSCTL_OFF) / 4; u += NTHREADS) ((LAS unsigned*)(F.lds + LDSCTL_OFF))[u] = 0u;
    __syncthreads();
    XcdBarrier bar; bar.bar = F.ctl() + CW_BAR; bar.x = 0; bar.st = nullptr; bar.wave = F.wave;
    if (N_LAUNCHES == 1) bar = xcd_barrier_post(F.ctl() + CW_BAR, (volatile LAS unsigned*)(F.lds + MISC_OFF) + 8, F.wave);
    const int lo = args.ph_lo, hi = args.ph_hi;
#ifndef PH_MASK
#define PH_MASK 0x3ffff
#endif
#define IN(k) (((PH_MASK >> (k)) & 1) && lo <= (k) && (k) < hi)
#define SEAM(k) do { if (IN(k) && IN((k) + 1)) xcd_barrier(bar); } while (0)
    const int cblk = (int)blockIdx.x;

#ifndef REP_MASK
#define REP_MASK 0
#endif
#ifndef EXTRA_BARS
#define EXTRA_BARS 0
#endif
#define REPS(k) ((((REP_MASK) >> ((k) % 32)) & 1) ? 2 : 1)
#define PHASE(k, ...) do { if (IN(k)) { for (int rep_ = 0; rep_ < REPS(k); ++rep_) { __VA_ARGS__; if (rep_ + 1 < REPS(k)) xcd_barrier(bar); } } SEAM(k); } while (0)
    for (int i = 0; i < EXTRA_BARS; ++i) xcd_barrier(bar);
    PHASE(0, p0_prologue(F));
    PHASE(1, { DenseOrder S{F.W<char>(WS_X2), F.W<char>(WS_WIN0), (size_t)256 * D * 2, (size_t)256 * D * 2, T / 256, DIN0 / 256, F.G, cblk};
        pg8::EpiIn0 E{F.W<bf16_t>(WS_U0)}; pg8::gemm_phase<pg8::EpiIn0, DenseOrder, false>(F.lds, F.wave, 2 * D, 2 * D, 2 * D, S, E); });
    PHASE(2, p_mix0(F));
    PHASE(3, { DenseOrder S{F.W<char>(WS_CAT0), F.W<char>(WS_WOUT0), (size_t)256 * D * 2, (size_t)256 * D * 2, T / 256, D / 256, F.G, cblk};
        pg8::EpiRes<false> E{F.I(0), F.W<float>(WS_YPRE0)}; pg8::gemm_phase<pg8::EpiRes<false>, DenseOrder, false>(F.lds, F.wave, 2 * D, 2 * D, 2 * D, S, E); });
    PHASE(4, p_ln1_route(F, 0, F.W<float>(WS_YPRE0), rep_ + 1 < REPS(4)));
#pragma unroll 1
    for (int layer = 0; layer < 2; ++layer) {
        const int pb = layer == 0 ? 5 : 15;
#if MOE_FP8
        PHASE(pb, { const int nu = moe_setup(F, layer, 2 * DEXP / 256, true, D);
            MoeOrder S{(LAS const int*)(F.lds + UNITS_OFF), nu, F.W<char>(WS_X1Q), F.W<char>(WS_W13) + (size_t)layer * NE * 2 * DEXP * D, (size_t)2 * DEXP * D, (size_t)256 * D, 0, true};
            pg8::EpiMoe1Q E{F.W<unsigned char>(WS_H)}; pg8::gemm_phase<pg8::EpiMoe1Q, MoeOrder, true, 1>(F.lds, F.wave, D, D, D, S, E, 0x01010101 * (127 - SCL_W13 / 2)); });
        PHASE(pb + 1, { const int nu = moe_setup(F, layer, D / 256, false, 0);
            MoeOrder S{(LAS const int*)(F.lds + UNITS_OFF), nu, F.W<char>(WS_H), F.W<char>(WS_W2) + (size_t)layer * NE * D * DEXP, (size_t)D * DEXP, (size_t)256 * DEXP, (size_t)256 * DEXP, false};
            pg8::EpiMoe2 E{F.W<bf16_t>(WS_Y)}; pg8::gemm_phase<pg8::EpiMoe2, MoeOrder, false, 1>(F.lds, F.wave, DEXP, DEXP, DEXP, S, E, 0x01010101 * (127 - SCL_W2 / 2)); });
#else
        PHASE(pb, { const int nu = moe_setup(F, layer, 2 * DEXP / 256, true, 2 * D);
            MoeOrder S{(LAS const int*)(F.lds + UNITS_OFF), nu, F.W<char>(WS_X1), F.W<char>(WS_W13) + (size_t)layer * NE * 2 * DEXP * D * 2, (size_t)2 * DEXP * D * 2, (size_t)256 * D * 2, 0, true};
            pg8::EpiMoe1 E{F.W<bf16_t>(WS_H)}; pg8::gemm_phase<pg8::EpiMoe1, MoeOrder, true>(F.lds, F.wave, 2 * D, 2 * D, 2 * D, S, E); });
        PHASE(pb + 1, { const int nu = moe_setup(F, layer, D / 256, false, 0);
            MoeOrder S{(LAS const int*)(F.lds + UNITS_OFF), nu, F.W<char>(WS_H), F.W<char>(WS_W2) + (size_t)layer * NE * D * DEXP * 2, (size_t)D * DEXP * 2, (size_t)256 * DEXP * 2, (size_t)256 * DEXP * 2, false};
            pg8::EpiMoe2 E{F.W<bf16_t>(WS_Y)}; pg8::gemm_phase<pg8::EpiMoe2, MoeOrder, false>(F.lds, F.wave, 2 * DEXP, 2 * DEXP, 2 * DEXP, S, E); });
#endif
        PHASE(pb + 2, p_combine(F, layer));
        if (layer == 0) {
            PHASE(8, { DenseOrder S{F.W<char>(WS_X2), F.W<char>(WS_WIN1), (size_t)256 * D * 2, (size_t)256 * D * 2, T / 256, 2 * DRNN / 256, F.G, cblk};
                pg8::EpiIn1 E{F.W<bf16_t>(WS_GY), F.W<bf16_t>(WS_XR)}; pg8::gemm_phase<pg8::EpiIn1, DenseOrder, false>(F.lds, F.wave, 2 * D, 2 * D, 2 * D, S, E); });
            PHASE(9, p_conv4(F));
            PHASE(10, { GatesOrder S{F.W<char>(WS_XC), F.W<char>(WS_WGT), F.G, cblk};
                pg8::EpiGates E{F.W<bf16_t>(WS_XC), F.I(16), F.I(18), F.W<float>(WS_SPL), F.W<bf16_t>(WS_XR), F.W<bf16_t>(WS_BV)};
                pg8::gemm_phase<pg8::EpiGates, GatesOrder, false>(F.lds, F.wave, 2 * DRNN, 2 * RBLK, 2 * RBLK, S, E); });
            PHASE(11, p_scan1(F));
            PHASE(12, p_scan2(F, rep_ + 1 < REPS(12)));
            PHASE(13, { DenseOrder S{F.W<char>(WS_GY), F.W<char>(WS_WOUT1), (size_t)256 * DRNN * 2, (size_t)256 * DRNN * 2, T / 256, D / 256, F.G, cblk};
                pg8::EpiRes<true> E{F.W<bf16_t>(WS_X2), F.W<float>(WS_YPRE1)}; pg8::gemm_phase<pg8::EpiRes<true>, DenseOrder, false>(F.lds, F.wave, 2 * DRNN, 2 * DRNN, 2 * DRNN, S, E); });
            PHASE(14, p_ln1_route(F, 1, F.W<float>(WS_YPRE1), rep_ + 1 < REPS(14)));
        }
    }
#undef PHASE
#undef REPS
#undef IN
#undef SEAM
}

static int g_grid = 0;
static inline bool fast_setup() {
    if (g_grid == 0) {
        int dev = 0, cus = 0, per_cu = 0;
        if (hipGetDevice(&dev) != hipSuccess || hipDeviceGetAttribute(&cus, hipDeviceAttributeMultiprocessorCount, dev) != hipSuccess) { fprintf(stderr, "kernel_launch: device query failed\n"); g_grid = -1; return false; }
        if (hipFuncSetAttribute((const void*)mega_fwd, hipFuncAttributeMaxDynamicSharedMemorySize, LDS_BYTES) != hipSuccess) { fprintf(stderr, "kernel_launch: hipFuncSetAttribute failed\n"); g_grid = -1; return false; }
        if (hipOccupancyMaxActiveBlocksPerMultiprocessor(&per_cu, (const void*)mega_fwd, NTHREADS, LDS_BYTES) != hipSuccess || per_cu < 1) { fprintf(stderr, "kernel_launch: occupancy query says %d blocks per CU\n", per_cu); (void)hipGetLastError(); per_cu = 1; }
        g_grid = cus;
        if (g_grid > 256) g_grid = 256;
    }
    return g_grid > 0;
}
static inline void fast_launch(void* const* d_in, void* d_out, void* d_ws, hipStream_t stream, int lo, int hi) {
    Args a{};
    for (int i = 0; i < 26; ++i) a.in[i] = (const float*)d_in[i];
    a.out = (float*)d_out; a.ws = (unsigned char*)d_ws; a.ph_lo = lo; a.ph_hi = hi;
    hipLaunchKernelGGL(mega_fwd, dim3(g_grid), dim3(NTHREADS), LDS_BYTES, stream, a);
}
extern "C" void kernel_launch(void* const* d_in, const int* in_sizes, int n_in, void* d_out, int out_size, void* d_ws, size_t ws_size, hipStream_t stream) {
    if (n_in != 26 || out_size != T * D || ws_size < WS_FAST_END) { fprintf(stderr, "kernel_launch: unexpected shapes (n_in %d out %d ws %zu)\n", n_in, out_size, ws_size); return; }
    if (!fast_setup()) return;
    if (hipMemsetAsync((char*)d_ws + WS_CTL, 0, CTL_ZERO_BYTES, stream) != hipSuccess) { fprintf(stderr, "kernel_launch: memset failed\n"); return; }
    if (N_LAUNCHES == 1) fast_launch(d_in, d_out, d_ws, stream, 0, NPH);
    else for (int p = 0; p < NPH; ++p) fast_launch(d_in, d_out, d_ws, stream, p, p + 1);
}
```

```cpp
#define BUILD_MODE 1
#define N_LAUNCHES 1
#include <hip/hip_runtime.h>
#include <cstdio>
#include <cstdint>
#include <cmath>
constexpr int D = 1024, BATCH = 2, SEQ = 8192, T = BATCH * SEQ, DEPTH = 2;
constexpr int DA = 512, DB = 512, DIN0 = 2 * DA + 3 * DB, CONVA = 31, CONVB = 3;
constexpr int DRNN = 1024, RBLK = 256, RHEADS = 4, CONVC = 4;
constexpr int NE = 16, NG = 4, EPG = 4, DEXP = 1024;
constexpr float LN_EPS = 1e-5f, ALPHA = 1.41421356237309515f;
#define LAS __attribute__((address_space(3)))
#define GAS __attribute__((address_space(1)))
typedef unsigned short bf16_t;
typedef short bf16x8 __attribute__((ext_vector_type(8)));
typedef float f32x4 __attribute__((ext_vector_type(4)));
typedef float f32x2 __attribute__((ext_vector_type(2)));
typedef unsigned u32x4 __attribute__((ext_vector_type(4)));
typedef unsigned u32x2 __attribute__((ext_vector_type(2)));
typedef GAS unsigned gu32;
#define RLX_AGENT __ATOMIC_RELAXED, __HIP_MEMORY_SCOPE_AGENT
#define LDS_WAIT() asm volatile("s_waitcnt lgkmcnt(0)" ::: "memory")
#define VM_WAIT() asm volatile("s_waitcnt vmcnt(0)" ::: "memory")

__device__ __forceinline__ unsigned cvt_pk_bf16(float lo, float hi) { unsigned r; asm volatile("v_cvt_pk_bf16_f32 %0, %1, %2" : "=v"(r) : "v"(lo), "v"(hi)); return r; }
__device__ __forceinline__ unsigned pack4_fp8(float a, float b, float c, float d) { int r = __builtin_amdgcn_cvt_pk_fp8_f32(a, b, 0, false); r = __builtin_amdgcn_cvt_pk_fp8_f32(c, d, r, true); return (unsigned)r; }
__device__ __forceinline__ float bf_lo(unsigned u) { return __uint_as_float(u << 16); }
__device__ __forceinline__ float bf_hi(unsigned u) { return __uint_as_float(u & 0xffff0000u); }
__device__ __forceinline__ float fsigmoid(float x) { return __builtin_amdgcn_rcpf(1.0f + __builtin_amdgcn_exp2f(-1.4426950408889634f * x)); }
__device__ __forceinline__ float fsilu(float x) { return x * fsigmoid(x); }
__device__ __forceinline__ float fgelu_tanh(float x) { return x * fsigmoid(1.5957691216057308f * (x + 0.044715f * x * x * x)); }
__device__ __forceinline__ float dpp_xor1(float v) { return __int_as_float(__builtin_amdgcn_mov_dpp(__float_as_int(v), 0xB1, 0xF, 0xF, true)); }
__device__ __forceinline__ float dpp_xor2(float v) { return __int_as_float(__builtin_amdgcn_mov_dpp(__float_as_int(v), 0x4E, 0xF, 0xF, true)); }
template <int M> __device__ __forceinline__ float swz_xor(float v) { return __int_as_float(__builtin_amdgcn_ds_swizzle(__float_as_int(v), (M << 10) | 0x1F)); }
__device__ __forceinline__ float half_sum(float v) { const auto r = __builtin_amdgcn_permlane32_swap(__float_as_uint(v), __float_as_uint(v), false, false); return __uint_as_float(r[0]) + __uint_as_float(r[1]); }
__device__ __forceinline__ float wave_sum(float v) { v += dpp_xor1(v); v += dpp_xor2(v); v += swz_xor<4>(v); v += swz_xor<8>(v); v += swz_xor<16>(v); return half_sum(v); }
__device__ __forceinline__ int lane_id_asm() { int l; asm volatile("v_mbcnt_lo_u32_b32 %0, -1, 0\n\tv_mbcnt_hi_u32_b32 %0, -1, %0" : "=v"(l)); return l; }

namespace pg8 {
constexpr int BM = 256, BK = 64, HALF = 128, HTB = HALF * BK * 2, STAGE_BYTES = 8 * HTB, NXCD = 8, WGM = 8;
__host__ __device__ __forceinline__ int lds_byte(int r, int c) { const int st = (r >> 4) * 2 + (c >> 5), rr = r & 15, cc = c & 31, ob = rr * 64 + cc * 2; return st * 1024 + (ob ^ (((ob >> 9) & 1) << 5)); }
__host__ __device__ __forceinline__ void stage_rc(int b, int& R, int& C) { const int st = b / 1024, sb = b % 1024, swz = sb ^ (((sb >> 9) & 1) << 5); R = (st >> 1) * 16 + swz / 64; C = (st & 1) * 32 + (swz % 64) / 2; }
__host__ __device__ __forceinline__ int perm32(int rho) { const int n = rho >> 4, i = rho & 15; return 8 * (i >> 2) + 4 * n + (i & 3); }

struct Unit { const char* A; const char* B; int row0, pn, e, gtab; };
__device__ __forceinline__ bool tile_of(int i, int G, int c, int nM, int nN, int& pm, int& pn) {
    const int nwg = nM * nN; const long L = (long)i * G + c; if (L >= nwg) return false;
    int wgid = (int)L; { const int q = nwg / NXCD, r = nwg % NXCD, xcd = wgid % NXCD, off = wgid / NXCD; wgid = (xcd < r ? xcd * (q + 1) : r * (q + 1) + (xcd - r) * q) + off; }
    const int nig = WGM * nN, gid = wgid / nig, fm = gid * WGM, gsz = (nM - fm) < WGM ? (nM - fm) : WGM;
    pm = fm + ((wgid % nig) % gsz); pn = (wgid % nig) / gsz; return true;
}

typedef int i32x8 __attribute__((ext_vector_type(8)));
typedef int i32x4 __attribute__((ext_vector_type(4)));
template <class Epi, class Sched, bool GATHER, int FMT = 0>
__device__ __forceinline__ void gemm_phase(LAS unsigned char* lds, const int wid_in, const int lda, const int ldb, const int KB, const Sched& S, const Epi& E, const int sclb = 0x7f7f7f7f) {
    const int lane = lane_id_asm(), wid = wid_in, tid = wid * 64 + lane, wr = wid >> 2, wc = wid & 3, fr = lane & 15, fq = lane >> 4;
    const int nt = KB / 128;
    int sclr = sclb; if constexpr (FMT == 1) asm volatile("" : "+v"(sclr));
    unsigned voffA[2], voffB[2];
#pragma unroll
    for (int i = 0; i < 2; ++i) { int R, C; stage_rc(tid * 16 + i * 8192, R, C); const int Rb = Epi::PERM ? ((R & ~31) + perm32(R & 31)) : R;
        voffA[i] = (unsigned)(R * lda + C * 2); voffB[i] = (unsigned)(Rb * ldb + C * 2); }
    const size_t kstep = (size_t)(BK * 2);
    const size_t hstepA = (size_t)HALF * lda, hstepB = (size_t)HALF * ldb;
    const unsigned ldsw = (unsigned)wid * 1024u;
    const int aoff = lds_byte(wr * 64 + fr, fq * 8), boff = lds_byte(wc * 32 + fr, fq * 8);
#define PG8_SA(b, h) (((b) * 2 + (h)) * HTB)
#define PG8_SB(b, h) ((4 + (b) * 2 + (h)) * HTB)
#define PG8_ST2(bufoff, gbase, o0, o1) do { \
        __builtin_amdgcn_global_load_lds((const unsigned*)((const char*)(gbase) + (o0)), (LAS unsigned*)(lds + (bufoff) + ldsw), 16, 0, 0); \
        __builtin_amdgcn_global_load_lds((const unsigned*)((const char*)(gbase) + (o1)), (LAS unsigned*)(lds + (bufoff) + ldsw + 8192), 16, 0, 0); } while (0)
#define PG8_STB(bufoff, gbase, h) PG8_ST2(bufoff, (gbase) + (h) * hstepB, voffB[0], voffB[1])
#define PG8_STA(bufoff, gbase, h, G0, G1) do { if constexpr (GATHER) { PG8_ST2(bufoff, gbase, G0, G1); } else { PG8_ST2(bufoff, (gbase) + (h) * hstepA, voffA[0], voffA[1]); } } while (0)
#define PG8_CAT8(l_, h_) __builtin_shufflevector(l_, h_, 0, 1, 2, 3, 4, 5, 6, 7)
#define PG8_LO4(v_) __builtin_bit_cast(bf16x8, __builtin_shufflevector(v_, v_, 0, 1, 2, 3))
#define PG8_HI4(v_) __builtin_bit_cast(bf16x8, __builtin_shufflevector(v_, v_, 4, 5, 6, 7))
#define PG8_LDA(dst, b, h) do { _Pragma("unroll") for (int m = 0; m < 4; ++m) { const i32x4 l_ = *(const LAS i32x4*)(lds + PG8_SA(b, h) + aoff + m * 2048), h_ = *(const LAS i32x4*)(lds + PG8_SA(b, h) + aoff + m * 2048 + 1024); dst[m] = PG8_CAT8(l_, h_); } } while (0)
#define PG8_LDB(dst, b, h) do { _Pragma("unroll") for (int n = 0; n < 2; ++n) { const i32x4 l_ = *(const LAS i32x4*)(lds + PG8_SB(b, h) + boff + n * 2048), h_ = *(const LAS i32x4*)(lds + PG8_SB(b, h) + boff + n * 2048 + 1024); dst[n] = PG8_CAT8(l_, h_); } } while (0)
#define PG8_MMA(ai, bj, At, Bt) do { __builtin_amdgcn_s_setprio(1); _Pragma("unroll") for (int m = 0; m < 4; ++m) _Pragma("unroll") for (int n = 0; n < 2; ++n) { \
        if constexpr (FMT == 0) { acc[ai][bj][m][n] = __builtin_amdgcn_mfma_f32_16x16x32_bf16(PG8_LO4(Bt[n]), PG8_LO4(At[m]), acc[ai][bj][m][n], 0, 0, 0); \
                                  acc[ai][bj][m][n] = __builtin_amdgcn_mfma_f32_16x16x32_bf16(PG8_HI4(Bt[n]), PG8_HI4(At[m]), acc[ai][bj][m][n], 0, 0, 0); } \
        else asm volatile("v_mfma_scale_f32_16x16x128_f8f6f4 %0, %1, %2, %0, %3, %3 op_sel_hi:[0,0,0]" : "+v"(acc[ai][bj][m][n]) : "v"(Bt[n]), "v"(At[m]), "v"(sclr)); } \
        __builtin_amdgcn_s_setprio(0); } while (0)
#define PG8_WAIT_V(n) asm volatile("s_waitcnt vmcnt(" #n ")" ::: "memory")
#define PG8_WAIT_L(n) asm volatile("s_waitcnt lgkmcnt(" #n ")" ::: "memory")
#define PG8_BAR __builtin_amdgcn_s_barrier()
#define PG8_SCHED __builtin_amdgcn_sched_barrier(0)
    Unit cur, nxt; int ui = 0;
    if (!S.next(0, cur)) return;
    f32x4 acc[2][2][4][2];
#pragma unroll
    for (int a = 0; a < 2; ++a)
#pragma unroll
        for (int b = 0; b < 2; ++b)
#pragma unroll
            for (int m = 0; m < 4; ++m)
#pragma unroll
                for (int n = 0; n < 2; ++n) acc[a][b][m][n] = (f32x4){0.f, 0.f, 0.f, 0.f};
    i32x8 At[4], B0[2], B1[2];
    unsigned gc[2][2] = {{0u, 0u}, {0u, 0u}};
    if constexpr (GATHER) {
#pragma unroll
        for (int i = 0; i < 2; ++i) { int R, C; stage_rc(tid * 16 + i * 8192, R, C);
#pragma unroll
            for (int h = 0; h < 2; ++h) gc[h][i] = *(const LAS unsigned*)(lds + cur.gtab + (h * HALF + R) * 4) + (unsigned)C * 2u; }
    }
    const char* cA = cur.A; const char* cB = cur.B;
    PG8_STB(PG8_SB(0, 0), cB, 0); PG8_STB(PG8_SB(0, 1), cB, 1); PG8_STA(PG8_SA(0, 0), cA, 0, gc[0][0], gc[0][1]); PG8_STA(PG8_SA(0, 1), cA, 1, gc[1][0], gc[1][1]);
    if (wr == 1) PG8_BAR;
    PG8_WAIT_V(2); PG8_BAR;
    PG8_STB(PG8_SB(1, 0), cB + kstep, 0); PG8_STA(PG8_SA(1, 0), cA + kstep, 0, gc[0][0], gc[0][1]); PG8_STB(PG8_SB(1, 1), cB + kstep, 1);
    PG8_WAIT_V(6); PG8_BAR;
#define PG8_KITER(a1_, a2_, b2_, G00, G01, G10, G11) do { \
            const char* a3_ = (a2_) + kstep; const char* b3_ = (b2_) + kstep; \
              \
            PG8_LDB(B0, 0, 0); PG8_LDB(B1, 0, 1); PG8_SCHED; PG8_LDA(At, 0, 0); PG8_STA(PG8_SA(1, 1), a1_, 1, gc[1][0], gc[1][1]); \
            PG8_WAIT_V(8); PG8_WAIT_L(0); PG8_BAR; PG8_MMA(0, 0, At, B0); PG8_MMA(0, 1, At, B1); PG8_BAR; PG8_SCHED; \
              \
            PG8_LDA(At, 0, 1); PG8_STB(PG8_SB(0, 0), b2_, 0); PG8_STB(PG8_SB(0, 1), b2_, 1); PG8_STA(PG8_SA(0, 0), a2_, 0, G00, G01); \
            PG8_WAIT_V(8); PG8_WAIT_L(0); PG8_BAR; PG8_MMA(1, 0, At, B0); PG8_MMA(1, 1, At, B1); PG8_BAR; PG8_SCHED; \
              \
            PG8_LDB(B0, 1, 0); PG8_LDB(B1, 1, 1); PG8_SCHED; PG8_LDA(At, 1, 0); PG8_STA(PG8_SA(0, 1), a2_, 1, G10, G11); \
            PG8_WAIT_V(8); PG8_WAIT_L(0); PG8_BAR; PG8_MMA(0, 0, At, B0); PG8_MMA(0, 1, At, B1); PG8_BAR; PG8_SCHED; \
              \
            PG8_LDA(At, 1, 1); PG8_STB(PG8_SB(1, 0), b3_, 0); PG8_STB(PG8_SB(1, 1), b3_, 1); PG8_STA(PG8_SA(1, 0), a3_, 0, G00, G01); \
            PG8_WAIT_V(8); PG8_WAIT_L(0); PG8_BAR; PG8_MMA(1, 0, At, B0); PG8_MMA(1, 1, At, B1); PG8_BAR; PG8_SCHED; } while (0)
    for (;;) {
        const bool has_next = S.next(ui + 1, nxt);
        const char* nA = has_next ? nxt.A : cA; const char* nB = has_next ? nxt.B : cB;
        if constexpr (!GATHER) {
#pragma unroll 1
            for (int t = 0; t < nt; t += 2) {
                const bool last = (t == nt - 2);
                const char* a1 = cA + (size_t)(t + 1) * kstep;
                const char* a2 = last ? nA : cA + (size_t)(t + 2) * kstep; const char* b2 = last ? nB : cB + (size_t)(t + 2) * kstep;
                PG8_KITER(a1, a2, b2, 0u, 0u, 0u, 0u);
            }
        } else {
#pragma unroll 1
            for (int t = 0; t < nt - 2; t += 2) {
                const char* a1 = cA + (size_t)(t + 1) * kstep; const char* a2 = cA + (size_t)(t + 2) * kstep; const char* b2 = cB + (size_t)(t + 2) * kstep;
                PG8_KITER(a1, a2, b2, gc[0][0], gc[0][1], gc[1][0], gc[1][1]);
            }
            unsigned gn[2][2] = {{gc[0][0], gc[0][1]}, {gc[1][0], gc[1][1]}};
            if (has_next) {
                const int tid2 = wid * 64 + lane_id_asm();
#pragma unroll
                for (int i = 0; i < 2; ++i) { int R, C; stage_rc(tid2 * 16 + i * 8192, R, C);
#pragma unroll
                    for (int h = 0; h < 2; ++h) gn[h][i] = *(const LAS unsigned*)(lds + nxt.gtab + (h * HALF + R) * 4) + (unsigned)C * 2u; } }
            const char* a1 = cA + (size_t)(nt - 1) * kstep;
            PG8_KITER(a1, nA, nB, gn[0][0], gn[0][1], gn[1][0], gn[1][1]);
            gc[0][0] = gn[0][0]; gc[0][1] = gn[0][1]; gc[1][0] = gn[1][0]; gc[1][1] = gn[1][1];
        }
        if (wr == 0) PG8_BAR;
        if constexpr (FMT == 1) asm volatile("s_nop 15\n\ts_nop 15" ::: "memory");
        if constexpr (GATHER) { int fr2 = fr, fq2 = fq; asm volatile("" : "+v"(fr2), "+v"(fq2));
            E(acc, cur, wr, wc, fr2, fq2); }
        else E(acc, cur, wr, wc, fr, fq);
        if (!has_next) break;
#pragma unroll
        for (int a = 0; a < 2; ++a)
#pragma unroll
            for (int b = 0; b < 2; ++b)
#pragma unroll
                for (int m = 0; m < 4; ++m)
#pragma unroll
                    for (int n = 0; n < 2; ++n) acc[a][b][m][n] = (f32x4){0.f, 0.f, 0.f, 0.f};
        cur = nxt; cA = nA; cB = nB; ++ui;
        if (wr == 1) PG8_BAR;
    }
    PG8_WAIT_V(0);
    PG8_BAR;
#undef PG8_SA
#undef PG8_SB
#undef PG8_ST2
#undef PG8_STB
#undef PG8_STA
#undef PG8_LDA
#undef PG8_CAT8
#undef PG8_LO4
#undef PG8_HI4
#undef PG8_LDB
#undef PG8_MMA
#undef PG8_WAIT_V
#undef PG8_WAIT_L
#undef PG8_BAR
#undef PG8_SCHED
#undef PG8_KITER
}

typedef f32x4 AccT[2][2][4][2];
__device__ __forceinline__ u32x4 pack8(const f32x4 a, const f32x4 b) { u32x4 w; w.x = cvt_pk_bf16(a[0], a[1]); w.y = cvt_pk_bf16(a[2], a[3]); w.z = cvt_pk_bf16(b[0], b[1]); w.w = cvt_pk_bf16(b[2], b[3]); return w; }
template <int ACT> __device__ __forceinline__ void store_plain(const AccT& acc, bf16_t* O, int ldo, int row0, int col0, int wr, int wc, int fr, int fq) {
#pragma unroll
    for (int ai = 0; ai < 2; ++ai)
#pragma unroll
        for (int m = 0; m < 4; ++m) { bf16_t* rowp = O + (size_t)(row0 + ai * HALF + wr * 64 + m * 16 + fr) * ldo + col0 + wc * 32 + 8 * fq;
#pragma unroll
            for (int bj = 0; bj < 2; ++bj) { f32x4 v0 = acc[ai][bj][m][0], v1 = acc[ai][bj][m][1];
                if (ACT == 1) {
#pragma unroll
                    for (int j = 0; j < 4; ++j) { v0[j] = fgelu_tanh(v0[j]); v1[j] = fgelu_tanh(v1[j]); } }
                *(u32x4*)(rowp + bj * HALF) = pack8(v0, v1); } }
}
template <int MODE> __device__ __forceinline__ void store_pair(const AccT& acc, bf16_t* O, int ldo, int row0, int col0, int wr, int wc, int fr, int fq) {
#pragma unroll
    for (int ai = 0; ai < 2; ++ai)
#pragma unroll
        for (int m = 0; m < 4; ++m) { bf16_t* rowp = O + (size_t)(row0 + ai * HALF + wr * 64 + m * 16 + fr) * ldo + col0 + wc * 32 + 8 * fq;
            f32x4 o[2];
#pragma unroll
            for (int n = 0; n < 2; ++n) { const f32x4 v = acc[ai][0][m][n], g = acc[ai][1][m][n];
#pragma unroll
                for (int j = 0; j < 4; ++j) o[n][j] = MODE == 0 ? v[j] * fsigmoid(g[j]) : (MODE == 1 ? v[j] * g[j] : fsilu(v[j]) * g[j]); }
            *(u32x4*)rowp = pack8(o[0], o[1]); }
}
struct EpiIn0 {
    static constexpr bool PERM = true; bf16_t* U0;
    __device__ __forceinline__ void operator()(const AccT& acc, const Unit& u, int wr, int wc, int fr, int fq) const {
        if (u.pn < 4) store_pair<0>(acc, U0, 1536, u.row0, 128 * u.pn, wr, wc, fr, fq);
        else if (u.pn < 8) store_pair<1>(acc, U0, 1536, u.row0, 512 + 128 * (u.pn - 4), wr, wc, fr, fq);
        else store_plain<0>(acc, U0, 1536, u.row0, 1024 + 256 * (u.pn - 8), wr, wc, fr, fq);
    }
};
struct EpiIn1 {
    static constexpr bool PERM = true; bf16_t* GY; bf16_t* XR;
    __device__ __forceinline__ void operator()(const AccT& acc, const Unit& u, int wr, int wc, int fr, int fq) const {
        if (u.pn < 4) store_plain<1>(acc, GY, D, u.row0, 256 * u.pn, wr, wc, fr, fq);
        else store_plain<0>(acc, XR, D, u.row0, 256 * (u.pn - 4), wr, wc, fr, fq);
    }
};
__device__ __forceinline__ void store_pair_fp8(const AccT& acc, unsigned char* O, int ldo, int row0, int col0, int wr, int wc, int fr, int fq) {
#pragma unroll
    for (int ai = 0; ai < 2; ++ai)
#pragma unroll
        for (int m = 0; m < 4; ++m) { unsigned char* rowp = O + (size_t)(row0 + ai * HALF + wr * 64 + m * 16 + fr) * ldo + col0 + wc * 32 + 8 * fq;
            u32x2 w;
#pragma unroll
            for (int n = 0; n < 2; ++n) { const f32x4 v = acc[ai][0][m][n], g = acc[ai][1][m][n]; float o[4];
#pragma unroll
                for (int j = 0; j < 4; ++j) o[j] = fminf(fmaxf(fsilu(v[j]) * g[j], -448.f), 448.f);
                const unsigned pk = pack4_fp8(o[0], o[1], o[2], o[3]); if (n == 0) w.x = pk; else w.y = pk; }
            *(u32x2*)rowp = w; }
}
struct EpiMoe1Q { static constexpr bool PERM = true; unsigned char* H;
    __device__ __forceinline__ void operator()(const AccT& acc, const Unit& u, int wr, int wc, int fr, int fq) const { store_pair_fp8(acc, H, DEXP, u.row0, 128 * u.pn, wr, wc, fr, fq); } };
struct EpiMoe1 { static constexpr bool PERM = true; bf16_t* H;
    __device__ __forceinline__ void operator()(const AccT& acc, const Unit& u, int wr, int wc, int fr, int fq) const { store_pair<2>(acc, H, DEXP, u.row0, 128 * u.pn, wr, wc, fr, fq); } };
struct EpiMoe2 { static constexpr bool PERM = true; bf16_t* Y;
    __device__ __forceinline__ void operator()(const AccT& acc, const Unit& u, int wr, int wc, int fr, int fq) const { store_plain<0>(acc, Y, D, u.row0, 256 * u.pn, wr, wc, fr, fq); } };
struct EpiRes { static constexpr bool PERM = true; const bf16_t* res; bf16_t* Y;
    __device__ __forceinline__ void operator()(const AccT& acc, const Unit& u, int wr, int wc, int fr, int fq) const {
#pragma unroll
        for (int ai = 0; ai < 2; ++ai)
#pragma unroll
            for (int m = 0; m < 4; ++m) { const size_t off = (size_t)(u.row0 + ai * HALF + wr * 64 + m * 16 + fr) * D + u.pn * 256 + wc * 32 + 8 * fq;
#pragma unroll
                for (int bj = 0; bj < 2; ++bj) { const size_t o = off + bj * HALF; const u32x4 w = *(const u32x4*)(res + o);
                    const f32x4 r0 = {bf_lo(w.x), bf_hi(w.x), bf_lo(w.y), bf_hi(w.y)}, r1 = {bf_lo(w.z), bf_hi(w.z), bf_lo(w.w), bf_hi(w.w)};
                    *(u32x4*)(Y + o) = pack8(r0 * ALPHA + acc[ai][bj][m][0], r1 * ALPHA + acc[ai][bj][m][1]); } }
    }
};
struct EpiGates { static constexpr bool PERM = true; const bf16_t* XC; const float* ba; const float* bx; const float* spl; bf16_t* L2A; bf16_t* BV;
    __device__ __forceinline__ void operator()(const AccT& acc, const Unit& u, int wr, int wc, int fr, int fq) const {
        const int col = 128 * u.pn + wc * 32 + 8 * fq;
#pragma unroll
        for (int ai = 0; ai < 2; ++ai)
#pragma unroll
            for (int m = 0; m < 4; ++m) { const size_t o = (size_t)(u.row0 + ai * HALF + wr * 64 + m * 16 + fr) * DRNN + col;
                const u32x4 xw = *(const u32x4*)(XC + o); const float xv[8] = {bf_lo(xw.x), bf_hi(xw.x), bf_lo(xw.y), bf_hi(xw.y), bf_lo(xw.z), bf_hi(xw.z), bf_lo(xw.w), bf_hi(xw.w)};
                f32x4 la2[2], bo[2];
#pragma unroll
                for (int n = 0; n < 2; ++n) { const f32x4 cba = *(const f32x4*)(ba + col + 4 * n), cbx = *(const f32x4*)(bx + col + 4 * n), csp = *(const f32x4*)(spl + col + 4 * n);
#pragma unroll
                    for (int j = 0; j < 4; ++j) { const float r = fsigmoid(acc[ai][0][m][n][j] + cba[j]), ig = fsigmoid(acc[ai][1][m][n][j] + cbx[j]);
                        const float l2 = -1.4426950408889634f * csp[j] * r;
                        const float a = __builtin_amdgcn_exp2f(l2); la2[n][j] = l2; bo[n][j] = __builtin_sqrtf(fmaxf(1.0f - a * a, 0.f)) * (ig * xv[4 * n + j]); } }
                *(u32x4*)(L2A + o) = pack8(la2[0], la2[1]); *(u32x4*)(BV + o) = pack8(bo[0], bo[1]);
                asm volatile("" ::: "memory"); }
    }
};
}

constexpr size_t MiB = 1u << 20;
constexpr size_t WS_CTL = 0, CTL_ZERO_BYTES = 65536;
constexpr size_t WS_WIN0 = 2 * MiB, WS_WOUT0 = 7 * MiB, WS_WIN1 = 9 * MiB, WS_WGT = 13 * MiB, WS_WOUT1 = 14 * MiB, WS_W13 = 16 * MiB, WS_W2 = 144 * MiB, WS_SPL = 208 * MiB;
constexpr size_t WS_X1 = 212 * MiB, WS_X2 = 244 * MiB, WS_XB = WS_X2;
constexpr size_t WS_R = 276 * MiB;
constexpr size_t WS_U0 = WS_R, WS_CAT0 = WS_R + 48 * MiB, WS_YPRE0 = WS_R + 80 * MiB;
constexpr size_t WS_GY = WS_R, WS_XR = WS_R + 32 * MiB, WS_XC = WS_R + 64 * MiB, WS_BV = WS_R + 96 * MiB, WS_YPRE1 = WS_R + 64 * MiB;
constexpr size_t WS_H = WS_R, WS_Y = WS_R + 72 * MiB;
constexpr size_t WS_LIST = 420 * MiB, WS_TOKSLOT = 421 * MiB, WS_TOKGATE = WS_TOKSLOT + 256 * 1024, WS_AGG = 422 * MiB, WS_X1Q = 424 * MiB  , WS_FAST_END = 440 * MiB;
#ifndef MOE_FP8
#define MOE_FP8 1
#endif
constexpr int SCL_W13 = 6, SCL_W2 = 6;
static_assert(SCL_W13 % 2 == 0 && SCL_W2 % 2 == 0, "even scales");
constexpr int NPAD_ROWS = 2 * T + NE * 256;
static_assert(WS_H + (size_t)NPAD_ROWS * DEXP * 2 <= WS_Y && WS_Y + (size_t)NPAD_ROWS * D * 2 <= WS_LIST, "H / Y fit");
constexpr int CW_TMO = 0, CW_CODE = 1, CW_GCOUNT = 256  , CW_BAR = 4096;
constexpr int RING_BYTES = 131072, LDSCTL_OFF = RING_BYTES, MISC_OFF = LDSCTL_OFF + 320, UNITS_OFF = LDSCTL_OFF + 512, MOEMETA_OFF = LDSCTL_OFF + 768, GTAB_OFF = LDSCTL_OFF + 1024, MAX_UNITS = 8;
constexpr int LDS_BYTES = 147456;
static_assert(GTAB_OFF + MAX_UNITS * 1024 <= LDS_BYTES, "LDS map");
constexpr int NWAVES = 8, NTHREADS = 512;

#define XB_TMO      128
#define XB_XCNT(j)  (256  + 64 * (j))
#define XB_XSUB(j)  (1280 + 64 * (j))
#define XB_XGEN(j)  (2304 + 64 * (j))
#define XB_TOP      3328
#define XB_TOPGEN   3392
#define XCD_BAR_WORDS 3456
#define XB_SPIN_CAP (1u << 18)
__device__ __forceinline__ unsigned xb_ld(unsigned* p)              { return __hip_atomic_load(p, __ATOMIC_RELAXED, __HIP_MEMORY_SCOPE_AGENT); }
__device__ __forceinline__ unsigned xb_add(unsigned* p, unsigned v) { return __hip_atomic_fetch_add(p, v, __ATOMIC_RELAXED, __HIP_MEMORY_SCOPE_AGENT); }
__device__ __forceinline__ unsigned xb_xcc_id() { return (unsigned)__builtin_amdgcn_s_getreg((3 << 11) | 20) & 0xFu; }
#define XB_SPIN(cond, bar) do { unsigned _sp = 0; while (cond) { __builtin_amdgcn_s_sleep(1); \
    if ((++_sp & 255u) == 0u) { if (xb_ld(&(bar)[XB_TMO])) break; if (_sp > XB_SPIN_CAP) { atomicAdd(&(bar)[XB_TMO], 1u); break; } } } } while (0)
struct XcdBarrier { unsigned* bar; unsigned x; volatile LAS unsigned* st; int wave; };
__device__ __forceinline__ XcdBarrier xcd_barrier_post(unsigned* bar, volatile LAS unsigned* st, int wave) {
    XcdBarrier b; b.bar = bar; b.x = xb_xcc_id(); b.st = st; b.wave = wave;
    if (wave == 0 && lane_id_asm() == 0) (void)xb_add(&bar[XB_XCNT(b.x)], 1u);
    return b;
}
__device__ __forceinline__ void xcd_barrier_complete(unsigned* bar, unsigned x, unsigned& nloc, unsigned& nx) {
    const unsigned G = gridDim.x * gridDim.y * gridDim.z;
    unsigned sum, cnt, mine, sp = 0u;
    for (;;) {
        sum = 0u; cnt = 0u; mine = 0u;
#pragma unroll
        for (unsigned j = 0; j < 16; ++j) { const unsigned c = xb_ld(&bar[XB_XCNT(j)]); sum += c; cnt += (c > 0u) ? 1u : 0u; mine = (j == x) ? c : mine; }
        if (sum == G) break;
        __builtin_amdgcn_s_sleep(1);
        if ((++sp & 255u) == 0u) { if (xb_ld(&bar[XB_TMO])) break; if (sp > XB_SPIN_CAP) { atomicAdd(&bar[XB_TMO], 1u); break; } }
    }
    nloc = mine > 0u ? mine : 1u; nx = cnt > 0u ? cnt : 1u;
}
__device__ __forceinline__ void xcd_barrier(const XcdBarrier& b) {
    asm volatile("s_waitcnt vmcnt(0)" ::: "memory");
    __syncthreads();
    if (b.wave == 0 && lane_id_asm() == 0) {
        unsigned* bar = b.bar;
        __builtin_amdgcn_s_waitcnt(0);
        unsigned nloc = b.st[0], nx = b.st[1];
        if (nloc == 0u) { xcd_barrier_complete(bar, b.x, nloc, nx); b.st[0] = nloc; b.st[1] = nx; }
        const unsigned old = xb_add(&bar[XB_XSUB(b.x)], 1u);
        const unsigned gen = old / nloc;
        if (old + 1u == (gen + 1u) * nloc) {
            __builtin_amdgcn_fence(__ATOMIC_RELEASE, "agent");
            asm volatile("s_waitcnt vmcnt(0)" ::: "memory");
            const unsigned og = xb_add(&bar[XB_TOP], 1u);
            const unsigned tg = og / nx;
            if (og + 1u == (tg + 1u) * nx) xb_add(&bar[XB_TOPGEN], 1u);
            else XB_SPIN(xb_ld(&bar[XB_TOPGEN]) == tg, bar);
            __builtin_amdgcn_fence(__ATOMIC_ACQUIRE, "agent");
            xb_add(&bar[XB_XGEN(b.x)], 1u);
            asm volatile("s_waitcnt vmcnt(0)" ::: "memory");
        } else {
            XB_SPIN(xb_ld(&bar[XB_XGEN(b.x)]) == gen, bar);
            __builtin_amdgcn_fence(__ATOMIC_ACQUIRE, "agent");
            asm volatile("s_waitcnt vmcnt(0)" ::: "memory");
        }
    }
    __syncthreads();
}

struct Args { const float* in[26]; float* out; unsigned char* ws; int ph_lo, ph_hi; };
struct Frame {
    LAS unsigned char* lds; unsigned char* ws; const float* const* in; float* out;
    int tid, lane, wave, vcu, G;
    template <class Tp> __device__ __forceinline__ Tp* W(size_t off) const { return (Tp*)(ws + off); }
    __device__ __forceinline__ const float* I(int i) const { return in[i]; }
    __device__ __forceinline__ unsigned* ctl() const { return (unsigned*)(ws + WS_CTL); }
    __device__ __forceinline__ void retid() { lane = lane_id_asm(); tid = wave * 64 + lane; }
};

__device__ __forceinline__ void cvt_item(const float* src, int ldsrc, int k0, int c0, bf16_t* dst, int lddst, int drow0, LAS unsigned* scr, int lane) {
    const int cg = lane & 15, rp = lane >> 4;
    const float* sp = src + (size_t)k0 * ldsrc + c0 + 4 * cg;
    f32x4 v[16];
#pragma unroll
    for (int j = 0; j < 8; ++j) { const int r = 2 * (rp + 4 * j); v[2 * j] = *(const f32x4*)(sp + (size_t)r * ldsrc); v[2 * j + 1] = *(const f32x4*)(sp + (size_t)(r + 1) * ldsrc); }
#pragma unroll
    for (int j = 0; j < 8; ++j) { const int kd = rp + 4 * j;
#pragma unroll
        for (int i = 0; i < 4; ++i) scr[(4 * cg + i) * 33 + kd] = cvt_pk_bf16(v[2 * j][i], v[2 * j + 1][i]); }
    LDS_WAIT();
    const int kc = lane & 7;
#pragma unroll
    for (int jj = 0; jj < 8; ++jj) { const int n = (lane >> 3) + 8 * jj; const LAS unsigned* s = scr + n * 33 + 4 * kc;
        u32x4 o; o.x = s[0]; o.y = s[1]; o.z = s[2]; o.w = s[3];
        *(u32x4*)(dst + (size_t)(drow0 + n) * lddst + k0 + 8 * kc) = o; }
    LDS_WAIT();
}
__device__ __forceinline__ void cvt_item8(const float* src, int ldsrc, int k0, int c0, unsigned char* dst, int lddst, int drow0, float scale, LAS unsigned* scr, int lane) {
    const int cg = lane & 15, rp = lane >> 4;
    const float* sp = src + (size_t)k0 * ldsrc + c0 + 4 * cg;
    f32x4 v[16];
#pragma unroll
    for (int j = 0; j < 4; ++j)
#pragma unroll
        for (int q = 0; q < 4; ++q) v[4 * j + q] = *(const f32x4*)(sp + (size_t)(4 * (rp + 4 * j) + q) * ldsrc);
#pragma unroll
    for (int j = 0; j < 4; ++j) { const int kq = rp + 4 * j;
#pragma unroll
        for (int i = 0; i < 4; ++i) scr[(4 * cg + i) * 17 + kq] = pack4_fp8(v[4 * j][i] * scale, v[4 * j + 1][i] * scale, v[4 * j + 2][i] * scale, v[4 * j + 3][i] * scale); }
    LDS_WAIT();
    const int c4 = lane & 3;
#pragma unroll
    for (int jj = 0; jj < 4; ++jj) { const int n = (lane >> 2) + 16 * jj; const LAS unsigned* s = scr + n * 17 + 4 * c4;
        u32x4 o; o.x = s[0]; o.y = s[1]; o.z = s[2]; o.w = s[3];
        *(u32x4*)(dst + (size_t)(drow0 + n) * lddst + k0 + 16 * c4) = o; }
    LDS_WAIT();
}
__device__ __forceinline__ void p0_prologue(Frame& F) {
    F.retid();
    LAS unsigned* scr = (LAS unsigned*)(F.lds + F.wave * 8448);
    const int gw = F.vcu * NWAVES + F.wave, NGW = F.G * NWAVES;
    constexpr int I_IN0 = 16 * 40, I_OUT0 = 16 * 16, I_IN1 = 16 * 32, I_GT = 4 * 4 * 8, I_OUT1 = 16 * 16, I_W13 = 32 * 16 * 32, I_W2 = 32 * 16 * 16;
    constexpr int NITEMS = I_IN0 + I_OUT0 + I_IN1 + I_GT + I_OUT1 + I_W13 + I_W2;
    for (int it = gw; it < NITEMS; it += NGW) {
        int r = it; const float* src; int ldsrc, k0, sc, lddst, drow0; unsigned char* dst; bool q8 = false; float scale = 1.f;
        if (r < I_IN0) { const int kb = r / 40, db = r % 40, p = db >> 2, q = db & 3;
            if (p < 4) sc = (q < 2) ? 128 * p + 64 * q : 512 + 128 * p + 64 * (q - 2);
            else if (p < 8) sc = (q < 2) ? 1536 + 128 * (p - 4) + 64 * q : 2048 + 128 * (p - 4) + 64 * (q - 2);
            else sc = 1024 + 256 * (p - 8) + 64 * q;
            src = F.I(5); ldsrc = DIN0; k0 = 64 * kb; dst = F.W<unsigned char>(WS_WIN0); lddst = D; drow0 = 64 * db; }
        else if ((r -= I_IN0) < I_OUT0) { const int kb = r / 16, db = r % 16; src = F.I(11); ldsrc = D; k0 = 64 * kb; sc = 64 * db; dst = F.W<unsigned char>(WS_WOUT0); lddst = D; drow0 = 64 * db; }
        else if ((r -= I_OUT0) < I_IN1) { const int kb = r / 32, db = r % 32; src = F.I(12); ldsrc = 2 * DRNN; k0 = 64 * kb; sc = 64 * db; dst = F.W<unsigned char>(WS_WIN1); lddst = D; drow0 = 64 * db; }
        else if ((r -= I_IN1) < I_GT) { const int h = r / 32, r2 = r % 32, kb = r2 / 8, db = r2 % 8, p = db >> 2, q = db & 3;
            src = (q < 2 ? F.I(15) : F.I(17)) + (size_t)h * RBLK * RBLK; ldsrc = RBLK; k0 = 64 * kb; sc = 128 * p + 64 * (q & 1); dst = F.W<unsigned char>(WS_WGT) + (size_t)h * 512 * RBLK * 2; lddst = RBLK; drow0 = 64 * db; }
        else if ((r -= I_GT) < I_OUT1) { const int kb = r / 16, db = r % 16; src = F.I(20); ldsrc = D; k0 = 64 * kb; sc = 64 * db; dst = F.W<unsigned char>(WS_WOUT1); lddst = DRNN; drow0 = 64 * db; }
        else if ((r -= I_OUT1) < I_W13) { const int le = r / 512, r2 = r % 512, kb = r2 / 32, db = r2 % 32, p = db >> 2, q = db & 3;
            src = (q < 2 ? F.I(23) : F.I(24)) + (size_t)le * D * DEXP; ldsrc = DEXP; k0 = 64 * kb; sc = 128 * p + 64 * (q & 1); lddst = D; drow0 = 64 * db;
            q8 = MOE_FP8; scale = (float)(1 << SCL_W13); dst = F.W<unsigned char>(WS_W13) + (size_t)le * 2 * DEXP * D * (MOE_FP8 ? 1 : 2); }
        else { r -= I_W13; const int le = r / 256, r2 = r % 256, kb = r2 / 16, db = r2 % 16;
            src = F.I(25) + (size_t)le * DEXP * D; ldsrc = D; k0 = 64 * kb; sc = 64 * db; lddst = DEXP; drow0 = 64 * db;
            q8 = MOE_FP8; scale = (float)(1 << SCL_W2); dst = F.W<unsigned char>(WS_W2) + (size_t)le * D * DEXP * (MOE_FP8 ? 1 : 2); }
        if (q8) cvt_item8(src, ldsrc, k0, sc, dst, lddst, drow0, scale, scr, F.lane);
        else cvt_item(src, ldsrc, k0, sc, (bf16_t*)dst, lddst, drow0, scr, F.lane);
    }
    { const float* x = F.I(0); bf16_t* xb = F.W<bf16_t>(WS_X2); const size_t n8 = (size_t)T * D / 8, stride = (size_t)F.G * NTHREADS;
      for (size_t i = (size_t)F.vcu * NTHREADS + F.tid; i < n8; i += stride) { const f32x4 a = *(const f32x4*)(x + i * 8), b = *(const f32x4*)(x + i * 8 + 4); *(u32x4*)(xb + i * 8) = pg8::pack8(a, b); } }
    { const int i = F.vcu * NTHREADS + F.tid; if (i < DRNN) F.W<float>(WS_SPL)[i] = 8.0f * log1pf(expf(-F.I(19)[i])); }
}

struct DenseOrder {
    const char* A; const char* B; size_t a_tile, b_tile; int nM, nN, G, c;
    __device__ __forceinline__ bool next(int i, pg8::Unit& u) const { int pm, pn; if (!pg8::tile_of(i, G, c, nM, nN, pm, pn)) return false;
        u.A = A + (size_t)pm * a_tile; u.B = B + (size_t)pn * b_tile; u.row0 = pm * 256; u.pn = pn; u.e = 0; u.gtab = 0; return true; }
};
struct GatesOrder {
    const char* XC; const char* WG; int G, c;
    __device__ __forceinline__ bool next(int i, pg8::Unit& u) const { int pm, pn; if (!pg8::tile_of(i, G, c, T / 256, 2 * RHEADS, pm, pn)) return false;
        u.A = XC + (size_t)pm * 256 * DRNN * 2 + (size_t)(pn >> 1) * RBLK * 2; u.B = WG + (size_t)pn * 256 * RBLK * 2; u.row0 = pm * 256; u.pn = pn; u.e = 0; u.gtab = 0; return true; }
};
struct MoeOrder { LAS const int* units; int nu; const char* A; const char* B; size_t b_exp, b_tile, a_tile; bool gather;
    __device__ __forceinline__ bool next(int i, pg8::Unit& u) const { if (i >= nu) return false;
        const int e = __builtin_amdgcn_readfirstlane(units[4 * i]), pm = __builtin_amdgcn_readfirstlane(units[4 * i + 1]), pn = __builtin_amdgcn_readfirstlane(units[4 * i + 2]);
        u.A = gather ? A : A + (size_t)pm * a_tile; u.B = B + (size_t)e * b_exp + (size_t)pn * b_tile; u.row0 = pm * 256; u.pn = pn; u.e = e; u.gtab = GTAB_OFF + i * 1024; return true; }
};
__device__ __forceinline__ int moe_setup(Frame& F, int layer, int nN, bool gather, unsigned rowbytes) {
    F.retid();
    LAS int* meta = (LAS int*)(F.lds + MOEMETA_OFF); LAS int* units = (LAS int*)(F.lds + UNITS_OFF); LAS unsigned* gtab = (LAS unsigned*)(F.lds + GTAB_OFF);
    const unsigned* gcount = F.ctl() + CW_GCOUNT + 32 * layer;
    if (F.tid < NE) meta[17 + F.tid] = (int)__hip_atomic_load(gcount + F.tid, RLX_AGENT);
    __syncthreads();
    if (F.tid == 0) { int acc = 0; for (int e = 0; e < NE; ++e) { meta[e] = acc; acc += (meta[17 + e] + 255) >> 8; } meta[NE] = acc; }
    __syncthreads();
    const int nM = meta[NE]; int nu = 0;
    for (int i = 0; i < MAX_UNITS; ++i) { int pm, pn; if (!pg8::tile_of(i, F.G, (int)blockIdx.x, nM, nN, pm, pn)) break;
        int e = 0;
#pragma unroll
        for (int j = 1; j < NE; ++j) e += (meta[j] <= pm) ? 1 : 0;
        if (F.tid == 0) { units[4 * i] = e; units[4 * i + 1] = pm; units[4 * i + 2] = pn; units[4 * i + 3] = 0; }
        if (gather && F.tid < 256) { const int idx = (pm - meta[e]) * 256 + F.tid; const int cnt = meta[17 + e];
            const int tok = idx < cnt ? F.W<int>(WS_LIST)[e * T + idx] : 0; gtab[i * 256 + F.tid] = (unsigned)tok * rowbytes; }
        nu = i + 1; }
    __syncthreads();
    return nu;
}

__device__ __forceinline__ void p_mix0(Frame& F) {
    F.retid();
    LAS float* wA = (LAS float*)F.lds;
    LAS float* wB = wA + CONVA * DA;
    LAS float* pb = wB + CONVB * DB;
    for (int i = F.tid; i < CONVA * DA; i += NTHREADS) wA[i] = F.I(6)[i];
    for (int i = F.tid; i < CONVB * DB; i += NTHREADS) wB[i] = F.I(10)[i];
    for (int i = F.tid; i < DA; i += NTHREADS) { pb[i] = F.I(7)[i]; pb[DA + i] = F.I(8)[i]; pb[2 * DA + i] = F.I(9)[i]; }
    __syncthreads();
    const bf16_t* U0 = F.W<bf16_t>(WS_U0); bf16_t* CAT = F.W<bf16_t>(WS_CAT0);
    const int c0 = 8 * F.lane;
#pragma unroll 1
    for (int tb = F.vcu * NWAVES + F.wave; tb < T / 8; tb += F.G * NWAVES) {
        const int t0 = tb * 8, s0 = t0 & (SEQ - 1);
        float acc[8][8];
        { const f32x4 b0 = *(const LAS f32x4*)(pb + c0), b1 = *(const LAS f32x4*)(pb + c0 + 4);
#pragma unroll
          for (int r = 0; r < 8; ++r) { acc[r][0] = b0[0]; acc[r][1] = b0[1]; acc[r][2] = b0[2]; acc[r][3] = b0[3]; acc[r][4] = b1[0]; acc[r][5] = b1[1]; acc[r][6] = b1[2]; acc[r][7] = b1[3]; } }
#pragma unroll
        for (int jb = 0; jb < 5; ++jb) {
            u32x4 in[8];
#pragma unroll
            for (int jj = 0; jj < 8; ++jj) { const int j = jb * 8 + jj; const int d = 30 - j;
                const bool ok = (j < 38) && (s0 - d >= 0); const size_t rr = ok ? (size_t)(t0 - d) : (size_t)t0;
                in[jj] = *(const u32x4*)(U0 + rr * 1536 + c0); if (!ok) in[jj] = (u32x4){0u, 0u, 0u, 0u}; }
#pragma unroll
            for (int jj = 0; jj < 8; ++jj) { const int j = jb * 8 + jj;
                const float x0 = bf_lo(in[jj].x), x1 = bf_hi(in[jj].x), x2 = bf_lo(in[jj].y), x3 = bf_hi(in[jj].y), x4 = bf_lo(in[jj].z), x5 = bf_hi(in[jj].z), x6 = bf_lo(in[jj].w), x7 = bf_hi(in[jj].w);
#pragma unroll
                for (int r = 0; r < 8; ++r) { const int k = j - r; if (k < 0 || k >= CONVA) continue;
                    const f32x4 w0 = *(const LAS f32x4*)(wA + k * DA + c0), w1 = *(const LAS f32x4*)(wA + k * DA + c0 + 4);
                    acc[r][0] += w0[0] * x0; acc[r][1] += w0[1] * x1; acc[r][2] += w0[2] * x2; acc[r][3] += w0[3] * x3;
                    acc[r][4] += w1[0] * x4; acc[r][5] += w1[1] * x5; acc[r][6] += w1[2] * x6; acc[r][7] += w1[3] * x7; } }
        }
        float mean[8], rstd[8];
#pragma unroll
        for (int r = 0; r < 8; ++r) { float sm = 0.f;
#pragma unroll
            for (int j = 0; j < 8; ++j) sm += acc[r][j];
            mean[r] = sm; }
#pragma unroll
        for (int r = 0; r < 8; ++r) mean[r] = wave_sum(mean[r]) * (1.0f / DA);
#pragma unroll
        for (int r = 0; r < 8; ++r) { float q = 0.f;
#pragma unroll
            for (int j = 0; j < 8; ++j) { acc[r][j] -= mean[r]; q += acc[r][j] * acc[r][j]; }
            rstd[r] = q; }
#pragma unroll
        for (int r = 0; r < 8; ++r) rstd[r] = 1.0f / sqrtf(wave_sum(rstd[r]) * (1.0f / DA) + LN_EPS);
        { const f32x4 g0 = *(const LAS f32x4*)(pb + DA + c0), g1 = *(const LAS f32x4*)(pb + DA + c0 + 4), e0 = *(const LAS f32x4*)(pb + 2 * DA + c0), e1 = *(const LAS f32x4*)(pb + 2 * DA + c0 + 4);
#pragma unroll
          for (int r = 0; r < 8; ++r) { f32x4 o0, o1;
#pragma unroll
              for (int j = 0; j < 4; ++j) { o0[j] = fsilu(acc[r][j] * rstd[r] * g0[j] + e0[j]); o1[j] = fsilu(acc[r][4 + j] * rstd[r] * g1[j] + e1[j]); }
              *(u32x4*)(CAT + (size_t)(t0 + r) * D + c0) = pg8::pack8(o0, o1); } }
        { u32x4 cx[10], bbv[8];
#pragma unroll
          for (int j = 0; j < 10; ++j) { const int d = 2 - j; const bool ok = (s0 - d >= 0); const size_t rr = ok ? (size_t)(t0 - d) : (size_t)t0;
              cx[j] = *(const u32x4*)(U0 + rr * 1536 + 512 + c0); if (!ok) cx[j] = (u32x4){0u, 0u, 0u, 0u}; }
#pragma unroll
          for (int r = 0; r < 8; ++r) bbv[r] = *(const u32x4*)(U0 + (size_t)(t0 + r) * 1536 + 1024 + c0);
          f32x4 wv[3][2];
#pragma unroll
          for (int k = 0; k < 3; ++k) { wv[k][0] = *(const LAS f32x4*)(wB + k * DB + c0); wv[k][1] = *(const LAS f32x4*)(wB + k * DB + c0 + 4); }
#pragma unroll
          for (int r = 0; r < 8; ++r) { f32x4 a0 = {0.f, 0.f, 0.f, 0.f}, a1 = {0.f, 0.f, 0.f, 0.f};
#pragma unroll
              for (int k = 0; k < 3; ++k) { const u32x4 w = cx[r + k];
                  a0 += wv[k][0] * (f32x4){bf_lo(w.x), bf_hi(w.x), bf_lo(w.y), bf_hi(w.y)}; a1 += wv[k][1] * (f32x4){bf_lo(w.z), bf_hi(w.z), bf_lo(w.w), bf_hi(w.w)}; }
              const u32x4 bw = bbv[r];
              const f32x4 p0 = a0 * (f32x4){bf_lo(bw.x), bf_hi(bw.x), bf_lo(bw.y), bf_hi(bw.y)}, p1 = a1 * (f32x4){bf_lo(bw.z), bf_hi(bw.z), bf_lo(bw.w), bf_hi(bw.w)};
              *(u32x4*)(CAT + (size_t)(t0 + r) * D + 512 + c0) = pg8::pack8(p0, p1); } }
    }
    __syncthreads();
}

__device__ __forceinline__ void route16(const float (&l)[NE], int& e1, int& e2, float& g1, float& g2) {
    float mx = l[0];
#pragma unroll
    for (int e = 1; e < NE; ++e) mx = fmaxf(mx, l[e]);
    float p[NE];
#pragma unroll
    for (int e = 0; e < NE; ++e) p[e] = __expf(l[e] - mx);
    int gsel = 0; float best = -1.f, bq0 = 0.f, bq1 = 0.f, bq2 = 0.f, bq3 = 0.f;
#pragma unroll
    for (int g = 0; g < NG; ++g) { float m1 = -1.f, m2 = -1.f;
#pragma unroll
        for (int j = 0; j < EPG; ++j) { const float v = p[g * EPG + j]; if (v > m1) { m2 = m1; m1 = v; } else if (v > m2) m2 = v; }
        const float sc = m1 + m2; if (sc > best) { best = sc; gsel = g; bq0 = p[g * EPG]; bq1 = p[g * EPG + 1]; bq2 = p[g * EPG + 2]; bq3 = p[g * EPG + 3]; } }
    int i1 = 0; float p1 = bq0;
    if (bq1 > p1) { p1 = bq1; i1 = 1; } if (bq2 > p1) { p1 = bq2; i1 = 2; } if (bq3 > p1) { p1 = bq3; i1 = 3; }
    int i2 = -1; float p2 = -1.f;
    if (i1 != 0 && bq0 > p2) { p2 = bq0; i2 = 0; } if (i1 != 1 && bq1 > p2) { p2 = bq1; i2 = 1; } if (i1 != 2 && bq2 > p2) { p2 = bq2; i2 = 2; } if (i1 != 3 && bq3 > p2) { p2 = bq3; i2 = 3; }
    e1 = gsel * EPG + i1; e2 = gsel * EPG + i2; const float inv = 1.0f / (p1 + p2); g1 = p1 * inv; g2 = p2 * inv;
}
#ifndef P4_VAR
#define P4_VAR 0
#endif
__device__ __forceinline__ void p_ln1_route(Frame& F, int layer, const bf16_t* YPRE, bool dummy = false) {
    const int var = dummy ? P4_VAR : 0;
    F.retid();
    LAS float* wrT = (LAS float*)F.lds;
    LAS int* rt = (LAS int*)(F.lds + 65536);
    LAS int* re = rt; LAS int* rlp = rt + 128; LAS float* rg = (LAS float*)(rt + 256); LAS int* lcount = rt + 384; LAS int* gbase = rt + 400;
    { const float* wr = F.I(21);
      for (int idx = F.tid; idx < D * NE / 4; idx += NTHREADS) { const f32x4 v = *(const f32x4*)(wr + idx * 4); const int c = idx >> 2, e4 = (idx & 3) * 4;
          wrT[(e4 + 0) * D + c] = v[0]; wrT[(e4 + 1) * D + c] = v[1]; wrT[(e4 + 2) * D + c] = v[2]; wrT[(e4 + 3) * D + c] = v[3]; } }
    const float* g1p = F.I(1) + layer * D; const float* b1p = F.I(2) + layer * D; const float* br = F.I(22);
    bf16_t* X1 = F.W<bf16_t>(WS_X1); unsigned* gcount = F.ctl() + CW_GCOUNT + 32 * layer + (dummy ? 16 : 0);
    int* LIST = F.W<int>(WS_LIST); int* TOKSLOT = F.W<int>(WS_TOKSLOT); float* TOKGATE = F.W<float>(WS_TOKGATE); unsigned char* X1Q = F.W<unsigned char>(WS_X1Q); (void)X1Q;
    const int lane = F.lane;
    for (int tb = F.vcu; tb < T / 64; tb += F.G) {
        if (F.tid < NE) lcount[F.tid] = 0;
        __syncthreads();
        const int tok0 = tb * 64;
        const float brl = br[lane & 15];
#pragma unroll 1
        for (int grp = 0; grp < 2; ++grp) {
            const int rl0 = F.wave * 8 + grp * 4;
            f32x4 x[4][4]; float st[4];
#pragma unroll
            for (int r = 0; r < 4; ++r) { const bf16_t* yr = YPRE + (size_t)(tok0 + rl0 + r) * D + 4 * lane;
#pragma unroll
                for (int j = 0; j < 4; ++j) { const u32x2 w = *(const u32x2*)(yr + 256 * j); x[r][j] = (f32x4){bf_lo(w.x), bf_hi(w.x), bf_lo(w.y), bf_hi(w.y)}; } }
#pragma unroll
            for (int r = 0; r < 4; ++r) { float s_ = 0.f;
#pragma unroll
                for (int j = 0; j < 4; ++j) s_ += (x[r][j][0] + x[r][j][1]) + (x[r][j][2] + x[r][j][3]);
                st[r] = s_; }
#pragma unroll
            for (int r = 0; r < 4; ++r) st[r] = wave_sum(st[r]) * (1.0f / D);
#pragma unroll
            for (int r = 0; r < 4; ++r) { float q = 0.f;
#pragma unroll
                for (int j = 0; j < 4; ++j) { x[r][j] = x[r][j] - st[r]; q += (x[r][j][0] * x[r][j][0] + x[r][j][1] * x[r][j][1]) + (x[r][j][2] * x[r][j][2] + x[r][j][3] * x[r][j][3]); }
                st[r] = q; }
#pragma unroll
            for (int r = 0; r < 4; ++r) st[r] = 1.0f / sqrtf(wave_sum(st[r]) * (1.0f / D) + LN_EPS);
#pragma unroll
            for (int j = 0; j < 4; ++j) { const f32x4 gg = *(const f32x4*)(g1p + 256 * j + 4 * lane), bb = *(const f32x4*)(b1p + 256 * j + 4 * lane);
#pragma unroll
                for (int r = 0; r < 4; ++r) { x[r][j] = x[r][j] * st[r] * gg + bb;
                    u32x2 w; w.x = cvt_pk_bf16(x[r][j][0], x[r][j][1]); w.y = cvt_pk_bf16(x[r][j][2], x[r][j][3]);
                    *(u32x2*)(X1 + (size_t)(tok0 + rl0 + r) * D + 256 * j + 4 * lane) = w;
#if MOE_FP8
                    *(unsigned*)(X1Q + (size_t)(tok0 + rl0 + r) * D + 256 * j + 4 * lane) = pack4_fp8(x[r][j][0], x[r][j][1], x[r][j][2], x[r][j][3]);
#endif
                } }
            if (var == 1) { asm volatile("" :: "v"(x[0][0][0])); continue; }
            int zoff = 0; asm volatile("" : "+v"(zoff));
            const LAS float* wl = wrT + zoff + 4 * lane;
            float pr[4];
            {
                float lg[4][NE];
#pragma unroll
                for (int e = 0; e < NE; ++e) {
#pragma unroll
                    for (int r = 0; r < 4; ++r) lg[r][e] = 0.f;
#pragma unroll
                    for (int j = 0; j < 4; ++j) { const f32x4 w = *(const LAS f32x4*)(wl + e * D + 256 * j);
#pragma unroll
                        for (int r = 0; r < 4; ++r) lg[r][e] += (x[r][j][0] * w[0] + x[r][j][1] * w[1]) + (x[r][j][2] * w[2] + x[r][j][3] * w[3]); } }
                if (var == 2) {
#pragma unroll
                    for (int e = 0; e < NE; ++e) asm volatile("" :: "v"(lg[0][e]), "v"(lg[1][e]), "v"(lg[2][e]), "v"(lg[3][e]));
                    continue; }
#pragma unroll
                for (int r = 0; r < 4; ++r) { float a8[8], a4[4], a2[2];
#pragma unroll
                    for (int i = 0; i < 8; ++i) { const bool hi = lane & 1; const float send = hi ? lg[r][2 * i] : lg[r][2 * i + 1], keep = hi ? lg[r][2 * i + 1] : lg[r][2 * i]; a8[i] = keep + dpp_xor1(send); }
#pragma unroll
                    for (int i = 0; i < 4; ++i) { const bool hi = lane & 2; const float send = hi ? a8[2 * i] : a8[2 * i + 1], keep = hi ? a8[2 * i + 1] : a8[2 * i]; a4[i] = keep + dpp_xor2(send); }
#pragma unroll
                    for (int i = 0; i < 2; ++i) { const bool hi = lane & 4; const float send = hi ? a4[2 * i] : a4[2 * i + 1], keep = hi ? a4[2 * i + 1] : a4[2 * i]; a2[i] = keep + swz_xor<4>(send); }
                    { const bool hi = lane & 8; const float send = hi ? a2[0] : a2[1], keep = hi ? a2[1] : a2[0]; pr[r] = keep + swz_xor<8>(send); } }
            }
            float L;
            { const bool h16 = lane & 16, h32 = lane & 32;
              const float k0 = h16 ? pr[1] : pr[0], s0_ = h16 ? pr[0] : pr[1], k1 = h16 ? pr[3] : pr[2], s1_ = h16 ? pr[2] : pr[3];
              const float u0 = k0 + swz_xor<16>(s0_), u1 = k1 + swz_xor<16>(s1_);
              const float kk = h32 ? u1 : u0, ss = h32 ? u0 : u1;
              L = kk + __int_as_float(__builtin_amdgcn_ds_bpermute((lane ^ 32) << 2, __float_as_int(ss))) + brl; }
            float mx = L; mx = fmaxf(mx, dpp_xor1(mx)); mx = fmaxf(mx, dpp_xor2(mx)); mx = fmaxf(mx, swz_xor<4>(mx)); mx = fmaxf(mx, swz_xor<8>(mx));
            const float p = __expf(L - mx);
            const float q0 = __int_as_float(__builtin_amdgcn_mov_dpp(__float_as_int(p), 0x00, 0xF, 0xF, true)), q1 = __int_as_float(__builtin_amdgcn_mov_dpp(__float_as_int(p), 0x55, 0xF, 0xF, true)),
                        q2 = __int_as_float(__builtin_amdgcn_mov_dpp(__float_as_int(p), 0xAA, 0xF, 0xF, true)), q3 = __int_as_float(__builtin_amdgcn_mov_dpp(__float_as_int(p), 0xFF, 0xF, 0xF, true));
            int i1 = 0; float p1 = q0;
            if (q1 > p1) { p1 = q1; i1 = 1; } if (q2 > p1) { p1 = q2; i1 = 2; } if (q3 > p1) { p1 = q3; i1 = 3; }
            int i2 = -1; float p2 = -1.f;
            if (i1 != 0 && q0 > p2) { p2 = q0; i2 = 0; } if (i1 != 1 && q1 > p2) { p2 = q1; i2 = 1; } if (i1 != 2 && q2 > p2) { p2 = q2; i2 = 2; } if (i1 != 3 && q3 > p2) { p2 = q3; i2 = 3; }
            const int g = (lane >> 2) & 3;
            float bs_ = p1 + p2; int bg = g;
            { const float os = swz_xor<4>(bs_); const int og = __builtin_amdgcn_ds_swizzle(bg, (4 << 10) | 0x1F); if (os > bs_ || (os == bs_ && og < bg)) { bs_ = os; bg = og; } }
            { const float os = swz_xor<8>(bs_); const int og = __builtin_amdgcn_ds_swizzle(bg, (8 << 10) | 0x1F); if (os > bs_ || (os == bs_ && og < bg)) { bs_ = os; bg = og; } }
            if (var == 3) { asm volatile("" :: "v"(bg), "v"(i1), "v"(i2), "v"(p1), "v"(p2)); continue; }
            if (g == bg && (lane & 3) == 0) {
                const int rl = rl0 + (lane >> 4), e1 = 4 * g + i1, e2 = 4 * g + i2; const float inv = 1.0f / (p1 + p2);
                const int lp1 = __hip_atomic_fetch_add(lcount + e1, 1, __ATOMIC_RELAXED, __HIP_MEMORY_SCOPE_WORKGROUP), lp2 = __hip_atomic_fetch_add(lcount + e2, 1, __ATOMIC_RELAXED, __HIP_MEMORY_SCOPE_WORKGROUP);
                re[2 * rl] = e1; re[2 * rl + 1] = e2; rlp[2 * rl] = lp1; rlp[2 * rl + 1] = lp2; rg[2 * rl] = p1 * inv; rg[2 * rl + 1] = p2 * inv; }
        }
        __syncthreads();
        if (var != 0) continue;
        if (F.tid < NE) gbase[F.tid] = (int)__hip_atomic_fetch_add(gcount + F.tid, (unsigned)lcount[F.tid], RLX_AGENT);
        __syncthreads();
        if (F.tid < 128) { const int e = re[F.tid], pos = gbase[e] + rlp[F.tid], tok = tok0 + (F.tid >> 1);
            LIST[e * T + pos] = tok; TOKSLOT[tok * 2 + (F.tid & 1)] = e * T + pos; TOKGATE[tok * 2 + (F.tid & 1)] = rg[F.tid]; }
        __syncthreads();
    }
}

__device__ __forceinline__ void p_combine(Frame& F, int layer) {
    F.retid();
    const unsigned* gcount = F.ctl() + CW_GCOUNT + 32 * layer;
    const int lane = F.lane;
    int pre = 0;
#pragma unroll
    for (int j = 0; j < NE - 1; ++j) { const int cnt = (int)__builtin_amdgcn_readfirstlane(__hip_atomic_load(gcount + j, RLX_AGENT)); pre += ((lane & 15) > j) ? ((cnt + 255) >> 8) * 256 : 0; }
    const bf16_t* X1 = F.W<bf16_t>(WS_X1); const bf16_t* Y = F.W<bf16_t>(WS_Y); const int* TOKSLOT = F.W<int>(WS_TOKSLOT); const float* TOKGATE = F.W<float>(WS_TOKGATE);
    const float* g2p = F.I(3) + layer * D; const float* b2p = F.I(4) + layer * D;
    bf16_t* X2 = F.W<bf16_t>(WS_X2);
    for (int tb = F.vcu * NWAVES + F.wave; tb < T / 8; tb += F.G * NWAVES) {
#pragma unroll 2
        for (int i = 0; i < 8; ++i) { const int t = tb * 8 + i;
            const int s0 = __builtin_amdgcn_readfirstlane(TOKSLOT[2 * t]), s1 = __builtin_amdgcn_readfirstlane(TOKSLOT[2 * t + 1]);
            const float g0 = TOKGATE[2 * t], g1 = TOKGATE[2 * t + 1];
            const int r0 = __builtin_amdgcn_readlane(pre, s0 >> 14) + (s0 & (T - 1)), r1 = __builtin_amdgcn_readlane(pre, s1 >> 14) + (s1 & (T - 1));
            f32x4 v[4]; float s = 0.f;
#pragma unroll
            for (int j = 0; j < 4; ++j) { const u32x2 xw = *(const u32x2*)(X1 + (size_t)t * D + 256 * j + 4 * lane), y0 = *(const u32x2*)(Y + (size_t)r0 * D + 256 * j + 4 * lane), y1 = *(const u32x2*)(Y + (size_t)r1 * D + 256 * j + 4 * lane);
                v[j][0] = ALPHA * bf_lo(xw.x) + (g0 * bf_lo(y0.x) + g1 * bf_lo(y1.x)); v[j][1] = ALPHA * bf_hi(xw.x) + (g0 * bf_hi(y0.x) + g1 * bf_hi(y1.x));
                v[j][2] = ALPHA * bf_lo(xw.y) + (g0 * bf_lo(y0.y) + g1 * bf_lo(y1.y)); v[j][3] = ALPHA * bf_hi(xw.y) + (g0 * bf_hi(y0.y) + g1 * bf_hi(y1.y));
                s += (v[j][0] + v[j][1]) + (v[j][2] + v[j][3]); }
            const float mean = wave_sum(s) * (1.0f / D); float q = 0.f;
#pragma unroll
            for (int j = 0; j < 4; ++j) { v[j] = v[j] - mean; q += (v[j][0] * v[j][0] + v[j][1] * v[j][1]) + (v[j][2] * v[j][2] + v[j][3] * v[j][3]); }
            const float rstd = 1.0f / sqrtf(wave_sum(q) * (1.0f / D) + LN_EPS);
#pragma unroll
            for (int j = 0; j < 4; ++j) { const f32x4 gg = *(const f32x4*)(g2p + 256 * j + 4 * lane), bb = *(const f32x4*)(b2p + 256 * j + 4 * lane); const f32x4 o = v[j] * rstd * gg + bb;
                if (layer == 0) { u32x2 w; w.x = cvt_pk_bf16(o[0], o[1]); w.y = cvt_pk_bf16(o[2], o[3]); *(u32x2*)(X2 + (size_t)t * D + 256 * j + 4 * lane) = w; }
                else *(f32x4*)(F.out + (size_t)t * D + 256 * j + 4 * lane) = o; }
        }
    }
}

__device__ __forceinline__ void p_conv4(Frame& F) {
    F.retid();
    const bf16_t* XR = F.W<bf16_t>(WS_XR); bf16_t* XC = F.W<bf16_t>(WS_XC); const float* w = F.I(13); const float* bias = F.I(14);
    const int lane = F.lane;
#pragma unroll 1
    for (int it = F.vcu * NWAVES + F.wave; it < (T / 8) * 2; it += F.G * NWAVES) {
        const int tb = it >> 1, c0 = 8 * lane + 512 * (it & 1), t0 = tb * 8, s0 = t0 & (SEQ - 1);
        f32x4 wk[CONVC][2], bs[2];
#pragma unroll
        for (int k = 0; k < CONVC; ++k) { wk[k][0] = *(const f32x4*)(w + k * DRNN + c0); wk[k][1] = *(const f32x4*)(w + k * DRNN + c0 + 4); }
        bs[0] = *(const f32x4*)(bias + c0); bs[1] = *(const f32x4*)(bias + c0 + 4);
        u32x4 in[11];
#pragma unroll
        for (int j = 0; j < 11; ++j) { const int d = 3 - j; const bool ok = (s0 - d >= 0); const size_t rr = ok ? (size_t)(t0 - d) : (size_t)t0;
            in[j] = *(const u32x4*)(XR + rr * DRNN + c0); if (!ok) in[j] = (u32x4){0u, 0u, 0u, 0u}; }
#pragma unroll
        for (int r = 0; r < 8; ++r) { f32x4 a0 = bs[0], a1 = bs[1];
#pragma unroll
            for (int k = 0; k < CONVC; ++k) { const u32x4 xw = in[r + k];
                a0 += wk[k][0] * (f32x4){bf_lo(xw.x), bf_hi(xw.x), bf_lo(xw.y), bf_hi(xw.y)}; a1 += wk[k][1] * (f32x4){bf_lo(xw.z), bf_hi(xw.z), bf_lo(xw.w), bf_hi(xw.w)}; }
            *(u32x4*)(XC + (size_t)(t0 + r) * DRNN + c0) = pg8::pack8(a0, a1); }
    }
}

constexpr int SCH = 64, NCHUNK = SEQ / SCH;
__device__ __forceinline__ void p_scan1(Frame& F) {
    F.retid();
    const bf16_t* L2A = F.W<bf16_t>(WS_XR); const bf16_t* BV = F.W<bf16_t>(WS_BV); float* AGG = F.W<float>(WS_AGG);
    for (int task = F.vcu * NWAVES + F.wave; task < BATCH * NCHUNK * 8; task += F.G * NWAVES) {
        const int bc = task >> 3, c = (task & 7) * 128 + 2 * F.lane; const size_t base = (size_t)bc * SCH * DRNN + c;
        float sl0 = 0.f, sl1 = 0.f, h0 = 0.f, h1 = 0.f;
#pragma unroll 16
        for (int s = 0; s < SCH; ++s) { const unsigned lw = *(const unsigned*)(L2A + base + (size_t)s * DRNN), bw = *(const unsigned*)(BV + base + (size_t)s * DRNN);
            const float l0 = bf_lo(lw), l1 = bf_hi(lw); sl0 += l0; sl1 += l1;
            h0 = __builtin_amdgcn_exp2f(l0) * h0 + bf_lo(bw); h1 = __builtin_amdgcn_exp2f(l1) * h1 + bf_hi(bw); }
        *(f32x4*)(AGG + ((size_t)bc * DRNN + c) * 2) = (f32x4){sl0, h0, sl1, h1};
    }
}
__device__ __forceinline__ void p_scan2(Frame& F, bool dummy = false) {
    F.retid();
    const bf16_t* L2A = F.W<bf16_t>(WS_XR); const bf16_t* BV = F.W<bf16_t>(WS_BV); const float* AGG = F.W<float>(WS_AGG); bf16_t* GY = F.W<bf16_t>(WS_GY); bf16_t* OUTB = dummy ? F.W<bf16_t>(WS_XC) : GY;
#pragma unroll 1
    for (int task = F.vcu * NWAVES + F.wave; task < BATCH * NCHUNK * 8; task += F.G * NWAVES) {
        const int bc = task >> 3, c = (task & 7) * 128 + 2 * F.lane; const int b = bc / NCHUNK, ch = bc % NCHUNK;
        float h0 = 0.f, h1 = 0.f;
#pragma unroll 1
        for (int j0 = 0; j0 < ch; j0 += 16) { f32x4 g[16];
#pragma unroll
            for (int i = 0; i < 16; ++i) { const int j = j0 + i; const int jc = j < ch ? j : ch - 1; g[i] = *(const f32x4*)(AGG + ((size_t)(b * NCHUNK + jc) * DRNN + c) * 2); if (j >= ch) g[i] = (f32x4){0.f, 0.f, 0.f, 0.f}; }
#pragma unroll
            for (int i = 0; i < 16; ++i) { h0 = __builtin_amdgcn_exp2f(g[i][0]) * h0 + g[i][1]; h1 = __builtin_amdgcn_exp2f(g[i][2]) * h1 + g[i][3]; } }
        const size_t base = (size_t)bc * SCH * DRNN + c;
#pragma unroll 1
        for (int s0 = 0; s0 < SCH; s0 += 16) { unsigned lw[16], bw[16], gw[16];
#pragma unroll
            for (int i = 0; i < 16; ++i) { const size_t o = base + (size_t)(s0 + i) * DRNN; lw[i] = *(const unsigned*)(L2A + o); bw[i] = *(const unsigned*)(BV + o); gw[i] = *(const unsigned*)(GY + o); }
#pragma unroll
            for (int i = 0; i < 16; ++i) { h0 = __builtin_amdgcn_exp2f(bf_lo(lw[i])) * h0 + bf_lo(bw[i]); h1 = __builtin_amdgcn_exp2f(bf_hi(lw[i])) * h1 + bf_hi(bw[i]);
                gw[i] = cvt_pk_bf16(bf_lo(gw[i]) * h0, bf_hi(gw[i]) * h1); }
#pragma unroll
            for (int i = 0; i < 16; ++i) *(unsigned*)(OUTB + base + (size_t)(s0 + i) * DRNN) = gw[i]; }
    }
}

constexpr int NPH = 18;
#ifndef N_LAUNCHES
#define N_LAUNCHES 1
#endif
__global__ void __launch_bounds__(NTHREADS, 2) mega_fwd(Args args) {
    extern __shared__ __attribute__((aligned(16))) unsigned char lds_raw[];
    Frame F;
    F.lds = (LAS unsigned char*)lds_raw; F.ws = args.ws; F.in = args.in; F.out = args.out;
    F.tid = threadIdx.x; F.lane = F.tid & 63; F.wave = __builtin_amdgcn_readfirstlane(F.tid >> 6);
    F.G = gridDim.x; { const int bx = blockIdx.x; F.vcu = (F.G % 8 == 0) ? (bx % 8) * (F.G / 8) + bx / 8 : bx; }
    for (int u = F.tid; u < (LDS_BYTES - LDSCTL_OFF) / 4; u += NTHREADS) ((LAS unsigned*)(F.lds + LDSCTL_OFF))[u] = 0u;
    __syncthreads();
    XcdBarrier bar; bar.bar = F.ctl() + CW_BAR; bar.x = 0; bar.st = nullptr; bar.wave = F.wave;
    if (N_LAUNCHES == 1) bar = xcd_barrier_post(F.ctl() + CW_BAR, (volatile LAS unsigned*)(F.lds + MISC_OFF) + 8, F.wave);
    const int lo = args.ph_lo, hi = args.ph_hi;
#ifndef PH_MASK
#define PH_MASK 0x3ffff
#endif
#define IN(k) (((PH_MASK >> (k)) & 1) && lo <= (k) && (k) < hi)
#define SEAM(k) do { if (IN(k) && IN((k) + 1)) xcd_barrier(bar); } while (0)
    const int cblk = (int)blockIdx.x;

#ifndef REP_MASK
#define REP_MASK 0
#endif
#ifndef EXTRA_BARS
#define EXTRA_BARS 0
#endif
#define REPS(k) ((((REP_MASK) >> ((k) % 32)) & 1) ? 2 : 1)
#define PHASE(k, ...) do { if (IN(k)) { for (int rep_ = 0; rep_ < REPS(k); ++rep_) { __VA_ARGS__; if (rep_ + 1 < REPS(k)) xcd_barrier(bar); } } SEAM(k); } while (0)
    for (int i = 0; i < EXTRA_BARS; ++i) xcd_barrier(bar);
    PHASE(0, p0_prologue(F));
    PHASE(1, { DenseOrder S{F.W<char>(WS_X2), F.W<char>(WS_WIN0), (size_t)256 * D * 2, (size_t)256 * D * 2, T / 256, DIN0 / 256, F.G, cblk};
        pg8::EpiIn0 E{F.W<bf16_t>(WS_U0)}; pg8::gemm_phase<pg8::EpiIn0, DenseOrder, false>(F.lds, F.wave, 2 * D, 2 * D, 2 * D, S, E); });
    PHASE(2, p_mix0(F));
    PHASE(3, { DenseOrder S{F.W<char>(WS_CAT0), F.W<char>(WS_WOUT0), (size_t)256 * D * 2, (size_t)256 * D * 2, T / 256, D / 256, F.G, cblk};
        pg8::EpiRes E{F.W<bf16_t>(WS_XB), F.W<bf16_t>(WS_YPRE0)}; pg8::gemm_phase<pg8::EpiRes, DenseOrder, false>(F.lds, F.wave, 2 * D, 2 * D, 2 * D, S, E); });
    PHASE(4, p_ln1_route(F, 0, F.W<bf16_t>(WS_YPRE0), rep_ + 1 < REPS(4)));
#pragma unroll 1
    for (int layer = 0; layer < 2; ++layer) {
        const int pb = layer == 0 ? 5 : 15;
#if MOE_FP8
        PHASE(pb, { const int nu = moe_setup(F, layer, 2 * DEXP / 256, true, D);
            MoeOrder S{(LAS const int*)(F.lds + UNITS_OFF), nu, F.W<char>(WS_X1Q), F.W<char>(WS_W13) + (size_t)layer * NE * 2 * DEXP * D, (size_t)2 * DEXP * D, (size_t)256 * D, 0, true};
            pg8::EpiMoe1Q E{F.W<unsigned char>(WS_H)}; pg8::gemm_phase<pg8::EpiMoe1Q, MoeOrder, true, 1>(F.lds, F.wave, D, D, D, S, E, 0x01010101 * (127 - SCL_W13 / 2)); });
        PHASE(pb + 1, { const int nu = moe_setup(F, layer, D / 256, false, 0);
            MoeOrder S{(LAS const int*)(F.lds + UNITS_OFF), nu, F.W<char>(WS_H), F.W<char>(WS_W2) + (size_t)layer * NE * D * DEXP, (size_t)D * DEXP, (size_t)256 * DEXP, (size_t)256 * DEXP, false};
            pg8::EpiMoe2 E{F.W<bf16_t>(WS_Y)}; pg8::gemm_phase<pg8::EpiMoe2, MoeOrder, false, 1>(F.lds, F.wave, DEXP, DEXP, DEXP, S, E, 0x01010101 * (127 - SCL_W2 / 2)); });
#else
        PHASE(pb, { const int nu = moe_setup(F, layer, 2 * DEXP / 256, true, 2 * D);
            MoeOrder S{(LAS const int*)(F.lds + UNITS_OFF), nu, F.W<char>(WS_X1), F.W<char>(WS_W13) + (size_t)layer * NE * 2 * DEXP * D * 2, (size_t)2 * DEXP * D * 2, (size_t)256 * D * 2, 0, true};
            pg8::EpiMoe1 E{F.W<bf16_t>(WS_H)}; pg8::gemm_phase<pg8::EpiMoe1, MoeOrder, true>(F.lds, F.wave, 2 * D, 2 * D, 2 * D, S, E); });
        PHASE(pb + 1, { const int nu = moe_setup(F, layer, D / 256, false, 0);
            MoeOrder S{(LAS const int*)(F.lds + UNITS_OFF), nu, F.W<char>(WS_H), F.W<char>(WS_W2) + (size_t)layer * NE * D * DEXP * 2, (size_t)D * DEXP * 2, (size_t)256 * DEXP * 2, (size_t)256 * DEXP * 2, false};
            pg8::EpiMoe2 E{F.W<bf16_t>(WS_Y)}; pg8::gemm_phase<pg8::EpiMoe2, MoeOrder, false>(F.lds, F.wave, 2 * DEXP, 2 * DEXP, 2 * DEXP, S, E); });
#endif
        PHASE(pb + 2, p_combine(F, layer));
        if (layer == 0) {
            PHASE(8, { DenseOrder S{F.W<char>(WS_X2), F.W<char>(WS_WIN1), (size_t)256 * D * 2, (size_t)256 * D * 2, T / 256, 2 * DRNN / 256, F.G, cblk};
                pg8::EpiIn1 E{F.W<bf16_t>(WS_GY), F.W<bf16_t>(WS_XR)}; pg8::gemm_phase<pg8::EpiIn1, DenseOrder, false>(F.lds, F.wave, 2 * D, 2 * D, 2 * D, S, E); });
            PHASE(9, p_conv4(F));
            PHASE(10, { GatesOrder S{F.W<char>(WS_XC), F.W<char>(WS_WGT), F.G, cblk};
                pg8::EpiGates E{F.W<bf16_t>(WS_XC), F.I(16), F.I(18), F.W<float>(WS_SPL), F.W<bf16_t>(WS_XR), F.W<bf16_t>(WS_BV)};
                pg8::gemm_phase<pg8::EpiGates, GatesOrder, false>(F.lds, F.wave, 2 * DRNN, 2 * RBLK, 2 * RBLK, S, E); });
            PHASE(11, p_scan1(F));
            PHASE(12, p_scan2(F, rep_ + 1 < REPS(12)));
            PHASE(13, { DenseOrder S{F.W<char>(WS_GY), F.W<char>(WS_WOUT1), (size_t)256 * DRNN * 2, (size_t)256 * DRNN * 2, T / 256, D / 256, F.G, cblk};
                pg8::EpiRes E{F.W<bf16_t>(WS_X2), F.W<bf16_t>(WS_YPRE1)}; pg8::gemm_phase<pg8::EpiRes, DenseOrder, false>(F.lds, F.wave, 2 * DRNN, 2 * DRNN, 2 * DRNN, S, E); });
            PHASE(14, p_ln1_route(F, 1, F.W<bf16_t>(WS_YPRE1), rep_ + 1 < REPS(14)));
        }
    }
#undef PHASE
#undef REPS
#undef IN
#undef SEAM
}

static int g_grid = 0;
static inline bool fast_setup() {
    if (g_grid == 0) {
        int dev = 0, cus = 0, per_cu = 0;
        if (hipGetDevice(&dev) != hipSuccess || hipDeviceGetAttribute(&cus, hipDeviceAttributeMultiprocessorCount, dev) != hipSuccess) { fprintf(stderr, "kernel_launch: device query failed\n"); g_grid = -1; return false; }
        if (hipFuncSetAttribute((const void*)mega_fwd, hipFuncAttributeMaxDynamicSharedMemorySize, LDS_BYTES) != hipSuccess) { fprintf(stderr, "kernel_launch: hipFuncSetAttribute failed\n"); g_grid = -1; return false; }
        if (hipOccupancyMaxActiveBlocksPerMultiprocessor(&per_cu, (const void*)mega_fwd, NTHREADS, LDS_BYTES) != hipSuccess || per_cu < 1) { fprintf(stderr, "kernel_launch: occupancy query says %d blocks per CU\n", per_cu); (void)hipGetLastError(); per_cu = 1; }
        g_grid = cus;
        if (g_grid > 256) g_grid = 256;
    }
    return g_grid > 0;
}
static inline void fast_launch(void* const* d_in, void* d_out, void* d_ws, hipStream_t stream, int lo, int hi) {
    Args a{};
    for (int i = 0; i < 26; ++i) a.in[i] = (const float*)d_in[i];
    a.out = (float*)d_out; a.ws = (unsigned char*)d_ws; a.ph_lo = lo; a.ph_hi = hi;
    hipLaunchKernelGGL(mega_fwd, dim3(g_grid), dim3(NTHREADS), LDS_BYTES, stream, a);
}
extern "C" void kernel_launch(void* const* d_in, const int* in_sizes, int n_in, void* d_out, int out_size, void* d_ws, size_t ws_size, hipStream_t stream) {
    if (n_in != 26 || out_size != T * D || ws_size < WS_FAST_END) { fprintf(stderr, "kernel_launch: unexpected shapes (n_in %d out %d ws %zu)\n", n_in, out_size, ws_size); return; }
    if (!fast_setup()) return;
    if (hipMemsetAsync((char*)d_ws + WS_CTL, 0, CTL_ZERO_BYTES, stream) != hipSuccess) { fprintf(stderr, "kernel_launch: memset failed\n"); return; }
    if (N_LAUNCHES == 1) fast_launch(d_in, d_out, d_ws, stream, 0, NPH);
    else for (int p = 0; p < NPH; ++p) fast_launch(d_in, d_out, d_ws, stream, p, p + 1);
}
```

```cpp
#define BUILD_MODE 1
#define N_LAUNCHES 1
#include <hip/hip_runtime.h>
#include <cstdio>
#include <cstdint>
#include <cmath>
constexpr int D = 1024, BATCH = 2, SEQ = 8192, T = BATCH * SEQ, DEPTH = 2;
constexpr int DA = 512, DB = 512, DIN0 = 2 * DA + 3 * DB, CONVA = 31, CONVB = 3;
constexpr int DRNN = 1024, RBLK = 256, RHEADS = 4, CONVC = 4;
constexpr int NE = 16, NG = 4, EPG = 4, DEXP = 1024;
constexpr float LN_EPS = 1e-5f, ALPHA = 1.41421356237309515f;
#define LAS __attribute__((address_space(3)))
#define GAS __attribute__((address_space(1)))
typedef unsigned short bf16_t;
typedef short bf16x8 __attribute__((ext_vector_type(8)));
typedef float f32x4 __attribute__((ext_vector_type(4)));
typedef float f32x2 __attribute__((ext_vector_type(2)));
typedef unsigned u32x4 __attribute__((ext_vector_type(4)));
typedef unsigned u32x2 __attribute__((ext_vector_type(2)));
typedef GAS unsigned gu32;
#define RLX_AGENT __ATOMIC_RELAXED, __HIP_MEMORY_SCOPE_AGENT
#define LDS_WAIT() asm volatile("s_waitcnt lgkmcnt(0)" ::: "memory")
#define VM_WAIT() asm volatile("s_waitcnt vmcnt(0)" ::: "memory")

__device__ __forceinline__ unsigned cvt_pk_bf16(float lo, float hi) { unsigned r; asm volatile("v_cvt_pk_bf16_f32 %0, %1, %2" : "=v"(r) : "v"(lo), "v"(hi)); return r; }
__device__ __forceinline__ unsigned pack4_fp8(float a, float b, float c, float d) { int r = __builtin_amdgcn_cvt_pk_fp8_f32(a, b, 0, false); r = __builtin_amdgcn_cvt_pk_fp8_f32(c, d, r, true); return (unsigned)r; }
__device__ __forceinline__ float bf_lo(unsigned u) { return __uint_as_float(u << 16); }
__device__ __forceinline__ float bf_hi(unsigned u) { return __uint_as_float(u & 0xffff0000u); }
__device__ __forceinline__ float fsigmoid(float x) { return __builtin_amdgcn_rcpf(1.0f + __builtin_amdgcn_exp2f(-1.4426950408889634f * x)); }
__device__ __forceinline__ float fsilu(float x) { return x * fsigmoid(x); }
__device__ __forceinline__ float fgelu_tanh(float x) { return x * fsigmoid(1.5957691216057308f * (x + 0.044715f * x * x * x)); }
__device__ __forceinline__ float dpp_xor1(float v) { return __int_as_float(__builtin_amdgcn_mov_dpp(__float_as_int(v), 0xB1, 0xF, 0xF, true)); }
__device__ __forceinline__ float dpp_xor2(float v) { return __int_as_float(__builtin_amdgcn_mov_dpp(__float_as_int(v), 0x4E, 0xF, 0xF, true)); }
template <int M> __device__ __forceinline__ float swz_xor(float v) { return __int_as_float(__builtin_amdgcn_ds_swizzle(__float_as_int(v), (M << 10) | 0x1F)); }
__device__ __forceinline__ float half_sum(float v) { const auto r = __builtin_amdgcn_permlane32_swap(__float_as_uint(v), __float_as_uint(v), false, false); return __uint_as_float(r[0]) + __uint_as_float(r[1]); }
__device__ __forceinline__ float wave_sum(float v) { v += dpp_xor1(v); v += dpp_xor2(v); v += swz_xor<4>(v); v += swz_xor<8>(v); v += swz_xor<16>(v); return half_sum(v); }
__device__ __forceinline__ int lane_id_asm() { int l; asm volatile("v_mbcnt_lo_u32_b32 %0, -1, 0\n\tv_mbcnt_hi_u32_b32 %0, -1, %0" : "=v"(l)); return l; }

namespace pg8 {
constexpr int BM = 256, BK = 64, HALF = 128, HTB = HALF * BK * 2, STAGE_BYTES = 8 * HTB, NXCD = 8, WGM = 8;
__host__ __device__ __forceinline__ int lds_byte(int r, int c) { const int st = (r >> 4) * 2 + (c >> 5), rr = r & 15, cc = c & 31, ob = rr * 64 + cc * 2; return st * 1024 + (ob ^ (((ob >> 9) & 1) << 5)); }
__host__ __device__ __forceinline__ void stage_rc(int b, int& R, int& C) { const int st = b / 1024, sb = b % 1024, swz = sb ^ (((sb >> 9) & 1) << 5); R = (st >> 1) * 16 + swz / 64; C = (st & 1) * 32 + (swz % 64) / 2; }
__host__ __device__ __forceinline__ int perm32(int rho) { const int n = rho >> 4, i = rho & 15; return 8 * (i >> 2) + 4 * n + (i & 3); }

struct Unit { const char* A; const char* B; int row0, pn, e, gtab; };
__device__ __forceinline__ bool tile_of(int i, int G, int c, int nM, int nN, int& pm, int& pn) {
    const int nwg = nM * nN; const long L = (long)i * G + c; if (L >= nwg) return false;
    int wgid = (int)L; { const int q = nwg / NXCD, r = nwg % NXCD, xcd = wgid % NXCD, off = wgid / NXCD; wgid = (xcd < r ? xcd * (q + 1) : r * (q + 1) + (xcd - r) * q) + off; }
    const int nig = WGM * nN, gid = wgid / nig, fm = gid * WGM, gsz = (nM - fm) < WGM ? (nM - fm) : WGM;
    pm = fm + ((wgid % nig) % gsz); pn = (wgid % nig) / gsz; return true;
}

typedef int i32x8 __attribute__((ext_vector_type(8)));
typedef int i32x4 __attribute__((ext_vector_type(4)));
template <class Epi, class Sched, bool GATHER, int FMT = 0>
__device__ __forceinline__ void gemm_phase(LAS unsigned char* lds, const int wid_in, const int lda, const int ldb, const int KB, const Sched& S, const Epi& E, const int sclb = 0x7f7f7f7f) {
    const int lane = lane_id_asm(), wid = wid_in, tid = wid * 64 + lane, wr = wid >> 2, wc = wid & 3, fr = lane & 15, fq = lane >> 4;
    const int nt = KB / 128;
    int sclr = sclb; if constexpr (FMT == 1) asm volatile("" : "+v"(sclr));
    unsigned voffA[2], voffB[2];
#pragma unroll
    for (int i = 0; i < 2; ++i) { int R, C; stage_rc(tid * 16 + i * 8192, R, C); const int Rb = Epi::PERM ? ((R & ~31) + perm32(R & 31)) : R;
        voffA[i] = (unsigned)(R * lda + C * 2); voffB[i] = (unsigned)(Rb * ldb + C * 2); }
    const size_t kstep = (size_t)(BK * 2);
    const size_t hstepA = (size_t)HALF * lda, hstepB = (size_t)HALF * ldb;
    const unsigned ldsw = (unsigned)wid * 1024u;
    const int aoff = lds_byte(wr * 64 + fr, fq * 8), boff = lds_byte(wc * 32 + fr, fq * 8);
#define PG8_SA(b, h) (((b) * 2 + (h)) * HTB)
#define PG8_SB(b, h) ((4 + (b) * 2 + (h)) * HTB)
#define PG8_ST2(bufoff, gbase, o0, o1) do { \
        __builtin_amdgcn_global_load_lds((const unsigned*)((const char*)(gbase) + (o0)), (LAS unsigned*)(lds + (bufoff) + ldsw), 16, 0, 0); \
        __builtin_amdgcn_global_load_lds((const unsigned*)((const char*)(gbase) + (o1)), (LAS unsigned*)(lds + (bufoff) + ldsw + 8192), 16, 0, 0); } while (0)
#define PG8_STB(bufoff, gbase, h) PG8_ST2(bufoff, (gbase) + (h) * hstepB, voffB[0], voffB[1])
#define PG8_STA(bufoff, gbase, h, G0, G1) do { if constexpr (GATHER) { PG8_ST2(bufoff, gbase, G0, G1); } else { PG8_ST2(bufoff, (gbase) + (h) * hstepA, voffA[0], voffA[1]); } } while (0)
#define PG8_CAT8(l_, h_) __builtin_shufflevector(l_, h_, 0, 1, 2, 3, 4, 5, 6, 7)
#define PG8_LO4(v_) __builtin_bit_cast(bf16x8, __builtin_shufflevector(v_, v_, 0, 1, 2, 3))
#define PG8_HI4(v_) __builtin_bit_cast(bf16x8, __builtin_shufflevector(v_, v_, 4, 5, 6, 7))
#define PG8_LDA(dst, b, h) do { _Pragma("unroll") for (int m = 0; m < 4; ++m) { const i32x4 l_ = *(const LAS i32x4*)(lds + PG8_SA(b, h) + aoff + m * 2048), h_ = *(const LAS i32x4*)(lds + PG8_SA(b, h) + aoff + m * 2048 + 1024); dst[m] = PG8_CAT8(l_, h_); } } while (0)
#define PG8_LDB(dst, b, h) do { _Pragma("unroll") for (int n = 0; n < 2; ++n) { const i32x4 l_ = *(const LAS i32x4*)(lds + PG8_SB(b, h) + boff + n * 2048), h_ = *(const LAS i32x4*)(lds + PG8_SB(b, h) + boff + n * 2048 + 1024); dst[n] = PG8_CAT8(l_, h_); } } while (0)
#define PG8_MMA(ai, bj, At, Bt) do { __builtin_amdgcn_s_setprio(1); _Pragma("unroll") for (int m = 0; m < 4; ++m) _Pragma("unroll") for (int n = 0; n < 2; ++n) { \
        if constexpr (FMT == 0) { acc[ai][bj][m][n] = __builtin_amdgcn_mfma_f32_16x16x32_bf16(PG8_LO4(Bt[n]), PG8_LO4(At[m]), acc[ai][bj][m][n], 0, 0, 0); \
                                  acc[ai][bj][m][n] = __builtin_amdgcn_mfma_f32_16x16x32_bf16(PG8_HI4(Bt[n]), PG8_HI4(At[m]), acc[ai][bj][m][n], 0, 0, 0); } \
        else asm volatile("v_mfma_scale_f32_16x16x128_f8f6f4 %0, %1, %2, %0, %3, %3 op_sel_hi:[0,0,0]" : "+v"(acc[ai][bj][m][n]) : "v"(Bt[n]), "v"(At[m]), "v"(sclr)); } \
        __builtin_amdgcn_s_setprio(0); } while (0)
#define PG8_WAIT_V(n) asm volatile("s_waitcnt vmcnt(" #n ")" ::: "memory")
#define PG8_WAIT_L(n) asm volatile("s_waitcnt lgkmcnt(" #n ")" ::: "memory")
#define PG8_BAR __builtin_amdgcn_s_barrier()
#define PG8_SCHED __builtin_amdgcn_sched_barrier(0)
    Unit cur, nxt; int ui = 0;
    if (!S.next(0, cur)) return;
    f32x4 acc[2][2][4][2];
#pragma unroll
    for (int a = 0; a < 2; ++a)
#pragma unroll
        for (int b = 0; b < 2; ++b)
#pragma unroll
            for (int m = 0; m < 4; ++m)
#pragma unroll
                for (int n = 0; n < 2; ++n) acc[a][b][m][n] = (f32x4){0.f, 0.f, 0.f, 0.f};
    i32x8 At[4], B0[2], B1[2];
    unsigned gc[2][2] = {{0u, 0u}, {0u, 0u}};
    if constexpr (GATHER) {
#pragma unroll
        for (int i = 0; i < 2; ++i) { int R, C; stage_rc(tid * 16 + i * 8192, R, C);
#pragma unroll
            for (int h = 0; h < 2; ++h) gc[h][i] = *(const LAS unsigned*)(lds + cur.gtab + (h * HALF + R) * 4) + (unsigned)C * 2u; }
    }
    const char* cA = cur.A; const char* cB = cur.B;
    PG8_STB(PG8_SB(0, 0), cB, 0); PG8_STB(PG8_SB(0, 1), cB, 1); PG8_STA(PG8_SA(0, 0), cA, 0, gc[0][0], gc[0][1]); PG8_STA(PG8_SA(0, 1), cA, 1, gc[1][0], gc[1][1]);
    if (wr == 1) PG8_BAR;
    PG8_WAIT_V(2); PG8_BAR;
    PG8_STB(PG8_SB(1, 0), cB + kstep, 0); PG8_STA(PG8_SA(1, 0), cA + kstep, 0, gc[0][0], gc[0][1]); PG8_STB(PG8_SB(1, 1), cB + kstep, 1);
    PG8_WAIT_V(6); PG8_BAR;
#define PG8_KITER(a1_, a2_, b2_, G00, G01, G10, G11) do { \
            const char* a3_ = (a2_) + kstep; const char* b3_ = (b2_) + kstep; \
              \
            PG8_LDB(B0, 0, 0); PG8_LDB(B1, 0, 1); PG8_SCHED; PG8_LDA(At, 0, 0); PG8_STA(PG8_SA(1, 1), a1_, 1, gc[1][0], gc[1][1]); \
            PG8_WAIT_V(8); PG8_WAIT_L(0); PG8_BAR; PG8_MMA(0, 0, At, B0); PG8_MMA(0, 1, At, B1); PG8_BAR; PG8_SCHED; \
              \
            PG8_LDA(At, 0, 1); PG8_STB(PG8_SB(0, 0), b2_, 0); PG8_STB(PG8_SB(0, 1), b2_, 1); PG8_STA(PG8_SA(0, 0), a2_, 0, G00, G01); \
            PG8_WAIT_V(8); PG8_WAIT_L(0); PG8_BAR; PG8_MMA(1, 0, At, B0); PG8_MMA(1, 1, At, B1); PG8_BAR; PG8_SCHED; \
              \
            PG8_LDB(B0, 1, 0); PG8_LDB(B1, 1, 1); PG8_SCHED; PG8_LDA(At, 1, 0); PG8_STA(PG8_SA(0, 1), a2_, 1, G10, G11); \
            PG8_WAIT_V(8); PG8_WAIT_L(0); PG8_BAR; PG8_MMA(0, 0, At, B0); PG8_MMA(0, 1, At, B1); PG8_BAR; PG8_SCHED; \
              \
            PG8_LDA(At, 1, 1); PG8_STB(PG8_SB(1, 0), b3_, 0); PG8_STB(PG8_SB(1, 1), b3_, 1); PG8_STA(PG8_SA(1, 0), a3_, 0, G00, G01); \
            PG8_WAIT_V(8); PG8_WAIT_L(0); PG8_BAR; PG8_MMA(1, 0, At, B0); PG8_MMA(1, 1, At, B1); PG8_BAR; PG8_SCHED; } while (0)
    for (;;) {
        const bool has_next = S.next(ui + 1, nxt);
        const char* nA = has_next ? nxt.A : cA; const char* nB = has_next ? nxt.B : cB;
        if constexpr (!GATHER) {
#pragma unroll 1
            for (int t = 0; t < nt; t += 2) {
                const bool last = (t == nt - 2);
                const char* a1 = cA + (size_t)(t + 1) * kstep;
                const char* a2 = last ? nA : cA + (size_t)(t + 2) * kstep; const char* b2 = last ? nB : cB + (size_t)(t + 2) * kstep;
                PG8_KITER(a1, a2, b2, 0u, 0u, 0u, 0u);
            }
        } else {
#pragma unroll 1
            for (int t = 0; t < nt - 2; t += 2) {
                const char* a1 = cA + (size_t)(t + 1) * kstep; const char* a2 = cA + (size_t)(t + 2) * kstep; const char* b2 = cB + (size_t)(t + 2) * kstep;
                PG8_KITER(a1, a2, b2, gc[0][0], gc[0][1], gc[1][0], gc[1][1]);
            }
            unsigned gn[2][2] = {{gc[0][0], gc[0][1]}, {gc[1][0], gc[1][1]}};
            if (has_next) {
                const int tid2 = wid * 64 + lane_id_asm();
#pragma unroll
                for (int i = 0; i < 2; ++i) { int R, C; stage_rc(tid2 * 16 + i * 8192, R, C);
#pragma unroll
                    for (int h = 0; h < 2; ++h) gn[h][i] = *(const LAS unsigned*)(lds + nxt.gtab + (h * HALF + R) * 4) + (unsigned)C * 2u; } }
            const char* a1 = cA + (size_t)(nt - 1) * kstep;
            PG8_KITER(a1, nA, nB, gn[0][0], gn[0][1], gn[1][0], gn[1][1]);
            gc[0][0] = gn[0][0]; gc[0][1] = gn[0][1]; gc[1][0] = gn[1][0]; gc[1][1] = gn[1][1];
        }
        if (wr == 0) PG8_BAR;
        if constexpr (FMT == 1) asm volatile("s_nop 15\n\ts_nop 15" ::: "memory");
        if constexpr (GATHER) { int fr2 = fr, fq2 = fq; asm volatile("" : "+v"(fr2), "+v"(fq2));
            E(acc, cur, wr, wc, fr2, fq2); }
        else E(acc, cur, wr, wc, fr, fq);
        if (!has_next) break;
#pragma unroll
        for (int a = 0; a < 2; ++a)
#pragma unroll
            for (int b = 0; b < 2; ++b)
#pragma unroll
                for (int m = 0; m < 4; ++m)
#pragma unroll
                    for (int n = 0; n < 2; ++n) acc[a][b][m][n] = (f32x4){0.f, 0.f, 0.f, 0.f};
        cur = nxt; cA = nA; cB = nB; ++ui;
        if (wr == 1) PG8_BAR;
    }
    PG8_WAIT_V(0);
    PG8_BAR;
#undef PG8_SA
#undef PG8_SB
#undef PG8_ST2
#undef PG8_STB
#undef PG8_STA
#undef PG8_LDA
#undef PG8_CAT8
#undef PG8_LO4
#undef PG8_HI4
#undef PG8_LDB
#undef PG8_MMA
#undef PG8_WAIT_V
#undef PG8_WAIT_L
#undef PG8_BAR
#undef PG8_SCHED
#undef PG8_KITER
}

typedef f32x4 AccT[2][2][4][2];
__device__ __forceinline__ u32x4 pack8(const f32x4 a, const f32x4 b) { u32x4 w; w.x = cvt_pk_bf16(a[0], a[1]); w.y = cvt_pk_bf16(a[2], a[3]); w.z = cvt_pk_bf16(b[0], b[1]); w.w = cvt_pk_bf16(b[2], b[3]); return w; }
template <int ACT> __device__ __forceinline__ void store_plain(const AccT& acc, bf16_t* O, int ldo, int row0, int col0, int wr, int wc, int fr, int fq) {
#pragma unroll
    for (int ai = 0; ai < 2; ++ai)
#pragma unroll
        for (int m = 0; m < 4; ++m) { bf16_t* rowp = O + (size_t)(row0 + ai * HALF + wr * 64 + m * 16 + fr) * ldo + col0 + wc * 32 + 8 * fq;
#pragma unroll
            for (int bj = 0; bj < 2; ++bj) { f32x4 v0 = acc[ai][bj][m][0], v1 = acc[ai][bj][m][1];
                if (ACT == 1) {
#pragma unroll
                    for (int j = 0; j < 4; ++j) { v0[j] = fgelu_tanh(v0[j]); v1[j] = fgelu_tanh(v1[j]); } }
                *(u32x4*)(rowp + bj * HALF) = pack8(v0, v1); } }
}
template <int MODE> __device__ __forceinline__ void store_pair(const AccT& acc, bf16_t* O, int ldo, int row0, int col0, int wr, int wc, int fr, int fq) {
#pragma unroll
    for (int ai = 0; ai < 2; ++ai)
#pragma unroll
        for (int m = 0; m < 4; ++m) { bf16_t* rowp = O + (size_t)(row0 + ai * HALF + wr * 64 + m * 16 + fr) * ldo + col0 + wc * 32 + 8 * fq;
            f32x4 o[2];
#pragma unroll
            for (int n = 0; n < 2; ++n) { const f32x4 v = acc[ai][0][m][n], g = acc[ai][1][m][n];
#pragma unroll
                for (int j = 0; j < 4; ++j) o[n][j] = MODE == 0 ? v[j] * fsigmoid(g[j]) : (MODE == 1 ? v[j] * g[j] : fsilu(v[j]) * g[j]); }
            *(u32x4*)rowp = pack8(o[0], o[1]); }
}
struct EpiIn0 {
    static constexpr bool PERM = true; bf16_t* U0;
    __device__ __forceinline__ void operator()(const AccT& acc, const Unit& u, int wr, int wc, int fr, int fq) const {
        if (u.pn < 4) store_pair<0>(acc, U0, 1536, u.row0, 128 * u.pn, wr, wc, fr, fq);
        else if (u.pn < 8) store_pair<1>(acc, U0, 1536, u.row0, 512 + 128 * (u.pn - 4), wr, wc, fr, fq);
        else store_plain<0>(acc, U0, 1536, u.row0, 1024 + 256 * (u.pn - 8), wr, wc, fr, fq);
    }
};
struct EpiIn1 {
    static constexpr bool PERM = true; bf16_t* GY; bf16_t* XR;
    __device__ __forceinline__ void operator()(const AccT& acc, const Unit& u, int wr, int wc, int fr, int fq) const {
        if (u.pn < 4) store_plain<1>(acc, GY, D, u.row0, 256 * u.pn, wr, wc, fr, fq);
        else store_plain<0>(acc, XR, D, u.row0, 256 * (u.pn - 4), wr, wc, fr, fq);
    }
};
__device__ __forceinline__ void store_pair_fp8(const AccT& acc, unsigned char* O, int ldo, int row0, int col0, int wr, int wc, int fr, int fq) {
#pragma unroll
    for (int ai = 0; ai < 2; ++ai)
#pragma unroll
        for (int m = 0; m < 4; ++m) { unsigned char* rowp = O + (size_t)(row0 + ai * HALF + wr * 64 + m * 16 + fr) * ldo + col0 + wc * 32 + 8 * fq;
            u32x2 w;
#pragma unroll
            for (int n = 0; n < 2; ++n) { const f32x4 v = acc[ai][0][m][n], g = acc[ai][1][m][n]; float o[4];
#pragma unroll
                for (int j = 0; j < 4; ++j) o[j] = fminf(fmaxf(fsilu(v[j]) * g[j], -448.f), 448.f);
                const unsigned pk = pack4_fp8(o[0], o[1], o[2], o[3]); if (n == 0) w.x = pk; else w.y = pk; }
            *(u32x2*)rowp = w; }
}
struct EpiMoe1Q { static constexpr bool PERM = true; unsigned char* H;
    __device__ __forceinline__ void operator()(const AccT& acc, const Unit& u, int wr, int wc, int fr, int fq) const { store_pair_fp8(acc, H, DEXP, u.row0, 128 * u.pn, wr, wc, fr, fq); } };
struct EpiMoe1 { static constexpr bool PERM = true; bf16_t* H;
    __device__ __forceinline__ void operator()(const AccT& acc, const Unit& u, int wr, int wc, int fr, int fq) const { store_pair<2>(acc, H, DEXP, u.row0, 128 * u.pn, wr, wc, fr, fq); } };
struct EpiMoe2 { static constexpr bool PERM = true; bf16_t* Y;
    __device__ __forceinline__ void operator()(const AccT& acc, const Unit& u, int wr, int wc, int fr, int fq) const { store_plain<0>(acc, Y, D, u.row0, 256 * u.pn, wr, wc, fr, fq); } };
struct EpiRes { static constexpr bool PERM = true; const bf16_t* res; bf16_t* Y;
    __device__ __forceinline__ void operator()(const AccT& acc, const Unit& u, int wr, int wc, int fr, int fq) const {
#pragma unroll
        for (int ai = 0; ai < 2; ++ai)
#pragma unroll
            for (int m = 0; m < 4; ++m) { const size_t off = (size_t)(u.row0 + ai * HALF + wr * 64 + m * 16 + fr) * D + u.pn * 256 + wc * 32 + 8 * fq;
#pragma unroll
                for (int bj = 0; bj < 2; ++bj) { const size_t o = off + bj * HALF; const u32x4 w = *(const u32x4*)(res + o);
                    const f32x4 r0 = {bf_lo(w.x), bf_hi(w.x), bf_lo(w.y), bf_hi(w.y)}, r1 = {bf_lo(w.z), bf_hi(w.z), bf_lo(w.w), bf_hi(w.w)};
                    *(u32x4*)(Y + o) = pack8(r0 * ALPHA + acc[ai][bj][m][0], r1 * ALPHA + acc[ai][bj][m][1]); } }
    }
};
struct EpiGates { static constexpr bool PERM = true; const bf16_t* XC; const float* ba; const float* bx; const float* spl; bf16_t* L2A; bf16_t* BV;
    __device__ __forceinline__ void operator()(const AccT& acc, const Unit& u, int wr, int wc, int fr, int fq) const {
        const int col = 128 * u.pn + wc * 32 + 8 * fq;
#pragma unroll
        for (int ai = 0; ai < 2; ++ai)
#pragma unroll
            for (int m = 0; m < 4; ++m) { const size_t o = (size_t)(u.row0 + ai * HALF + wr * 64 + m * 16 + fr) * DRNN + col;
                const u32x4 xw = *(const u32x4*)(XC + o); const float xv[8] = {bf_lo(xw.x), bf_hi(xw.x), bf_lo(xw.y), bf_hi(xw.y), bf_lo(xw.z), bf_hi(xw.z), bf_lo(xw.w), bf_hi(xw.w)};
                f32x4 la2[2], bo[2];
#pragma unroll
                for (int n = 0; n < 2; ++n) { const f32x4 cba = *(const f32x4*)(ba + col + 4 * n), cbx = *(const f32x4*)(bx + col + 4 * n), csp = *(const f32x4*)(spl + col + 4 * n);
#pragma unroll
                    for (int j = 0; j < 4; ++j) { const float r = fsigmoid(acc[ai][0][m][n][j] + cba[j]), ig = fsigmoid(acc[ai][1][m][n][j] + cbx[j]);
                        const float l2 = -1.4426950408889634f * csp[j] * r;
                        const float a = __builtin_amdgcn_exp2f(l2); la2[n][j] = l2; bo[n][j] = __builtin_sqrtf(fmaxf(1.0f - a * a, 0.f)) * (ig * xv[4 * n + j]); } }
                *(u32x4*)(L2A + o) = pack8(la2[0], la2[1]); *(u32x4*)(BV + o) = pack8(bo[0], bo[1]);
                asm volatile("" ::: "memory"); }
    }
};
}

constexpr size_t MiB = 1u << 20;
constexpr size_t WS_CTL = 0, CTL_ZERO_BYTES = 65536;
constexpr size_t WS_WIN0 = 2 * MiB, WS_WOUT0 = 7 * MiB, WS_WIN1 = 9 * MiB, WS_WGT = 13 * MiB, WS_WOUT1 = 14 * MiB, WS_W13 = 16 * MiB, WS_W2 = 144 * MiB, WS_SPL = 208 * MiB;
constexpr size_t WS_X1 = 212 * MiB, WS_X2 = 244 * MiB, WS_XB = WS_X2;
constexpr size_t WS_R = 276 * MiB;
constexpr size_t WS_U0 = WS_R, WS_CAT0 = WS_R + 48 * MiB, WS_YPRE0 = WS_R + 80 * MiB;
constexpr size_t WS_GY = WS_R, WS_XR = WS_R + 32 * MiB, WS_XC = WS_R + 64 * MiB, WS_BV = WS_R + 96 * MiB, WS_YPRE1 = WS_R + 64 * MiB;
constexpr size_t WS_H = WS_R, WS_Y = WS_R + 72 * MiB;
constexpr size_t WS_LIST = 420 * MiB, WS_TOKSLOT = 421 * MiB, WS_TOKGATE = WS_TOKSLOT + 256 * 1024, WS_AGG = 422 * MiB, WS_X1Q = 424 * MiB  , WS_FAST_END = 440 * MiB;
#ifndef MOE_FP8
#define MOE_FP8 1
#endif
#ifndef INP_FP8_L0
#define INP_FP8_L0 0
#endif
#ifndef INP_FP8_L1
#define INP_FP8_L1 1
#endif
#define INP_FP8 (INP_FP8_L0 || INP_FP8_L1)
constexpr int SCL_WIN = 6;
constexpr size_t WS_XQ = WS_X1Q;
constexpr int SCL_W13 = 6, SCL_W2 = 6;
static_assert(SCL_W13 % 2 == 0 && SCL_W2 % 2 == 0, "even scales");
constexpr int NPAD_ROWS = 2 * T + NE * 256;
static_assert(WS_H + (size_t)NPAD_ROWS * DEXP * 2 <= WS_Y && WS_Y + (size_t)NPAD_ROWS * D * 2 <= WS_LIST, "H / Y fit");
constexpr int CW_TMO = 0, CW_CODE = 1, CW_GCOUNT = 256  , CW_BAR = 4096;
constexpr int RING_BYTES = 131072, LDSCTL_OFF = RING_BYTES, MISC_OFF = LDSCTL_OFF + 320, UNITS_OFF = LDSCTL_OFF + 512, MOEMETA_OFF = LDSCTL_OFF + 768, GTAB_OFF = LDSCTL_OFF + 1024, MAX_UNITS = 8;
constexpr int LDS_BYTES = 147456;
static_assert(GTAB_OFF + MAX_UNITS * 1024 <= LDS_BYTES, "LDS map");
constexpr int NWAVES = 8, NTHREADS = 512;

#define XB_TMO      128
#define XB_XCNT(j)  (256  + 64 * (j))
#define XB_XSUB(j)  (1280 + 64 * (j))
#define XB_XGEN(j)  (2304 + 64 * (j))
#define XB_TOP      3328
#define XB_TOPGEN   3392
#define XCD_BAR_WORDS 3456
#define XB_SPIN_CAP (1u << 18)
__device__ __forceinline__ unsigned xb_ld(unsigned* p)              { return __hip_atomic_load(p, __ATOMIC_RELAXED, __HIP_MEMORY_SCOPE_AGENT); }
__device__ __forceinline__ unsigned xb_add(unsigned* p, unsigned v) { return __hip_atomic_fetch_add(p, v, __ATOMIC_RELAXED, __HIP_MEMORY_SCOPE_AGENT); }
__device__ __forceinline__ unsigned xb_xcc_id() { return (unsigned)__builtin_amdgcn_s_getreg((3 << 11) | 20) & 0xFu; }
#define XB_SPIN(cond, bar) do { unsigned _sp = 0; while (cond) { __builtin_amdgcn_s_sleep(1); \
    if ((++_sp & 255u) == 0u) { if (xb_ld(&(bar)[XB_TMO])) break; if (_sp > XB_SPIN_CAP) { atomicAdd(&(bar)[XB_TMO], 1u); break; } } } } while (0)
struct XcdBarrier { unsigned* bar; unsigned x; volatile LAS unsigned* st; int wave; };
__device__ __forceinline__ XcdBarrier xcd_barrier_post(unsigned* bar, volatile LAS unsigned* st, int wave) {
    XcdBarrier b; b.bar = bar; b.x = xb_xcc_id(); b.st = st; b.wave = wave;
    if (wave == 0 && lane_id_asm() == 0) (void)xb_add(&bar[XB_XCNT(b.x)], 1u);
    return b;
}
__device__ __forceinline__ void xcd_barrier_complete(unsigned* bar, unsigned x, unsigned& nloc, unsigned& nx) {
    const unsigned G = gridDim.x * gridDim.y * gridDim.z;
    unsigned sum, cnt, mine, sp = 0u;
    for (;;) {
        sum = 0u; cnt = 0u; mine = 0u;
#pragma unroll
        for (unsigned j = 0; j < 16; ++j) { const unsigned c = xb_ld(&bar[XB_XCNT(j)]); sum += c; cnt += (c > 0u) ? 1u : 0u; mine = (j == x) ? c : mine; }
        if (sum == G) break;
        __builtin_amdgcn_s_sleep(1);
        if ((++sp & 255u) == 0u) { if (xb_ld(&bar[XB_TMO])) break; if (sp > XB_SPIN_CAP) { atomicAdd(&bar[XB_TMO], 1u); break; } }
    }
    nloc = mine > 0u ? mine : 1u; nx = cnt > 0u ? cnt : 1u;
}
__device__ __forceinline__ void xcd_barrier(const XcdBarrier& b) {
    asm volatile("s_waitcnt vmcnt(0)" ::: "memory");
    __syncthreads();
    if (b.wave == 0 && lane_id_asm() == 0) {
        unsigned* bar = b.bar;
        __builtin_amdgcn_s_waitcnt(0);
        unsigned nloc = b.st[0], nx = b.st[1];
        if (nloc == 0u) { xcd_barrier_complete(bar, b.x, nloc, nx); b.st[0] = nloc; b.st[1] = nx; }
        const unsigned old = xb_add(&bar[XB_XSUB(b.x)], 1u);
        const unsigned gen = old / nloc;
        if (old + 1u == (gen + 1u) * nloc) {
            __builtin_amdgcn_fence(__ATOMIC_RELEASE, "agent");
            asm volatile("s_waitcnt vmcnt(0)" ::: "memory");
            const unsigned og = xb_add(&bar[XB_TOP], 1u);
            const unsigned tg = og / nx;
            if (og + 1u == (tg + 1u) * nx) xb_add(&bar[XB_TOPGEN], 1u);
            else XB_SPIN(xb_ld(&bar[XB_TOPGEN]) == tg, bar);
            __builtin_amdgcn_fence(__ATOMIC_ACQUIRE, "agent");
            xb_add(&bar[XB_XGEN(b.x)], 1u);
            asm volatile("s_waitcnt vmcnt(0)" ::: "memory");
        } else {
            XB_SPIN(xb_ld(&bar[XB_XGEN(b.x)]) == gen, bar);
            __builtin_amdgcn_fence(__ATOMIC_ACQUIRE, "agent");
            asm volatile("s_waitcnt vmcnt(0)" ::: "memory");
        }
    }
    __syncthreads();
}

struct Args { const float* in[26]; float* out; unsigned char* ws; int ph_lo, ph_hi; };
struct Frame {
    LAS unsigned char* lds; unsigned char* ws; const float* const* in; float* out;
    int tid, lane, wave, vcu, G;
    template <class Tp> __device__ __forceinline__ Tp* W(size_t off) const { return (Tp*)(ws + off); }
    __device__ __forceinline__ const float* I(int i) const { return in[i]; }
    __device__ __forceinline__ unsigned* ctl() const { return (unsigned*)(ws + WS_CTL); }
    __device__ __forceinline__ void retid() { lane = lane_id_asm(); tid = wave * 64 + lane; }
};

__device__ __forceinline__ void cvt_item(const float* src, int ldsrc, int k0, int c0, bf16_t* dst, int lddst, int drow0, LAS unsigned* scr, int lane) {
    const int cg = lane & 15, rp = lane >> 4;
    const float* sp = src + (size_t)k0 * ldsrc + c0 + 4 * cg;
    f32x4 v[16];
#pragma unroll
    for (int j = 0; j < 8; ++j) { const int r = 2 * (rp + 4 * j); v[2 * j] = *(const f32x4*)(sp + (size_t)r * ldsrc); v[2 * j + 1] = *(const f32x4*)(sp + (size_t)(r + 1) * ldsrc); }
#pragma unroll
    for (int j = 0; j < 8; ++j) { const int kd = rp + 4 * j;
#pragma unroll
        for (int i = 0; i < 4; ++i) scr[(4 * cg + i) * 33 + kd] = cvt_pk_bf16(v[2 * j][i], v[2 * j + 1][i]); }
    LDS_WAIT();
    const int kc = lane & 7;
#pragma unroll
    for (int jj = 0; jj < 8; ++jj) { const int n = (lane >> 3) + 8 * jj; const LAS unsigned* s = scr + n * 33 + 4 * kc;
        u32x4 o; o.x = s[0]; o.y = s[1]; o.z = s[2]; o.w = s[3];
        *(u32x4*)(dst + (size_t)(drow0 + n) * lddst + k0 + 8 * kc) = o; }
    LDS_WAIT();
}
__device__ __forceinline__ void cvt_item8(const float* src, int ldsrc, int k0, int c0, unsigned char* dst, int lddst, int drow0, float scale, LAS unsigned* scr, int lane) {
    const int cg = lane & 15, rp = lane >> 4;
    const float* sp = src + (size_t)k0 * ldsrc + c0 + 4 * cg;
    f32x4 v[16];
#pragma unroll
    for (int j = 0; j < 4; ++j)
#pragma unroll
        for (int q = 0; q < 4; ++q) v[4 * j + q] = *(const f32x4*)(sp + (size_t)(4 * (rp + 4 * j) + q) * ldsrc);
#pragma unroll
    for (int j = 0; j < 4; ++j) { const int kq = rp + 4 * j;
#pragma unroll
        for (int i = 0; i < 4; ++i) scr[(4 * cg + i) * 17 + kq] = pack4_fp8(v[4 * j][i] * scale, v[4 * j + 1][i] * scale, v[4 * j + 2][i] * scale, v[4 * j + 3][i] * scale); }
    LDS_WAIT();
    const int c4 = lane & 3;
#pragma unroll
    for (int jj = 0; jj < 4; ++jj) { const int n = (lane >> 2) + 16 * jj; const LAS unsigned* s = scr + n * 17 + 4 * c4;
        u32x4 o; o.x = s[0]; o.y = s[1]; o.z = s[2]; o.w = s[3];
        *(u32x4*)(dst + (size_t)(drow0 + n) * lddst + k0 + 16 * c4) = o; }
    LDS_WAIT();
}
__device__ __forceinline__ void p0_prologue(Frame& F) {
    F.retid();
    LAS unsigned* scr = (LAS unsigned*)(F.lds + F.wave * 8448);
    const int gw = F.vcu * NWAVES + F.wave, NGW = F.G * NWAVES;
    constexpr int I_IN0 = 16 * 40, I_OUT0 = 16 * 16, I_IN1 = 16 * 32, I_GT = 4 * 4 * 8, I_OUT1 = 16 * 16, I_W13 = 32 * 16 * 32, I_W2 = 32 * 16 * 16;
    constexpr int NITEMS = I_IN0 + I_OUT0 + I_IN1 + I_GT + I_OUT1 + I_W13 + I_W2;
    for (int it = gw; it < NITEMS; it += NGW) {
        int r = it; const float* src; int ldsrc, k0, sc, lddst, drow0; unsigned char* dst; bool q8 = false; float scale = 1.f;
        if (r < I_IN0) { const int kb = r / 40, db = r % 40, p = db >> 2, q = db & 3;
            if (p < 4) sc = (q < 2) ? 128 * p + 64 * q : 512 + 128 * p + 64 * (q - 2);
            else if (p < 8) sc = (q < 2) ? 1536 + 128 * (p - 4) + 64 * q : 2048 + 128 * (p - 4) + 64 * (q - 2);
            else sc = 1024 + 256 * (p - 8) + 64 * q;
            src = F.I(5); ldsrc = DIN0; k0 = 64 * kb; dst = F.W<unsigned char>(WS_WIN0); lddst = D; drow0 = 64 * db; q8 = INP_FP8_L0; scale = (float)(1 << SCL_WIN); }
        else if ((r -= I_IN0) < I_OUT0) { const int kb = r / 16, db = r % 16; src = F.I(11); ldsrc = D; k0 = 64 * kb; sc = 64 * db; dst = F.W<unsigned char>(WS_WOUT0); lddst = D; drow0 = 64 * db; }
        else if ((r -= I_OUT0) < I_IN1) { const int kb = r / 32, db = r % 32; src = F.I(12); ldsrc = 2 * DRNN; k0 = 64 * kb; sc = 64 * db; dst = F.W<unsigned char>(WS_WIN1); lddst = D; drow0 = 64 * db; q8 = INP_FP8_L1; scale = (float)(1 << SCL_WIN); }
        else if ((r -= I_IN1) < I_GT) { const int h = r / 32, r2 = r % 32, kb = r2 / 8, db = r2 % 8, p = db >> 2, q = db & 3;
            src = (q < 2 ? F.I(15) : F.I(17)) + (size_t)h * RBLK * RBLK; ldsrc = RBLK; k0 = 64 * kb; sc = 128 * p + 64 * (q & 1); dst = F.W<unsigned char>(WS_WGT) + (size_t)h * 512 * RBLK * 2; lddst = RBLK; drow0 = 64 * db; }
        else if ((r -= I_GT) < I_OUT1) { const int kb = r / 16, db = r % 16; src = F.I(20); ldsrc = D; k0 = 64 * kb; sc = 64 * db; dst = F.W<unsigned char>(WS_WOUT1); lddst = DRNN; drow0 = 64 * db; }
        else if ((r -= I_OUT1) < I_W13) { const int le = r / 512, r2 = r % 512, kb = r2 / 32, db = r2 % 32, p = db >> 2, q = db & 3;
            src = (q < 2 ? F.I(23) : F.I(24)) + (size_t)le * D * DEXP; ldsrc = DEXP; k0 = 64 * kb; sc = 128 * p + 64 * (q & 1); lddst = D; drow0 = 64 * db;
            q8 = MOE_FP8; scale = (float)(1 << SCL_W13); dst = F.W<unsigned char>(WS_W13) + (size_t)le * 2 * DEXP * D * (MOE_FP8 ? 1 : 2); }
        else { r -= I_W13; const int le = r / 256, r2 = r % 256, kb = r2 / 16, db = r2 % 16;
            src = F.I(25) + (size_t)le * DEXP * D; ldsrc = D; k0 = 64 * kb; sc = 64 * db; lddst = DEXP; drow0 = 64 * db;
            q8 = MOE_FP8; scale = (float)(1 << SCL_W2); dst = F.W<unsigned char>(WS_W2) + (size_t)le * D * DEXP * (MOE_FP8 ? 1 : 2); }
        if (q8) cvt_item8(src, ldsrc, k0, sc, dst, lddst, drow0, scale, scr, F.lane);
        else cvt_item(src, ldsrc, k0, sc, (bf16_t*)dst, lddst, drow0, scr, F.lane);
    }
    { const float* x = F.I(0); bf16_t* xb = F.W<bf16_t>(WS_X2); const size_t n8 = (size_t)T * D / 8, stride = (size_t)F.G * NTHREADS;
      unsigned char* xq = F.W<unsigned char>(WS_XQ); (void)xq;
      for (size_t i = (size_t)F.vcu * NTHREADS + F.tid; i < n8; i += stride) { const f32x4 a = *(const f32x4*)(x + i * 8), b = *(const f32x4*)(x + i * 8 + 4); *(u32x4*)(xb + i * 8) = pg8::pack8(a, b);
#if INP_FP8_L0
          u32x2 q; q.x = pack4_fp8(a[0], a[1], a[2], a[3]); q.y = pack4_fp8(b[0], b[1], b[2], b[3]); *(u32x2*)(xq + i * 8) = q;
#endif
      } }
    { const int i = F.vcu * NTHREADS + F.tid; if (i < DRNN) F.W<float>(WS_SPL)[i] = 8.0f * log1pf(expf(-F.I(19)[i])); }
}

struct DenseOrder {
    const char* A; const char* B; size_t a_tile, b_tile; int nM, nN, G, c;
    __device__ __forceinline__ bool next(int i, pg8::Unit& u) const { int pm, pn; if (!pg8::tile_of(i, G, c, nM, nN, pm, pn)) return false;
        u.A = A + (size_t)pm * a_tile; u.B = B + (size_t)pn * b_tile; u.row0 = pm * 256; u.pn = pn; u.e = 0; u.gtab = 0; return true; }
};
struct GatesOrder {
    const char* XC; const char* WG; int G, c;
    __device__ __forceinline__ bool next(int i, pg8::Unit& u) const { int pm, pn; if (!pg8::tile_of(i, G, c, T / 256, 2 * RHEADS, pm, pn)) return false;
        u.A = XC + (size_t)pm * 256 * DRNN * 2 + (size_t)(pn >> 1) * RBLK * 2; u.B = WG + (size_t)pn * 256 * RBLK * 2; u.row0 = pm * 256; u.pn = pn; u.e = 0; u.gtab = 0; return true; }
};
struct MoeOrder { LAS const int* units; int nu; const char* A; const char* B; size_t b_exp, b_tile, a_tile; bool gather;
    __device__ __forceinline__ bool next(int i, pg8::Unit& u) const { if (i >= nu) return false;
        const int e = __builtin_amdgcn_readfirstlane(units[4 * i]), pm = __builtin_amdgcn_readfirstlane(units[4 * i + 1]), pn = __builtin_amdgcn_readfirstlane(units[4 * i + 2]);
        u.A = gather ? A : A + (size_t)pm * a_tile; u.B = B + (size_t)e * b_exp + (size_t)pn * b_tile; u.row0 = pm * 256; u.pn = pn; u.e = e; u.gtab = GTAB_OFF + i * 1024; return true; }
};
__device__ __forceinline__ int moe_setup(Frame& F, int layer, int nN, bool gather, unsigned rowbytes) {
    F.retid();
    LAS int* meta = (LAS int*)(F.lds + MOEMETA_OFF); LAS int* units = (LAS int*)(F.lds + UNITS_OFF); LAS unsigned* gtab = (LAS unsigned*)(F.lds + GTAB_OFF);
    const unsigned* gcount = F.ctl() + CW_GCOUNT + 32 * layer;
    if (F.tid < NE) meta[17 + F.tid] = (int)__hip_atomic_load(gcount + F.tid, RLX_AGENT);
    __syncthreads();
    if (F.tid == 0) { int acc = 0; for (int e = 0; e < NE; ++e) { meta[e] = acc; acc += (meta[17 + e] + 255) >> 8; } meta[NE] = acc; }
    __syncthreads();
    const int nM = meta[NE]; int nu = 0;
    for (int i = 0; i < MAX_UNITS; ++i) { int pm, pn; if (!pg8::tile_of(i, F.G, (int)blockIdx.x, nM, nN, pm, pn)) break;
        int e = 0;
#pragma unroll
        for (int j = 1; j < NE; ++j) e += (meta[j] <= pm) ? 1 : 0;
        if (F.tid == 0) { units[4 * i] = e; units[4 * i + 1] = pm; units[4 * i + 2] = pn; units[4 * i + 3] = 0; }
        if (gather && F.tid < 256) { const int idx = (pm - meta[e]) * 256 + F.tid; const int cnt = meta[17 + e];
            const int tok = idx < cnt ? F.W<int>(WS_LIST)[e * T + idx] : 0; gtab[i * 256 + F.tid] = (unsigned)tok * rowbytes; }
        nu = i + 1; }
    __syncthreads();
    return nu;
}

__device__ __forceinline__ void p_mix0(Frame& F) {
    F.retid();
    LAS float* wA = (LAS float*)F.lds;
    LAS float* wB = wA + CONVA * DA;
    LAS float* pb = wB + CONVB * DB;
    for (int i = F.tid; i < CONVA * DA; i += NTHREADS) wA[i] = F.I(6)[i];
    for (int i = F.tid; i < CONVB * DB; i += NTHREADS) wB[i] = F.I(10)[i];
    for (int i = F.tid; i < DA; i += NTHREADS) { pb[i] = F.I(7)[i]; pb[DA + i] = F.I(8)[i]; pb[2 * DA + i] = F.I(9)[i]; }
    __syncthreads();
    const bf16_t* U0 = F.W<bf16_t>(WS_U0); bf16_t* CAT = F.W<bf16_t>(WS_CAT0);
    const int c0 = 8 * F.lane;
#pragma unroll 1
    for (int tb = F.vcu * NWAVES + F.wave; tb < T / 8; tb += F.G * NWAVES) {
        const int t0 = tb * 8, s0 = t0 & (SEQ - 1);
        float acc[8][8];
        { const f32x4 b0 = *(const LAS f32x4*)(pb + c0), b1 = *(const LAS f32x4*)(pb + c0 + 4);
#pragma unroll
          for (int r = 0; r < 8; ++r) { acc[r][0] = b0[0]; acc[r][1] = b0[1]; acc[r][2] = b0[2]; acc[r][3] = b0[3]; acc[r][4] = b1[0]; acc[r][5] = b1[1]; acc[r][6] = b1[2]; acc[r][7] = b1[3]; } }
#pragma unroll
        for (int jb = 0; jb < 5; ++jb) {
            u32x4 in[8];
#pragma unroll
            for (int jj = 0; jj < 8; ++jj) { const int j = jb * 8 + jj; const int d = 30 - j;
                const bool ok = (j < 38) && (s0 - d >= 0); const size_t rr = ok ? (size_t)(t0 - d) : (size_t)t0;
                in[jj] = *(const u32x4*)(U0 + rr * 1536 + c0); if (!ok) in[jj] = (u32x4){0u, 0u, 0u, 0u}; }
#pragma unroll
            for (int jj = 0; jj < 8; ++jj) { const int j = jb * 8 + jj;
                const float x0 = bf_lo(in[jj].x), x1 = bf_hi(in[jj].x), x2 = bf_lo(in[jj].y), x3 = bf_hi(in[jj].y), x4 = bf_lo(in[jj].z), x5 = bf_hi(in[jj].z), x6 = bf_lo(in[jj].w), x7 = bf_hi(in[jj].w);
#pragma unroll
                for (int r = 0; r < 8; ++r) { const int k = j - r; if (k < 0 || k >= CONVA) continue;
                    const f32x4 w0 = *(const LAS f32x4*)(wA + k * DA + c0), w1 = *(const LAS f32x4*)(wA + k * DA + c0 + 4);
                    acc[r][0] += w0[0] * x0; acc[r][1] += w0[1] * x1; acc[r][2] += w0[2] * x2; acc[r][3] += w0[3] * x3;
                    acc[r][4] += w1[0] * x4; acc[r][5] += w1[1] * x5; acc[r][6] += w1[2] * x6; acc[r][7] += w1[3] * x7; } }
        }
        float mean[8], rstd[8];
#pragma unroll
        for (int r = 0; r < 8; ++r) { float sm = 0.f;
#pragma unroll
            for (int j = 0; j < 8; ++j) sm += acc[r][j];
            mean[r] = sm; }
#pragma unroll
        for (int r = 0; r < 8; ++r) mean[r] = wave_sum(mean[r]) * (1.0f / DA);
#pragma unroll
        for (int r = 0; r < 8; ++r) { float q = 0.f;
#pragma unroll
            for (int j = 0; j < 8; ++j) { acc[r][j] -= mean[r]; q += acc[r][j] * acc[r][j]; }
            rstd[r] = q; }
#pragma unroll
        for (int r = 0; r < 8; ++r) rstd[r] = 1.0f / sqrtf(wave_sum(rstd[r]) * (1.0f / DA) + LN_EPS);
        { const f32x4 g0 = *(const LAS f32x4*)(pb + DA + c0), g1 = *(const LAS f32x4*)(pb + DA + c0 + 4), e0 = *(const LAS f32x4*)(pb + 2 * DA + c0), e1 = *(const LAS f32x4*)(pb + 2 * DA + c0 + 4);
#pragma unroll
          for (int r = 0; r < 8; ++r) { f32x4 o0, o1;
#pragma unroll
              for (int j = 0; j < 4; ++j) { o0[j] = fsilu(acc[r][j] * rstd[r] * g0[j] + e0[j]); o1[j] = fsilu(acc[r][4 + j] * rstd[r] * g1[j] + e1[j]); }
              *(u32x4*)(CAT + (size_t)(t0 + r) * D + c0) = pg8::pack8(o0, o1); } }
        { u32x4 cx[10], bbv[8];
#pragma unroll
          for (int j = 0; j < 10; ++j) { const int d = 2 - j; const bool ok = (s0 - d >= 0); const size_t rr = ok ? (size_t)(t0 - d) : (size_t)t0;
              cx[j] = *(const u32x4*)(U0 + rr * 1536 + 512 + c0); if (!ok) cx[j] = (u32x4){0u, 0u, 0u, 0u}; }
#pragma unroll
          for (int r = 0; r < 8; ++r) bbv[r] = *(const u32x4*)(U0 + (size_t)(t0 + r) * 1536 + 1024 + c0);
          f32x4 wv[3][2];
#pragma unroll
          for (int k = 0; k < 3; ++k) { wv[k][0] = *(const LAS f32x4*)(wB + k * DB + c0); wv[k][1] = *(const LAS f32x4*)(wB + k * DB + c0 + 4); }
#pragma unroll
          for (int r = 0; r < 8; ++r) { f32x4 a0 = {0.f, 0.f, 0.f, 0.f}, a1 = {0.f, 0.f, 0.f, 0.f};
#pragma unroll
              for (int k = 0; k < 3; ++k) { const u32x4 w = cx[r + k];
                  a0 += wv[k][0] * (f32x4){bf_lo(w.x), bf_hi(w.x), bf_lo(w.y), bf_hi(w.y)}; a1 += wv[k][1] * (f32x4){bf_lo(w.z), bf_hi(w.z), bf_lo(w.w), bf_hi(w.w)}; }
              const u32x4 bw = bbv[r];
              const f32x4 p0 = a0 * (f32x4){bf_lo(bw.x), bf_hi(bw.x), bf_lo(bw.y), bf_hi(bw.y)}, p1 = a1 * (f32x4){bf_lo(bw.z), bf_hi(bw.z), bf_lo(bw.w), bf_hi(bw.w)};
              *(u32x4*)(CAT + (size_t)(t0 + r) * D + 512 + c0) = pg8::pack8(p0, p1); } }
    }
    __syncthreads();
}

__device__ __forceinline__ void route16(const float (&l)[NE], int& e1, int& e2, float& g1, float& g2) {
    float mx = l[0];
#pragma unroll
    for (int e = 1; e < NE; ++e) mx = fmaxf(mx, l[e]);
    float p[NE];
#pragma unroll
    for (int e = 0; e < NE; ++e) p[e] = __expf(l[e] - mx);
    int gsel = 0; float best = -1.f, bq0 = 0.f, bq1 = 0.f, bq2 = 0.f, bq3 = 0.f;
#pragma unroll
    for (int g = 0; g < NG; ++g) { float m1 = -1.f, m2 = -1.f;
#pragma unroll
        for (int j = 0; j < EPG; ++j) { const float v = p[g * EPG + j]; if (v > m1) { m2 = m1; m1 = v; } else if (v > m2) m2 = v; }
        const float sc = m1 + m2; if (sc > best) { best = sc; gsel = g; bq0 = p[g * EPG]; bq1 = p[g * EPG + 1]; bq2 = p[g * EPG + 2]; bq3 = p[g * EPG + 3]; } }
    int i1 = 0; float p1 = bq0;
    if (bq1 > p1) { p1 = bq1; i1 = 1; } if (bq2 > p1) { p1 = bq2; i1 = 2; } if (bq3 > p1) { p1 = bq3; i1 = 3; }
    int i2 = -1; float p2 = -1.f;
    if (i1 != 0 && bq0 > p2) { p2 = bq0; i2 = 0; } if (i1 != 1 && bq1 > p2) { p2 = bq1; i2 = 1; } if (i1 != 2 && bq2 > p2) { p2 = bq2; i2 = 2; } if (i1 != 3 && bq3 > p2) { p2 = bq3; i2 = 3; }
    e1 = gsel * EPG + i1; e2 = gsel * EPG + i2; const float inv = 1.0f / (p1 + p2); g1 = p1 * inv; g2 = p2 * inv;
}
#ifndef P4_VAR
#define P4_VAR 0
#endif
__device__ __forceinline__ void p_ln1_route(Frame& F, int layer, const bf16_t* YPRE, bool dummy = false) {
    const int var = dummy ? P4_VAR : 0;
    F.retid();
    LAS float* wrT = (LAS float*)F.lds;
    LAS int* rt = (LAS int*)(F.lds + 65536);
    LAS int* re = rt; LAS int* rlp = rt + 128; LAS float* rg = (LAS float*)(rt + 256); LAS int* lcount = rt + 384; LAS int* gbase = rt + 400;
    { const float* wr = F.I(21);
      for (int idx = F.tid; idx < D * NE / 4; idx += NTHREADS) { const f32x4 v = *(const f32x4*)(wr + idx * 4); const int c = idx >> 2, e4 = (idx & 3) * 4;
          wrT[(e4 + 0) * D + c] = v[0]; wrT[(e4 + 1) * D + c] = v[1]; wrT[(e4 + 2) * D + c] = v[2]; wrT[(e4 + 3) * D + c] = v[3]; } }
    const float* g1p = F.I(1) + layer * D; const float* b1p = F.I(2) + layer * D; const float* br = F.I(22);
    bf16_t* X1 = F.W<bf16_t>(WS_X1); unsigned* gcount = F.ctl() + CW_GCOUNT + 32 * layer + (dummy ? 16 : 0);
    int* LIST = F.W<int>(WS_LIST); int* TOKSLOT = F.W<int>(WS_TOKSLOT); float* TOKGATE = F.W<float>(WS_TOKGATE); unsigned char* X1Q = F.W<unsigned char>(WS_X1Q); (void)X1Q;
    const int lane = F.lane;
    for (int tb = F.vcu; tb < T / 64; tb += F.G) {
        if (F.tid < NE) lcount[F.tid] = 0;
        __syncthreads();
        const int tok0 = tb * 64;
        const float brl = br[lane & 15];
#pragma unroll 1
        for (int grp = 0; grp < 2; ++grp) {
            const int rl0 = F.wave * 8 + grp * 4;
            f32x4 x[4][4]; float st[4];
#pragma unroll
            for (int r = 0; r < 4; ++r) { const bf16_t* yr = YPRE + (size_t)(tok0 + rl0 + r) * D + 4 * lane;
#pragma unroll
                for (int j = 0; j < 4; ++j) { const u32x2 w = *(const u32x2*)(yr + 256 * j); x[r][j] = (f32x4){bf_lo(w.x), bf_hi(w.x), bf_lo(w.y), bf_hi(w.y)}; } }
#pragma unroll
            for (int r = 0; r < 4; ++r) { float s_ = 0.f;
#pragma unroll
                for (int j = 0; j < 4; ++j) s_ += (x[r][j][0] + x[r][j][1]) + (x[r][j][2] + x[r][j][3]);
                st[r] = s_; }
#pragma unroll
            for (int r = 0; r < 4; ++r) st[r] = wave_sum(st[r]) * (1.0f / D);
#pragma unroll
            for (int r = 0; r < 4; ++r) { float q = 0.f;
#pragma unroll
                for (int j = 0; j < 4; ++j) { x[r][j] = x[r][j] - st[r]; q += (x[r][j][0] * x[r][j][0] + x[r][j][1] * x[r][j][1]) + (x[r][j][2] * x[r][j][2] + x[r][j][3] * x[r][j][3]); }
                st[r] = q; }
#pragma unroll
            for (int r = 0; r < 4; ++r) st[r] = 1.0f / sqrtf(wave_sum(st[r]) * (1.0f / D) + LN_EPS);
#pragma unroll
            for (int j = 0; j < 4; ++j) { const f32x4 gg = *(const f32x4*)(g1p + 256 * j + 4 * lane), bb = *(const f32x4*)(b1p + 256 * j + 4 * lane);
#pragma unroll
                for (int r = 0; r < 4; ++r) { x[r][j] = x[r][j] * st[r] * gg + bb;
                    u32x2 w; w.x = cvt_pk_bf16(x[r][j][0], x[r][j][1]); w.y = cvt_pk_bf16(x[r][j][2], x[r][j][3]);
                    *(u32x2*)(X1 + (size_t)(tok0 + rl0 + r) * D + 256 * j + 4 * lane) = w;
#if MOE_FP8
                    *(unsigned*)(X1Q + (size_t)(tok0 + rl0 + r) * D + 256 * j + 4 * lane) = pack4_fp8(x[r][j][0], x[r][j][1], x[r][j][2], x[r][j][3]);
#endif
                } }
            if (var == 1) { asm volatile("" :: "v"(x[0][0][0])); continue; }
            int zoff = 0; asm volatile("" : "+v"(zoff));
            const LAS float* wl = wrT + zoff + 4 * lane;
            float pr[4];
            {
                float lg[4][NE];
#pragma unroll
                for (int e = 0; e < NE; ++e) {
#pragma unroll
                    for (int r = 0; r < 4; ++r) lg[r][e] = 0.f;
#pragma unroll
                    for (int j = 0; j < 4; ++j) { const f32x4 w = *(const LAS f32x4*)(wl + e * D + 256 * j);
#pragma unroll
                        for (int r = 0; r < 4; ++r) lg[r][e] += (x[r][j][0] * w[0] + x[r][j][1] * w[1]) + (x[r][j][2] * w[2] + x[r][j][3] * w[3]); } }
                if (var == 2) {
#pragma unroll
                    for (int e = 0; e < NE; ++e) asm volatile("" :: "v"(lg[0][e]), "v"(lg[1][e]), "v"(lg[2][e]), "v"(lg[3][e]));
                    continue; }
#pragma unroll
                for (int r = 0; r < 4; ++r) { float a8[8], a4[4], a2[2];
#pragma unroll
                    for (int i = 0; i < 8; ++i) { const bool hi = lane & 1; const float send = hi ? lg[r][2 * i] : lg[r][2 * i + 1], keep = hi ? lg[r][2 * i + 1] : lg[r][2 * i]; a8[i] = keep + dpp_xor1(send); }
#pragma unroll
                    for (int i = 0; i < 4; ++i) { const bool hi = lane & 2; const float send = hi ? a8[2 * i] : a8[2 * i + 1], keep = hi ? a8[2 * i + 1] : a8[2 * i]; a4[i] = keep + dpp_xor2(send); }
#pragma unroll
                    for (int i = 0; i < 2; ++i) { const bool hi = lane & 4; const float send = hi ? a4[2 * i] : a4[2 * i + 1], keep = hi ? a4[2 * i + 1] : a4[2 * i]; a2[i] = keep + swz_xor<4>(send); }
                    { const bool hi = lane & 8; const float send = hi ? a2[0] : a2[1], keep = hi ? a2[1] : a2[0]; pr[r] = keep + swz_xor<8>(send); } }
            }
            float L;
            { const bool h16 = lane & 16, h32 = lane & 32;
              const float k0 = h16 ? pr[1] : pr[0], s0_ = h16 ? pr[0] : pr[1], k1 = h16 ? pr[3] : pr[2], s1_ = h16 ? pr[2] : pr[3];
              const float u0 = k0 + swz_xor<16>(s0_), u1 = k1 + swz_xor<16>(s1_);
              const float kk = h32 ? u1 : u0, ss = h32 ? u0 : u1;
              L = kk + __int_as_float(__builtin_amdgcn_ds_bpermute((lane ^ 32) << 2, __float_as_int(ss))) + brl; }
            float mx = L; mx = fmaxf(mx, dpp_xor1(mx)); mx = fmaxf(mx, dpp_xor2(mx)); mx = fmaxf(mx, swz_xor<4>(mx)); mx = fmaxf(mx, swz_xor<8>(mx));
            const float p = __expf(L - mx);
            const float q0 = __int_as_float(__builtin_amdgcn_mov_dpp(__float_as_int(p), 0x00, 0xF, 0xF, true)), q1 = __int_as_float(__builtin_amdgcn_mov_dpp(__float_as_int(p), 0x55, 0xF, 0xF, true)),
                        q2 = __int_as_float(__builtin_amdgcn_mov_dpp(__float_as_int(p), 0xAA, 0xF, 0xF, true)), q3 = __int_as_float(__builtin_amdgcn_mov_dpp(__float_as_int(p), 0xFF, 0xF, 0xF, true));
            int i1 = 0; float p1 = q0;
            if (q1 > p1) { p1 = q1; i1 = 1; } if (q2 > p1) { p1 = q2; i1 = 2; } if (q3 > p1) { p1 = q3; i1 = 3; }
            int i2 = -1; float p2 = -1.f;
            if (i1 != 0 && q0 > p2) { p2 = q0; i2 = 0; } if (i1 != 1 && q1 > p2) { p2 = q1; i2 = 1; } if (i1 != 2 && q2 > p2) { p2 = q2; i2 = 2; } if (i1 != 3 && q3 > p2) { p2 = q3; i2 = 3; }
            const int g = (lane >> 2) & 3;
            float bs_ = p1 + p2; int bg = g;
            { const float os = swz_xor<4>(bs_); const int og = __builtin_amdgcn_ds_swizzle(bg, (4 << 10) | 0x1F); if (os > bs_ || (os == bs_ && og < bg)) { bs_ = os; bg = og; } }
            { const float os = swz_xor<8>(bs_); const int og = __builtin_amdgcn_ds_swizzle(bg, (8 << 10) | 0x1F); if (os > bs_ || (os == bs_ && og < bg)) { bs_ = os; bg = og; } }
            if (var == 3) { asm volatile("" :: "v"(bg), "v"(i1), "v"(i2), "v"(p1), "v"(p2)); continue; }
            if (g == bg && (lane & 3) == 0) {
                const int rl = rl0 + (lane >> 4), e1 = 4 * g + i1, e2 = 4 * g + i2; const float inv = 1.0f / (p1 + p2);
                const int lp1 = __hip_atomic_fetch_add(lcount + e1, 1, __ATOMIC_RELAXED, __HIP_MEMORY_SCOPE_WORKGROUP), lp2 = __hip_atomic_fetch_add(lcount + e2, 1, __ATOMIC_RELAXED, __HIP_MEMORY_SCOPE_WORKGROUP);
                re[2 * rl] = e1; re[2 * rl + 1] = e2; rlp[2 * rl] = lp1; rlp[2 * rl + 1] = lp2; rg[2 * rl] = p1 * inv; rg[2 * rl + 1] = p2 * inv; }
        }
        __syncthreads();
        if (var != 0) continue;
        if (F.tid < NE) gbase[F.tid] = (int)__hip_atomic_fetch_add(gcount + F.tid, (unsigned)lcount[F.tid], RLX_AGENT);
        __syncthreads();
        if (F.tid < 128) { const int e = re[F.tid], pos = gbase[e] + rlp[F.tid], tok = tok0 + (F.tid >> 1);
            LIST[e * T + pos] = tok; TOKSLOT[tok * 2 + (F.tid & 1)] = e * T + pos; TOKGATE[tok * 2 + (F.tid & 1)] = rg[F.tid]; }
        __syncthreads();
    }
}

__device__ __forceinline__ void p_combine(Frame& F, int layer) {
    F.retid();
    const unsigned* gcount = F.ctl() + CW_GCOUNT + 32 * layer;
    const int lane = F.lane;
    int pre = 0;
#pragma unroll
    for (int j = 0; j < NE - 1; ++j) { const int cnt = (int)__builtin_amdgcn_readfirstlane(__hip_atomic_load(gcount + j, RLX_AGENT)); pre += ((lane & 15) > j) ? ((cnt + 255) >> 8) * 256 : 0; }
    const bf16_t* X1 = F.W<bf16_t>(WS_X1); const bf16_t* Y = F.W<bf16_t>(WS_Y); const int* TOKSLOT = F.W<int>(WS_TOKSLOT); const float* TOKGATE = F.W<float>(WS_TOKGATE);
    const float* g2p = F.I(3) + layer * D; const float* b2p = F.I(4) + layer * D;
    bf16_t* X2 = F.W<bf16_t>(WS_X2);
    for (int tb = F.vcu * NWAVES + F.wave; tb < T / 8; tb += F.G * NWAVES) {
#pragma unroll 2
        for (int i = 0; i < 8; ++i) { const int t = tb * 8 + i;
            const int s0 = __builtin_amdgcn_readfirstlane(TOKSLOT[2 * t]), s1 = __builtin_amdgcn_readfirstlane(TOKSLOT[2 * t + 1]);
            const float g0 = TOKGATE[2 * t], g1 = TOKGATE[2 * t + 1];
            const int r0 = __builtin_amdgcn_readlane(pre, s0 >> 14) + (s0 & (T - 1)), r1 = __builtin_amdgcn_readlane(pre, s1 >> 14) + (s1 & (T - 1));
            f32x4 v[4]; float s = 0.f;
#pragma unroll
            for (int j = 0; j < 4; ++j) { const u32x2 xw = *(const u32x2*)(X1 + (size_t)t * D + 256 * j + 4 * lane), y0 = *(const u32x2*)(Y + (size_t)r0 * D + 256 * j + 4 * lane), y1 = *(const u32x2*)(Y + (size_t)r1 * D + 256 * j + 4 * lane);
                v[j][0] = ALPHA * bf_lo(xw.x) + (g0 * bf_lo(y0.x) + g1 * bf_lo(y1.x)); v[j][1] = ALPHA * bf_hi(xw.x) + (g0 * bf_hi(y0.x) + g1 * bf_hi(y1.x));
                v[j][2] = ALPHA * bf_lo(xw.y) + (g0 * bf_lo(y0.y) + g1 * bf_lo(y1.y)); v[j][3] = ALPHA * bf_hi(xw.y) + (g0 * bf_hi(y0.y) + g1 * bf_hi(y1.y));
                s += (v[j][0] + v[j][1]) + (v[j][2] + v[j][3]); }
            const float mean = wave_sum(s) * (1.0f / D); float q = 0.f;
#pragma unroll
            for (int j = 0; j < 4; ++j) { v[j] = v[j] - mean; q += (v[j][0] * v[j][0] + v[j][1] * v[j][1]) + (v[j][2] * v[j][2] + v[j][3] * v[j][3]); }
            const float rstd = 1.0f / sqrtf(wave_sum(q) * (1.0f / D) + LN_EPS);
#pragma unroll
            for (int j = 0; j < 4; ++j) { const f32x4 gg = *(const f32x4*)(g2p + 256 * j + 4 * lane), bb = *(const f32x4*)(b2p + 256 * j + 4 * lane); const f32x4 o = v[j] * rstd * gg + bb;
                if (layer == 0) { u32x2 w; w.x = cvt_pk_bf16(o[0], o[1]); w.y = cvt_pk_bf16(o[2], o[3]); *(u32x2*)(X2 + (size_t)t * D + 256 * j + 4 * lane) = w;
#if INP_FP8_L1
                    *(unsigned*)(F.W<unsigned char>(WS_XQ) + (size_t)t * D + 256 * j + 4 * lane) = pack4_fp8(o[0], o[1], o[2], o[3]);
#endif
                }
                else *(f32x4*)(F.out + (size_t)t * D + 256 * j + 4 * lane) = o; }
        }
    }
}

__device__ __forceinline__ void p_conv4(Frame& F) {
    F.retid();
    const bf16_t* XR = F.W<bf16_t>(WS_XR); bf16_t* XC = F.W<bf16_t>(WS_XC); const float* w = F.I(13); const float* bias = F.I(14);
    const int lane = F.lane;
#pragma unroll 1
    for (int it = F.vcu * NWAVES + F.wave; it < (T / 8) * 2; it += F.G * NWAVES) {
        const int tb = it >> 1, c0 = 8 * lane + 512 * (it & 1), t0 = tb * 8, s0 = t0 & (SEQ - 1);
        f32x4 wk[CONVC][2], bs[2];
#pragma unroll
        for (int k = 0; k < CONVC; ++k) { wk[k][0] = *(const f32x4*)(w + k * DRNN + c0); wk[k][1] = *(const f32x4*)(w + k * DRNN + c0 + 4); }
        bs[0] = *(const f32x4*)(bias + c0); bs[1] = *(const f32x4*)(bias + c0 + 4);
        u32x4 in[11];
#pragma unroll
        for (int j = 0; j < 11; ++j) { const int d = 3 - j; const bool ok = (s0 - d >= 0); const size_t rr = ok ? (size_t)(t0 - d) : (size_t)t0;
            in[j] = *(const u32x4*)(XR + rr * DRNN + c0); if (!ok) in[j] = (u32x4){0u, 0u, 0u, 0u}; }
#pragma unroll
        for (int r = 0; r < 8; ++r) { f32x4 a0 = bs[0], a1 = bs[1];
#pragma unroll
            for (int k = 0; k < CONVC; ++k) { const u32x4 xw = in[r + k];
                a0 += wk[k][0] * (f32x4){bf_lo(xw.x), bf_hi(xw.x), bf_lo(xw.y), bf_hi(xw.y)}; a1 += wk[k][1] * (f32x4){bf_lo(xw.z), bf_hi(xw.z), bf_lo(xw.w), bf_hi(xw.w)}; }
            *(u32x4*)(XC + (size_t)(t0 + r) * DRNN + c0) = pg8::pack8(a0, a1); }
    }
}

constexpr int SCH = 64, NCHUNK = SEQ / SCH;
__device__ __forceinline__ void p_scan1(Frame& F) {
    F.retid();
    const bf16_t* L2A = F.W<bf16_t>(WS_XR); const bf16_t* BV = F.W<bf16_t>(WS_BV); float* AGG = F.W<float>(WS_AGG);
    for (int task = F.vcu * NWAVES + F.wave; task < BATCH * NCHUNK * 8; task += F.G * NWAVES) {
        const int bc = task >> 3, c = (task & 7) * 128 + 2 * F.lane; const size_t base = (size_t)bc * SCH * DRNN + c;
        float sl0 = 0.f, sl1 = 0.f, h0 = 0.f, h1 = 0.f;
#pragma unroll 16
        for (int s = 0; s < SCH; ++s) { const unsigned lw = *(const unsigned*)(L2A + base + (size_t)s * DRNN), bw = *(const unsigned*)(BV + base + (size_t)s * DRNN);
            const float l0 = bf_lo(lw), l1 = bf_hi(lw); sl0 += l0; sl1 += l1;
            h0 = __builtin_amdgcn_exp2f(l0) * h0 + bf_lo(bw); h1 = __builtin_amdgcn_exp2f(l1) * h1 + bf_hi(bw); }
        *(f32x4*)(AGG + ((size_t)bc * DRNN + c) * 2) = (f32x4){sl0, h0, sl1, h1};
    }
}
__device__ __forceinline__ void p_scan2(Frame& F, bool dummy = false) {
    F.retid();
    const bf16_t* L2A = F.W<bf16_t>(WS_XR); const bf16_t* BV = F.W<bf16_t>(WS_BV); const float* AGG = F.W<float>(WS_AGG); bf16_t* GY = F.W<bf16_t>(WS_GY); bf16_t* OUTB = dummy ? F.W<bf16_t>(WS_XC) : GY;
#pragma unroll 1
    for (int task = F.vcu * NWAVES + F.wave; task < BATCH * NCHUNK * 8; task += F.G * NWAVES) {
        const int bc = task >> 3, c = (task & 7) * 128 + 2 * F.lane; const int b = bc / NCHUNK, ch = bc % NCHUNK;
        float h0 = 0.f, h1 = 0.f;
#pragma unroll 1
        for (int j0 = 0; j0 < ch; j0 += 16) { f32x4 g[16];
#pragma unroll
            for (int i = 0; i < 16; ++i) { const int j = j0 + i; const int jc = j < ch ? j : ch - 1; g[i] = *(const f32x4*)(AGG + ((size_t)(b * NCHUNK + jc) * DRNN + c) * 2); if (j >= ch) g[i] = (f32x4){0.f, 0.f, 0.f, 0.f}; }
#pragma unroll
            for (int i = 0; i < 16; ++i) { h0 = __builtin_amdgcn_exp2f(g[i][0]) * h0 + g[i][1]; h1 = __builtin_amdgcn_exp2f(g[i][2]) * h1 + g[i][3]; } }
        const size_t base = (size_t)bc * SCH * DRNN + c;
#pragma unroll 1
        for (int s0 = 0; s0 < SCH; s0 += 16) { unsigned lw[16], bw[16], gw[16];
#pragma unroll
            for (int i = 0; i < 16; ++i) { const size_t o = base + (size_t)(s0 + i) * DRNN; lw[i] = *(const unsigned*)(L2A + o); bw[i] = *(const unsigned*)(BV + o); gw[i] = *(const unsigned*)(GY + o); }
#pragma unroll
            for (int i = 0; i < 16; ++i) { h0 = __builtin_amdgcn_exp2f(bf_lo(lw[i])) * h0 + bf_lo(bw[i]); h1 = __builtin_amdgcn_exp2f(bf_hi(lw[i])) * h1 + bf_hi(bw[i]);
                gw[i] = cvt_pk_bf16(bf_lo(gw[i]) * h0, bf_hi(gw[i]) * h1); }
#pragma unroll
            for (int i = 0; i < 16; ++i) *(unsigned*)(OUTB + base + (size_t)(s0 + i) * DRNN) = gw[i]; }
    }
}

constexpr int NPH = 18;
#ifndef N_LAUNCHES
#define N_LAUNCHES 1
#endif
__global__ void __launch_bounds__(NTHREADS, 2) mega_fwd(Args args) {
    extern __shared__ __attribute__((aligned(16))) unsigned char lds_raw[];
    Frame F;
    F.lds = (LAS unsigned char*)lds_raw; F.ws = args.ws; F.in = args.in; F.out = args.out;
    F.tid = threadIdx.x; F.lane = F.tid & 63; F.wave = __builtin_amdgcn_readfirstlane(F.tid >> 6);
    F.G = gridDim.x; { const int bx = blockIdx.x; F.vcu = (F.G % 8 == 0) ? (bx % 8) * (F.G / 8) + bx / 8 : bx; }
    for (int u = F.tid; u < (LDS_BYTES - LDSCTL_OFF) / 4; u += NTHREADS) ((LAS unsigned*)(F.lds + LDSCTL_OFF))[u] = 0u;
    __syncthreads();
    XcdBarrier bar; bar.bar = F.ctl() + CW_BAR; bar.x = 0; bar.st = nullptr; bar.wave = F.wave;
    if (N_LAUNCHES == 1) bar = xcd_barrier_post(F.ctl() + CW_BAR, (volatile LAS unsigned*)(F.lds + MISC_OFF) + 8, F.wave);
    const int lo = args.ph_lo, hi = args.ph_hi;
#ifndef PH_MASK
#define PH_MASK 0x3ffff
#endif
#define IN(k) (((PH_MASK >> (k)) & 1) && lo <= (k) && (k) < hi)
#define SEAM(k) do { if (IN(k) && IN((k) + 1)) xcd_barrier(bar); } while (0)
    const int cblk = (int)blockIdx.x;

#ifndef REP_MASK
#define REP_MASK 0
#endif
#ifndef EXTRA_BARS
#define EXTRA_BARS 0
#endif
#define REPS(k) ((((REP_MASK) >> ((k) % 32)) & 1) ? 2 : 1)
#define PHASE(k, ...) do { if (IN(k)) { for (int rep_ = 0; rep_ < REPS(k); ++rep_) { __VA_ARGS__; if (rep_ + 1 < REPS(k)) xcd_barrier(bar); } } SEAM(k); } while (0)
    for (int i = 0; i < EXTRA_BARS; ++i) xcd_barrier(bar);
    PHASE(0, p0_prologue(F));
#if INP_FP8_L0
    PHASE(1, { DenseOrder S{F.W<char>(WS_XQ), F.W<char>(WS_WIN0), (size_t)256 * D, (size_t)256 * D, T / 256, DIN0 / 256, F.G, cblk};
        pg8::EpiIn0 E{F.W<bf16_t>(WS_U0)}; pg8::gemm_phase<pg8::EpiIn0, DenseOrder, false, 1>(F.lds, F.wave, D, D, D, S, E, 0x01010101 * (127 - SCL_WIN / 2)); });
#else
    PHASE(1, { DenseOrder S{F.W<char>(WS_XB), F.W<char>(WS_WIN0), (size_t)256 * D * 2, (size_t)256 * D * 2, T / 256, DIN0 / 256, F.G, cblk};
        pg8::EpiIn0 E{F.W<bf16_t>(WS_U0)}; pg8::gemm_phase<pg8::EpiIn0, DenseOrder, false>(F.lds, F.wave, 2 * D, 2 * D, 2 * D, S, E); });
#endif
    PHASE(2, p_mix0(F));
    PHASE(3, { DenseOrder S{F.W<char>(WS_CAT0), F.W<char>(WS_WOUT0), (size_t)256 * D * 2, (size_t)256 * D * 2, T / 256, D / 256, F.G, cblk};
        pg8::EpiRes E{F.W<bf16_t>(WS_XB), F.W<bf16_t>(WS_YPRE0)}; pg8::gemm_phase<pg8::EpiRes, DenseOrder, false>(F.lds, F.wave, 2 * D, 2 * D, 2 * D, S, E); });
    PHASE(4, p_ln1_route(F, 0, F.W<bf16_t>(WS_YPRE0), rep_ + 1 < REPS(4)));
#pragma unroll 1
    for (int layer = 0; layer < 2; ++layer) {
        const int pb = layer == 0 ? 5 : 15;
#if MOE_FP8
        PHASE(pb, { const int nu = moe_setup(F, layer, 2 * DEXP / 256, true, D);
            MoeOrder S{(LAS const int*)(F.lds + UNITS_OFF), nu, F.W<char>(WS_X1Q), F.W<char>(WS_W13) + (size_t)layer * NE * 2 * DEXP * D, (size_t)2 * DEXP * D, (size_t)256 * D, 0, true};
            pg8::EpiMoe1Q E{F.W<unsigned char>(WS_H)}; pg8::gemm_phase<pg8::EpiMoe1Q, MoeOrder, true, 1>(F.lds, F.wave, D, D, D, S, E, 0x01010101 * (127 - SCL_W13 / 2)); });
        PHASE(pb + 1, { const int nu = moe_setup(F, layer, D / 256, false, 0);
            MoeOrder S{(LAS const int*)(F.lds + UNITS_OFF), nu, F.W<char>(WS_H), F.W<char>(WS_W2) + (size_t)layer * NE * D * DEXP, (size_t)D * DEXP, (size_t)256 * DEXP, (size_t)256 * DEXP, false};
            pg8::EpiMoe2 E{F.W<bf16_t>(WS_Y)}; pg8::gemm_phase<pg8::EpiMoe2, MoeOrder, false, 1>(F.lds, F.wave, DEXP, DEXP, DEXP, S, E, 0x01010101 * (127 - SCL_W2 / 2)); });
#else
        PHASE(pb, { const int nu = moe_setup(F, layer, 2 * DEXP / 256, true, 2 * D);
            MoeOrder S{(LAS const int*)(F.lds + UNITS_OFF), nu, F.W<char>(WS_X1), F.W<char>(WS_W13) + (size_t)layer * NE * 2 * DEXP * D * 2, (size_t)2 * DEXP * D * 2, (size_t)256 * D * 2, 0, true};
            pg8::EpiMoe1 E{F.W<bf16_t>(WS_H)}; pg8::gemm_phase<pg8::EpiMoe1, MoeOrder, true>(F.lds, F.wave, 2 * D, 2 * D, 2 * D, S, E); });
        PHASE(pb + 1, { const int nu = moe_setup(F, layer, D / 256, false, 0);
            MoeOrder S{(LAS const int*)(F.lds + UNITS_OFF), nu, F.W<char>(WS_H), F.W<char>(WS_W2) + (size_t)layer * NE * D * DEXP * 2, (size_t)D * DEXP * 2, (size_t)256 * DEXP * 2, (size_t)256 * DEXP * 2, false};
            pg8::EpiMoe2 E{F.W<bf16_t>(WS_Y)}; pg8::gemm_phase<pg8::EpiMoe2, MoeOrder, false>(F.lds, F.wave, 2 * DEXP, 2 * DEXP, 2 * DEXP, S, E); });
#endif
        PHASE(pb + 2, p_combine(F, layer));
        if (layer == 0) {
#if INP_FP8_L1
            PHASE(8, { DenseOrder S{F.W<char>(WS_XQ), F.W<char>(WS_WIN1), (size_t)256 * D, (size_t)256 * D, T / 256, 2 * DRNN / 256, F.G, cblk};
                pg8::EpiIn1 E{F.W<bf16_t>(WS_GY), F.W<bf16_t>(WS_XR)}; pg8::gemm_phase<pg8::EpiIn1, DenseOrder, false, 1>(F.lds, F.wave, D, D, D, S, E, 0x01010101 * (127 - SCL_WIN / 2)); });
#else
            PHASE(8, { DenseOrder S{F.W<char>(WS_X2), F.W<char>(WS_WIN1), (size_t)256 * D * 2, (size_t)256 * D * 2, T / 256, 2 * DRNN / 256, F.G, cblk};
                pg8::EpiIn1 E{F.W<bf16_t>(WS_GY), F.W<bf16_t>(WS_XR)}; pg8::gemm_phase<pg8::EpiIn1, DenseOrder, false>(F.lds, F.wave, 2 * D, 2 * D, 2 * D, S, E); });
#endif
            PHASE(9, p_conv4(F));
            PHASE(10, { GatesOrder S{F.W<char>(WS_XC), F.W<char>(WS_WGT), F.G, cblk};
                pg8::EpiGates E{F.W<bf16_t>(WS_XC), F.I(16), F.I(18), F.W<float>(WS_SPL), F.W<bf16_t>(WS_XR), F.W<bf16_t>(WS_BV)};
                pg8::gemm_phase<pg8::EpiGates, GatesOrder, false>(F.lds, F.wave, 2 * DRNN, 2 * RBLK, 2 * RBLK, S, E); });
            PHASE(11, p_scan1(F));
            PHASE(12, p_scan2(F, rep_ + 1 < REPS(12)));
            PHASE(13, { DenseOrder S{F.W<char>(WS_GY), F.W<char>(WS_WOUT1), (size_t)256 * DRNN * 2, (size_t)256 * DRNN * 2, T / 256, D / 256, F.G, cblk};
                pg8::EpiRes E{F.W<bf16_t>(WS_X2), F.W<bf16_t>(WS_YPRE1)}; pg8::gemm_phase<pg8::EpiRes, DenseOrder, false>(F.lds, F.wave, 2 * DRNN, 2 * DRNN, 2 * DRNN, S, E); });
            PHASE(14, p_ln1_route(F, 1, F.W<bf16_t>(WS_YPRE1), rep_ + 1 < REPS(14)));
        }
    }
#undef PHASE
#undef REPS
#undef IN
#undef SEAM
}

static int g_grid = 0;
static inline bool fast_setup() {
    if (g_grid == 0) {
        int dev = 0, cus = 0, per_cu = 0;
        if (hipGetDevice(&dev) != hipSuccess || hipDeviceGetAttribute(&cus, hipDeviceAttributeMultiprocessorCount, dev) != hipSuccess) { fprintf(stderr, "kernel_launch: device query failed\n"); g_grid = -1; return false; }
        if (hipFuncSetAttribute((const void*)mega_fwd, hipFuncAttributeMaxDynamicSharedMemorySize, LDS_BYTES) != hipSuccess) { fprintf(stderr, "kernel_launch: hipFuncSetAttribute failed\n"); g_grid = -1; return false; }
        if (hipOccupancyMaxActiveBlocksPerMultiprocessor(&per_cu, (const void*)mega_fwd, NTHREADS, LDS_BYTES) != hipSuccess || per_cu < 1) { fprintf(stderr, "kernel_launch: occupancy query says %d blocks per CU\n", per_cu); (void)hipGetLastError(); per_cu = 1; }
        g_grid = cus;
        if (g_grid > 256) g_grid = 256;
    }
    return g_grid > 0;
}
static inline void fast_launch(void* const* d_in, void* d_out, void* d_ws, hipStream_t stream, int lo, int hi) {
    Args a{};
    for (int i = 0; i < 26; ++i) a.in[i] = (const float*)d_in[i];
    a.out = (float*)d_out; a.ws = (unsigned char*)d_ws; a.ph_lo = lo; a.ph_hi = hi;
    hipLaunchKernelGGL(mega_fwd, dim3(g_grid), dim3(NTHREADS), LDS_BYTES, stream, a);
}
extern "C" void kernel_launch(void* const* d_in, const int* in_sizes, int n_in, void* d_out, int out_size, void* d_ws, size_t ws_size, hipStream_t stream) {
    if (n_in != 26 || out_size != T * D || ws_size < WS_FAST_END) { fprintf(stderr, "kernel_launch: unexpected shapes (n_in %d out %d ws %zu)\n", n_in, out_size, ws_size); return; }
    if (!fast_setup()) return;
    if (hipMemsetAsync((char*)d_ws + WS_CTL, 0, CTL_ZERO_BYTES, stream) != hipSuccess) { fprintf(stderr, "kernel_launch: memset failed\n"); return; }
    if (N_LAUNCHES == 1) fast_launch(d_in, d_out, d_ws, stream, 0, NPH);
    else for (int p = 0; p < NPH; ++p) fast_launch(d_in, d_out, d_ws, stream, p, p + 1);
}
```

```cpp
#define BUILD_MODE 1
#define N_LAUNCHES 1
#include <hip/hip_runtime.h>
#include <cstdio>
#include <cstdint>
#include <cmath>
constexpr int D = 1024, BATCH = 2, SEQ = 8192, T = BATCH * SEQ, DEPTH = 2;
constexpr int DA = 512, DB = 512, DIN0 = 2 * DA + 3 * DB, CONVA = 31, CONVB = 3;
constexpr int DRNN = 1024, RBLK = 256, RHEADS = 4, CONVC = 4;
constexpr int NE = 16, NG = 4, EPG = 4, DEXP = 1024;
constexpr float LN_EPS = 1e-5f, ALPHA = 1.41421356237309515f;
#define LAS __attribute__((address_space(3)))
#define GAS __attribute__((address_space(1)))
typedef unsigned short bf16_t;
typedef short bf16x8 __attribute__((ext_vector_type(8)));
typedef float f32x4 __attribute__((ext_vector_type(4)));
typedef float f32x2 __attribute__((ext_vector_type(2)));
typedef unsigned u32x4 __attribute__((ext_vector_type(4)));
typedef unsigned u32x2 __attribute__((ext_vector_type(2)));
typedef GAS unsigned gu32;
#define RLX_AGENT __ATOMIC_RELAXED, __HIP_MEMORY_SCOPE_AGENT
#define LDS_WAIT() asm volatile("s_waitcnt lgkmcnt(0)" ::: "memory")
#define VM_WAIT() asm volatile("s_waitcnt vmcnt(0)" ::: "memory")

__device__ __forceinline__ unsigned cvt_pk_bf16(float lo, float hi) { unsigned r; asm volatile("v_cvt_pk_bf16_f32 %0, %1, %2" : "=v"(r) : "v"(lo), "v"(hi)); return r; }
__device__ __forceinline__ unsigned pack4_fp8(float a, float b, float c, float d) { int r = __builtin_amdgcn_cvt_pk_fp8_f32(a, b, 0, false); r = __builtin_amdgcn_cvt_pk_fp8_f32(c, d, r, true); return (unsigned)r; }
__device__ __forceinline__ float bf_lo(unsigned u) { return __uint_as_float(u << 16); }
__device__ __forceinline__ float bf_hi(unsigned u) { return __uint_as_float(u & 0xffff0000u); }
__device__ __forceinline__ float fsigmoid(float x) { return __builtin_amdgcn_rcpf(1.0f + __builtin_amdgcn_exp2f(-1.4426950408889634f * x)); }
__device__ __forceinline__ float fsilu(float x) { return x * fsigmoid(x); }
__device__ __forceinline__ float fgelu_tanh(float x) { return x * fsigmoid(1.5957691216057308f * (x + 0.044715f * x * x * x)); }
__device__ __forceinline__ float dpp_xor1(float v) { return __int_as_float(__builtin_amdgcn_mov_dpp(__float_as_int(v), 0xB1, 0xF, 0xF, true)); }
__device__ __forceinline__ float dpp_xor2(float v) { return __int_as_float(__builtin_amdgcn_mov_dpp(__float_as_int(v), 0x4E, 0xF, 0xF, true)); }
template <int M> __device__ __forceinline__ float swz_xor(float v) { return __int_as_float(__builtin_amdgcn_ds_swizzle(__float_as_int(v), (M << 10) | 0x1F)); }
__device__ __forceinline__ float half_sum(float v) { const auto r = __builtin_amdgcn_permlane32_swap(__float_as_uint(v), __float_as_uint(v), false, false); return __uint_as_float(r[0]) + __uint_as_float(r[1]); }
__device__ __forceinline__ float wave_sum(float v) { v += dpp_xor1(v); v += dpp_xor2(v); v += swz_xor<4>(v); v += swz_xor<8>(v); v += swz_xor<16>(v); return half_sum(v); }
__device__ __forceinline__ int lane_id_asm() { int l; asm volatile("v_mbcnt_lo_u32_b32 %0, -1, 0\n\tv_mbcnt_hi_u32_b32 %0, -1, %0" : "=v"(l)); return l; }

namespace pg8 {
constexpr int BM = 256, BK = 64, HALF = 128, HTB = HALF * BK * 2, STAGE_BYTES = 8 * HTB, NXCD = 8, WGM = 8;
__host__ __device__ __forceinline__ int lds_byte(int r, int c) { const int st = (r >> 4) * 2 + (c >> 5), rr = r & 15, cc = c & 31, ob = rr * 64 + cc * 2; return st * 1024 + (ob ^ (((ob >> 9) & 1) << 5)); }
__host__ __device__ __forceinline__ void stage_rc(int b, int& R, int& C) { const int st = b / 1024, sb = b % 1024, swz = sb ^ (((sb >> 9) & 1) << 5); R = (st >> 1) * 16 + swz / 64; C = (st & 1) * 32 + (swz % 64) / 2; }
__host__ __device__ __forceinline__ int perm32(int rho) { const int n = rho >> 4, i = rho & 15; return 8 * (i >> 2) + 4 * n + (i & 3); }

struct Unit { const char* A; const char* B; int row0, pn, e, gtab; };
__device__ __forceinline__ bool tile_of(int i, int G, int c, int nM, int nN, int& pm, int& pn) {
    const int nwg = nM * nN; const long L = (long)i * G + c; if (L >= nwg) return false;
    int wgid = (int)L; { const int q = nwg / NXCD, r = nwg % NXCD, xcd = wgid % NXCD, off = wgid / NXCD; wgid = (xcd < r ? xcd * (q + 1) : r * (q + 1) + (xcd - r) * q) + off; }
    const int nig = WGM * nN, gid = wgid / nig, fm = gid * WGM, gsz = (nM - fm) < WGM ? (nM - fm) : WGM;
    pm = fm + ((wgid % nig) % gsz); pn = (wgid % nig) / gsz; return true;
}

typedef int i32x8 __attribute__((ext_vector_type(8)));
typedef int i32x4 __attribute__((ext_vector_type(4)));
template <class Epi, class Sched, bool GATHER, int FMT = 0>
__device__ __forceinline__ void gemm_phase(LAS unsigned char* lds, const int wid_in, const int lda, const int ldb, const int KB, const Sched& S, const Epi& E, const int sclb = 0x7f7f7f7f) {
    const int lane = lane_id_asm(), wid = wid_in, tid = wid * 64 + lane, wr = wid >> 2, wc = wid & 3, fr = lane & 15, fq = lane >> 4;
    const int nt = KB / 128;
    int sclr = sclb; if constexpr (FMT == 1) asm volatile("" : "+v"(sclr));
    unsigned voffA[2], voffB[2];
#pragma unroll
    for (int i = 0; i < 2; ++i) { int R, C; stage_rc(tid * 16 + i * 8192, R, C); const int Rb = Epi::PERM ? ((R & ~31) + perm32(R & 31)) : R;
        voffA[i] = (unsigned)(R * lda + C * 2); voffB[i] = (unsigned)(Rb * ldb + C * 2); }
    const size_t kstep = (size_t)(BK * 2);
    const size_t hstepA = (size_t)HALF * lda, hstepB = (size_t)HALF * ldb;
    const unsigned ldsw = (unsigned)wid * 1024u;
    const int aoff = lds_byte(wr * 64 + fr, fq * 8), boff = lds_byte(wc * 32 + fr, fq * 8);
#define PG8_SA(b, h) (((b) * 2 + (h)) * HTB)
#define PG8_SB(b, h) ((4 + (b) * 2 + (h)) * HTB)
#define PG8_ST2(bufoff, gbase, o0, o1) do { \
        __builtin_amdgcn_global_load_lds((const unsigned*)((const char*)(gbase) + (o0)), (LAS unsigned*)(lds + (bufoff) + ldsw), 16, 0, 0); \
        __builtin_amdgcn_global_load_lds((const unsigned*)((const char*)(gbase) + (o1)), (LAS unsigned*)(lds + (bufoff) + ldsw + 8192), 16, 0, 0); } while (0)
#define PG8_STB(bufoff, gbase, h) PG8_ST2(bufoff, (gbase) + (h) * hstepB, voffB[0], voffB[1])
#define PG8_STA(bufoff, gbase, h, G0, G1) do { if constexpr (GATHER) { PG8_ST2(bufoff, gbase, G0, G1); } else { PG8_ST2(bufoff, (gbase) + (h) * hstepA, voffA[0], voffA[1]); } } while (0)
#define PG8_CAT8(l_, h_) __builtin_shufflevector(l_, h_, 0, 1, 2, 3, 4, 5, 6, 7)
#define PG8_LO4(v_) __builtin_bit_cast(bf16x8, __builtin_shufflevector(v_, v_, 0, 1, 2, 3))
#define PG8_HI4(v_) __builtin_bit_cast(bf16x8, __builtin_shufflevector(v_, v_, 4, 5, 6, 7))
#define PG8_LDA(dst, b, h) do { _Pragma("unroll") for (int m = 0; m < 4; ++m) { const i32x4 l_ = *(const LAS i32x4*)(lds + PG8_SA(b, h) + aoff + m * 2048), h_ = *(const LAS i32x4*)(lds + PG8_SA(b, h) + aoff + m * 2048 + 1024); dst[m] = PG8_CAT8(l_, h_); } } while (0)
#define PG8_LDB(dst, b, h) do { _Pragma("unroll") for (int n = 0; n < 2; ++n) { const i32x4 l_ = *(const LAS i32x4*)(lds + PG8_SB(b, h) + boff + n * 2048), h_ = *(const LAS i32x4*)(lds + PG8_SB(b, h) + boff + n * 2048 + 1024); dst[n] = PG8_CAT8(l_, h_); } } while (0)
#define PG8_MMA(ai, bj, At, Bt) do { __builtin_amdgcn_s_setprio(1); _Pragma("unroll") for (int m = 0; m < 4; ++m) _Pragma("unroll") for (int n = 0; n < 2; ++n) { \
        if constexpr (FMT == 0) { acc[ai][bj][m][n] = __builtin_amdgcn_mfma_f32_16x16x32_bf16(PG8_LO4(Bt[n]), PG8_LO4(At[m]), acc[ai][bj][m][n], 0, 0, 0); \
                                  acc[ai][bj][m][n] = __builtin_amdgcn_mfma_f32_16x16x32_bf16(PG8_HI4(Bt[n]), PG8_HI4(At[m]), acc[ai][bj][m][n], 0, 0, 0); } \
        else asm volatile("v_mfma_scale_f32_16x16x128_f8f6f4 %0, %1, %2, %0, %3, %3 op_sel_hi:[0,0,0]" : "+v"(acc[ai][bj][m][n]) : "v"(Bt[n]), "v"(At[m]), "v"(sclr)); } \
        __builtin_amdgcn_s_setprio(0); } while (0)
#define PG8_WAIT_V(n) asm volatile("s_waitcnt vmcnt(" #n ")" ::: "memory")
#define PG8_WAIT_L(n) asm volatile("s_waitcnt lgkmcnt(" #n ")" ::: "memory")
#define PG8_BAR __builtin_amdgcn_s_barrier()
#define PG8_SCHED __builtin_amdgcn_sched_barrier(0)
    Unit cur, nxt; int ui = 0;
    if (!S.next(0, cur)) return;
    f32x4 acc[2][2][4][2];
#pragma unroll
    for (int a = 0; a < 2; ++a)
#pragma unroll
        for (int b = 0; b < 2; ++b)
#pragma unroll
            for (int m = 0; m < 4; ++m)
#pragma unroll
                for (int n = 0; n < 2; ++n) acc[a][b][m][n] = (f32x4){0.f, 0.f, 0.f, 0.f};
    i32x8 At[4], B0[2], B1[2];
    unsigned gc[2][2] = {{0u, 0u}, {0u, 0u}};
    if constexpr (GATHER) {
#pragma unroll
        for (int i = 0; i < 2; ++i) { int R, C; stage_rc(tid * 16 + i * 8192, R, C);
#pragma unroll
            for (int h = 0; h < 2; ++h) gc[h][i] = *(const LAS unsigned*)(lds + cur.gtab + (h * HALF + R) * 4) + (unsigned)C * 2u; }
    }
    const char* cA = cur.A; const char* cB = cur.B;
    PG8_STB(PG8_SB(0, 0), cB, 0); PG8_STB(PG8_SB(0, 1), cB, 1); PG8_STA(PG8_SA(0, 0), cA, 0, gc[0][0], gc[0][1]); PG8_STA(PG8_SA(0, 1), cA, 1, gc[1][0], gc[1][1]);
    if (wr == 1) PG8_BAR;
    PG8_WAIT_V(2); PG8_BAR;
    PG8_STB(PG8_SB(1, 0), cB + kstep, 0); PG8_STA(PG8_SA(1, 0), cA + kstep, 0, gc[0][0], gc[0][1]); PG8_STB(PG8_SB(1, 1), cB + kstep, 1);
    PG8_WAIT_V(6); PG8_BAR;
#define PG8_KITER(a1_, a2_, b2_, G00, G01, G10, G11) do { \
            const char* a3_ = (a2_) + kstep; const char* b3_ = (b2_) + kstep; \
              \
            PG8_LDB(B0, 0, 0); PG8_LDB(B1, 0, 1); PG8_SCHED; PG8_LDA(At, 0, 0); PG8_STA(PG8_SA(1, 1), a1_, 1, gc[1][0], gc[1][1]); \
            PG8_WAIT_V(8); PG8_WAIT_L(0); PG8_BAR; PG8_MMA(0, 0, At, B0); PG8_MMA(0, 1, At, B1); PG8_BAR; PG8_SCHED; \
              \
            PG8_LDA(At, 0, 1); PG8_STB(PG8_SB(0, 0), b2_, 0); PG8_STB(PG8_SB(0, 1), b2_, 1); PG8_STA(PG8_SA(0, 0), a2_, 0, G00, G01); \
            PG8_WAIT_V(8); PG8_WAIT_L(0); PG8_BAR; PG8_MMA(1, 0, At, B0); PG8_MMA(1, 1, At, B1); PG8_BAR; PG8_SCHED; \
              \
            PG8_LDB(B0, 1, 0); PG8_LDB(B1, 1, 1); PG8_SCHED; PG8_LDA(At, 1, 0); PG8_STA(PG8_SA(0, 1), a2_, 1, G10, G11); \
            PG8_WAIT_V(8); PG8_WAIT_L(0); PG8_BAR; PG8_MMA(0, 0, At, B0); PG8_MMA(0, 1, At, B1); PG8_BAR; PG8_SCHED; \
              \
            PG8_LDA(At, 1, 1); PG8_STB(PG8_SB(1, 0), b3_, 0); PG8_STB(PG8_SB(1, 1), b3_, 1); PG8_STA(PG8_SA(1, 0), a3_, 0, G00, G01); \
            PG8_WAIT_V(8); PG8_WAIT_L(0); PG8_BAR; PG8_MMA(1, 0, At, B0); PG8_MMA(1, 1, At, B1); PG8_BAR; PG8_SCHED; } while (0)
    for (;;) {
        const bool has_next = S.next(ui + 1, nxt);
        const char* nA = has_next ? nxt.A : cA; const char* nB = has_next ? nxt.B : cB;
        if constexpr (!GATHER) {
#pragma unroll 1
            for (int t = 0; t < nt; t += 2) {
                const bool last = (t == nt - 2);
                const char* a1 = cA + (size_t)(t + 1) * kstep;
                const char* a2 = last ? nA : cA + (size_t)(t + 2) * kstep; const char* b2 = last ? nB : cB + (size_t)(t + 2) * kstep;
                PG8_KITER(a1, a2, b2, 0u, 0u, 0u, 0u);
            }
        } else {
#pragma unroll 1
            for (int t = 0; t < nt - 2; t += 2) {
                const char* a1 = cA + (size_t)(t + 1) * kstep; const char* a2 = cA + (size_t)(t + 2) * kstep; const char* b2 = cB + (size_t)(t + 2) * kstep;
                PG8_KITER(a1, a2, b2, gc[0][0], gc[0][1], gc[1][0], gc[1][1]);
            }
            unsigned gn[2][2] = {{gc[0][0], gc[0][1]}, {gc[1][0], gc[1][1]}};
            if (has_next) {
                const int tid2 = wid * 64 + lane_id_asm();
#pragma unroll
                for (int i = 0; i < 2; ++i) { int R, C; stage_rc(tid2 * 16 + i * 8192, R, C);
#pragma unroll
                    for (int h = 0; h < 2; ++h) gn[h][i] = *(const LAS unsigned*)(lds + nxt.gtab + (h * HALF + R) * 4) + (unsigned)C * 2u; } }
            const char* a1 = cA + (size_t)(nt - 1) * kstep;
            PG8_KITER(a1, nA, nB, gn[0][0], gn[0][1], gn[1][0], gn[1][1]);
            gc[0][0] = gn[0][0]; gc[0][1] = gn[0][1]; gc[1][0] = gn[1][0]; gc[1][1] = gn[1][1];
        }
        if (wr == 0) PG8_BAR;
        if constexpr (FMT == 1) asm volatile("s_nop 15\n\ts_nop 15" ::: "memory");
        if constexpr (GATHER) { int fr2 = fr, fq2 = fq; asm volatile("" : "+v"(fr2), "+v"(fq2));
            E(acc, cur, wr, wc, fr2, fq2); }
        else E(acc, cur, wr, wc, fr, fq);
        if (!has_next) break;
#pragma unroll
        for (int a = 0; a < 2; ++a)
#pragma unroll
            for (int b = 0; b < 2; ++b)
#pragma unroll
                for (int m = 0; m < 4; ++m)
#pragma unroll
                    for (int n = 0; n < 2; ++n) acc[a][b][m][n] = (f32x4){0.f, 0.f, 0.f, 0.f};
        cur = nxt; cA = nA; cB = nB; ++ui;
        if (wr == 1) PG8_BAR;
    }
    PG8_WAIT_V(0);
    PG8_BAR;
#undef PG8_SA
#undef PG8_SB
#undef PG8_ST2
#undef PG8_STB
#undef PG8_STA
#undef PG8_LDA
#undef PG8_CAT8
#undef PG8_LO4
#undef PG8_HI4
#undef PG8_LDB
#undef PG8_MMA
#undef PG8_WAIT_V
#undef PG8_WAIT_L
#undef PG8_BAR
#undef PG8_SCHED
#undef PG8_KITER
}

typedef f32x4 AccT[2][2][4][2];
__device__ __forceinline__ u32x4 pack8(const f32x4 a, const f32x4 b) { u32x4 w; w.x = cvt_pk_bf16(a[0], a[1]); w.y = cvt_pk_bf16(a[2], a[3]); w.z = cvt_pk_bf16(b[0], b[1]); w.w = cvt_pk_bf16(b[2], b[3]); return w; }
template <int ACT> __device__ __forceinline__ void store_plain(const AccT& acc, bf16_t* O, int ldo, int row0, int col0, int wr, int wc, int fr, int fq) {
#pragma unroll
    for (int ai = 0; ai < 2; ++ai)
#pragma unroll
        for (int m = 0; m < 4; ++m) { bf16_t* rowp = O + (size_t)(row0 + ai * HALF + wr * 64 + m * 16 + fr) * ldo + col0 + wc * 32 + 8 * fq;
#pragma unroll
            for (int bj = 0; bj < 2; ++bj) { f32x4 v0 = acc[ai][bj][m][0], v1 = acc[ai][bj][m][1];
                if (ACT == 1) {
#pragma unroll
                    for (int j = 0; j < 4; ++j) { v0[j] = fgelu_tanh(v0[j]); v1[j] = fgelu_tanh(v1[j]); } }
                *(u32x4*)(rowp + bj * HALF) = pack8(v0, v1); } }
}
template <int MODE> __device__ __forceinline__ void store_pair(const AccT& acc, bf16_t* O, int ldo, int row0, int col0, int wr, int wc, int fr, int fq) {
#pragma unroll
    for (int ai = 0; ai < 2; ++ai)
#pragma unroll
        for (int m = 0; m < 4; ++m) { bf16_t* rowp = O + (size_t)(row0 + ai * HALF + wr * 64 + m * 16 + fr) * ldo + col0 + wc * 32 + 8 * fq;
            f32x4 o[2];
#pragma unroll
            for (int n = 0; n < 2; ++n) { const f32x4 v = acc[ai][0][m][n], g = acc[ai][1][m][n];
#pragma unroll
                for (int j = 0; j < 4; ++j) o[n][j] = MODE == 0 ? v[j] * fsigmoid(g[j]) : (MODE == 1 ? v[j] * g[j] : fsilu(v[j]) * g[j]); }
            *(u32x4*)rowp = pack8(o[0], o[1]); }
}
struct EpiIn0 {
    static constexpr bool PERM = true; bf16_t* U0;
    __device__ __forceinline__ void operator()(const AccT& acc, const Unit& u, int wr, int wc, int fr, int fq) const {
        if (u.pn < 4) store_pair<0>(acc, U0, 1536, u.row0, 128 * u.pn, wr, wc, fr, fq);
        else if (u.pn < 8) store_pair<1>(acc, U0, 1536, u.row0, 512 + 128 * (u.pn - 4), wr, wc, fr, fq);
        else store_plain<0>(acc, U0, 1536, u.row0, 1024 + 256 * (u.pn - 8), wr, wc, fr, fq);
    }
};
struct EpiIn1 {
    static constexpr bool PERM = true; bf16_t* GY; bf16_t* XR;
    __device__ __forceinline__ void operator()(const AccT& acc, const Unit& u, int wr, int wc, int fr, int fq) const {
        if (u.pn < 4) store_plain<1>(acc, GY, D, u.row0, 256 * u.pn, wr, wc, fr, fq);
        else store_plain<0>(acc, XR, D, u.row0, 256 * (u.pn - 4), wr, wc, fr, fq);
    }
};
__device__ __forceinline__ void store_pair_fp8(const AccT& acc, unsigned char* O, int ldo, int row0, int col0, int wr, int wc, int fr, int fq) {
#pragma unroll
    for (int ai = 0; ai < 2; ++ai)
#pragma unroll
        for (int m = 0; m < 4; ++m) { unsigned char* rowp = O + (size_t)(row0 + ai * HALF + wr * 64 + m * 16 + fr) * ldo + col0 + wc * 32 + 8 * fq;
            u32x2 w;
#pragma unroll
            for (int n = 0; n < 2; ++n) { const f32x4 v = acc[ai][0][m][n], g = acc[ai][1][m][n]; float o[4];
#pragma unroll
                for (int j = 0; j < 4; ++j) o[j] = fminf(fmaxf(fsilu(v[j]) * g[j], -448.f), 448.f);
                const unsigned pk = pack4_fp8(o[0], o[1], o[2], o[3]); if (n == 0) w.x = pk; else w.y = pk; }
            *(u32x2*)rowp = w; }
}
struct EpiMoe1Q { static constexpr bool PERM = true; unsigned char* H;
    __device__ __forceinline__ void operator()(const AccT& acc, const Unit& u, int wr, int wc, int fr, int fq) const { store_pair_fp8(acc, H, DEXP, u.row0, 128 * u.pn, wr, wc, fr, fq); } };
struct EpiMoe1 { static constexpr bool PERM = true; bf16_t* H;
    __device__ __forceinline__ void operator()(const AccT& acc, const Unit& u, int wr, int wc, int fr, int fq) const { store_pair<2>(acc, H, DEXP, u.row0, 128 * u.pn, wr, wc, fr, fq); } };
struct EpiMoe2 { static constexpr bool PERM = true; bf16_t* Y;
    __device__ __forceinline__ void operator()(const AccT& acc, const Unit& u, int wr, int wc, int fr, int fq) const { store_plain<0>(acc, Y, D, u.row0, 256 * u.pn, wr, wc, fr, fq); } };
struct EpiRes { static constexpr bool PERM = true; const bf16_t* res; bf16_t* Y;
    __device__ __forceinline__ void operator()(const AccT& acc, const Unit& u, int wr, int wc, int fr, int fq) const {
#pragma unroll
        for (int ai = 0; ai < 2; ++ai)
#pragma unroll
            for (int m = 0; m < 4; ++m) { const size_t off = (size_t)(u.row0 + ai * HALF + wr * 64 + m * 16 + fr) * D + u.pn * 256 + wc * 32 + 8 * fq;
#pragma unroll
                for (int bj = 0; bj < 2; ++bj) { const size_t o = off + bj * HALF; const u32x4 w = *(const u32x4*)(res + o);
                    const f32x4 r0 = {bf_lo(w.x), bf_hi(w.x), bf_lo(w.y), bf_hi(w.y)}, r1 = {bf_lo(w.z), bf_hi(w.z), bf_lo(w.w), bf_hi(w.w)};
                    *(u32x4*)(Y + o) = pack8(r0 * ALPHA + acc[ai][bj][m][0], r1 * ALPHA + acc[ai][bj][m][1]); } }
    }
};
struct EpiGates { static constexpr bool PERM = true; const bf16_t* XC; const float* ba; const float* bx; const float* spl; bf16_t* L2A; bf16_t* BV;
    __device__ __forceinline__ void operator()(const AccT& acc, const Unit& u, int wr, int wc, int fr, int fq) const {
        const int col = 128 * u.pn + wc * 32 + 8 * fq;
#pragma unroll
        for (int ai = 0; ai < 2; ++ai)
#pragma unroll
            for (int m = 0; m < 4; ++m) { const size_t o = (size_t)(u.row0 + ai * HALF + wr * 64 + m * 16 + fr) * DRNN + col;
                const u32x4 xw = *(const u32x4*)(XC + o); const float xv[8] = {bf_lo(xw.x), bf_hi(xw.x), bf_lo(xw.y), bf_hi(xw.y), bf_lo(xw.z), bf_hi(xw.z), bf_lo(xw.w), bf_hi(xw.w)};
                f32x4 la2[2], bo[2];
#pragma unroll
                for (int n = 0; n < 2; ++n) { const f32x4 cba = *(const f32x4*)(ba + col + 4 * n), cbx = *(const f32x4*)(bx + col + 4 * n), csp = *(const f32x4*)(spl + col + 4 * n);
#pragma unroll
                    for (int j = 0; j < 4; ++j) { const float r = fsigmoid(acc[ai][0][m][n][j] + cba[j]), ig = fsigmoid(acc[ai][1][m][n][j] + cbx[j]);
                        const float l2 = -1.4426950408889634f * csp[j] * r;
                        const float a = __builtin_amdgcn_exp2f(l2); la2[n][j] = l2; bo[n][j] = __builtin_sqrtf(fmaxf(1.0f - a * a, 0.f)) * (ig * xv[4 * n + j]); } }
                *(u32x4*)(L2A + o) = pack8(la2[0], la2[1]); *(u32x4*)(BV + o) = pack8(bo[0], bo[1]);
                asm volatile("" ::: "memory"); }
    }
};
}

constexpr size_t MiB = 1u << 20;
constexpr size_t WS_CTL = 0, CTL_ZERO_BYTES = 65536;
constexpr size_t WS_WIN0 = 2 * MiB, WS_WOUT0 = 7 * MiB, WS_WIN1 = 9 * MiB, WS_WGT = 13 * MiB, WS_WOUT1 = 14 * MiB, WS_W13 = 16 * MiB, WS_W2 = 144 * MiB, WS_SPL = 208 * MiB;
constexpr size_t WS_X1 = 212 * MiB, WS_X2 = 244 * MiB, WS_XB = WS_X2;
constexpr size_t WS_R = 276 * MiB;
constexpr size_t WS_U0 = WS_R, WS_CAT0 = WS_R + 48 * MiB, WS_YPRE0 = WS_R + 80 * MiB;
constexpr size_t WS_GY = WS_R, WS_XR = WS_R + 32 * MiB, WS_XC = WS_R + 64 * MiB, WS_BV = WS_R + 96 * MiB, WS_YPRE1 = WS_R + 64 * MiB;
constexpr size_t WS_H = WS_R, WS_Y = WS_R + 72 * MiB;
constexpr size_t WS_LIST = 420 * MiB, WS_TOKSLOT = 421 * MiB, WS_TOKGATE = WS_TOKSLOT + 256 * 1024, WS_AGG = 422 * MiB, WS_X1Q = 424 * MiB  , WS_FAST_END = 440 * MiB;
#ifndef MOE_FP8
#define MOE_FP8 1
#endif
#ifndef INP_FP8_L0
#define INP_FP8_L0 0
#endif
#ifndef INP_FP8_L1
#define INP_FP8_L1 1
#endif
#define INP_FP8 (INP_FP8_L0 || INP_FP8_L1)
constexpr int SCL_WIN = 6;
constexpr size_t WS_XQ = WS_X1Q;
constexpr int SCL_W13 = 6, SCL_W2 = 6;
static_assert(SCL_W13 % 2 == 0 && SCL_W2 % 2 == 0, "even scales");
constexpr int NPAD_ROWS = 2 * T + NE * 256;
static_assert(WS_H + (size_t)NPAD_ROWS * DEXP * 2 <= WS_Y && WS_Y + (size_t)NPAD_ROWS * D * 2 <= WS_LIST, "H / Y fit");
constexpr int CW_TMO = 0, CW_CODE = 1, CW_GCOUNT = 256  , CW_BAR = 4096;
constexpr int RING_BYTES = 131072, LDSCTL_OFF = RING_BYTES, MISC_OFF = LDSCTL_OFF + 320, UNITS_OFF = LDSCTL_OFF + 512, MOEMETA_OFF = LDSCTL_OFF + 768, GTAB_OFF = LDSCTL_OFF + 1024, MAX_UNITS = 8;
constexpr int LDS_BYTES = 147456;
static_assert(GTAB_OFF + MAX_UNITS * 1024 <= LDS_BYTES, "LDS map");
constexpr int NWAVES = 8, NTHREADS = 512;

#define XB_TMO      128
#define XB_XCNT(j)  (256  + 64 * (j))
#define XB_XSUB(j)  (1280 + 64 * (j))
#define XB_XGEN(j)  (2304 + 64 * (j))
#define XB_TOP      3328
#define XB_TOPGEN   3392
#define XCD_BAR_WORDS 3456
#define XB_SPIN_CAP (1u << 18)
__device__ __forceinline__ unsigned xb_ld(unsigned* p)              { return __hip_atomic_load(p, __ATOMIC_RELAXED, __HIP_MEMORY_SCOPE_AGENT); }
__device__ __forceinline__ unsigned xb_add(unsigned* p, unsigned v) { return __hip_atomic_fetch_add(p, v, __ATOMIC_RELAXED, __HIP_MEMORY_SCOPE_AGENT); }
__device__ __forceinline__ unsigned xb_xcc_id() { return (unsigned)__builtin_amdgcn_s_getreg((3 << 11) | 20) & 0xFu; }
#define XB_SPIN(cond, bar) do { unsigned _sp = 0; while (cond) { __builtin_amdgcn_s_sleep(1); \
    if ((++_sp & 255u) == 0u) { if (xb_ld(&(bar)[XB_TMO])) break; if (_sp > XB_SPIN_CAP) { atomicAdd(&(bar)[XB_TMO], 1u); break; } } } } while (0)
struct XcdBarrier { unsigned* bar; unsigned x; volatile LAS unsigned* st; int wave; };
__device__ __forceinline__ XcdBarrier xcd_barrier_post(unsigned* bar, volatile LAS unsigned* st, int wave) {
    XcdBarrier b; b.bar = bar; b.x = xb_xcc_id(); b.st = st; b.wave = wave;
    if (wave == 0 && lane_id_asm() == 0) (void)xb_add(&bar[XB_XCNT(b.x)], 1u);
    return b;
}
__device__ __forceinline__ void xcd_barrier_complete(unsigned* bar, unsigned x, unsigned& nloc, unsigned& nx) {
    const unsigned G = gridDim.x * gridDim.y * gridDim.z;
    unsigned sum, cnt, mine, sp = 0u;
    for (;;) {
        sum = 0u; cnt = 0u; mine = 0u;
#pragma unroll
        for (unsigned j = 0; j < 16; ++j) { const unsigned c = xb_ld(&bar[XB_XCNT(j)]); sum += c; cnt += (c > 0u) ? 1u : 0u; mine = (j == x) ? c : mine; }
        if (sum == G) break;
        __builtin_amdgcn_s_sleep(1);
        if ((++sp & 255u) == 0u) { if (xb_ld(&bar[XB_TMO])) break; if (sp > XB_SPIN_CAP) { atomicAdd(&bar[XB_TMO], 1u); break; } }
    }
    nloc = mine > 0u ? mine : 1u; nx = cnt > 0u ? cnt : 1u;
}
__device__ __forceinline__ void xcd_barrier(const XcdBarrier& b) {
    asm volatile("s_waitcnt vmcnt(0)" ::: "memory");
    __syncthreads();
    if (b.wave == 0 && lane_id_asm() == 0) {
        unsigned* bar = b.bar;
        __builtin_amdgcn_s_waitcnt(0);
        unsigned nloc = b.st[0], nx = b.st[1];
        if (nloc == 0u) { xcd_barrier_complete(bar, b.x, nloc, nx); b.st[0] = nloc; b.st[1] = nx; }
        const unsigned old = xb_add(&bar[XB_XSUB(b.x)], 1u);
        const unsigned gen = old / nloc;
        if (old + 1u == (gen + 1u) * nloc) {
            __builtin_amdgcn_fence(__ATOMIC_RELEASE, "agent");
            asm volatile("s_waitcnt vmcnt(0)" ::: "memory");
            const unsigned og = xb_add(&bar[XB_TOP], 1u);
            const unsigned tg = og / nx;
            if (og + 1u == (tg + 1u) * nx) xb_add(&bar[XB_TOPGEN], 1u);
            else XB_SPIN(xb_ld(&bar[XB_TOPGEN]) == tg, bar);
            __builtin_amdgcn_fence(__ATOMIC_ACQUIRE, "agent");
            xb_add(&bar[XB_XGEN(b.x)], 1u);
            asm volatile("s_waitcnt vmcnt(0)" ::: "memory");
        } else {
            XB_SPIN(xb_ld(&bar[XB_XGEN(b.x)]) == gen, bar);
            __builtin_amdgcn_fence(__ATOMIC_ACQUIRE, "agent");
            asm volatile("s_waitcnt vmcnt(0)" ::: "memory");
        }
    }
    __syncthreads();
}

struct Args { const float* in[26]; float* out; unsigned char* ws; int ph_lo, ph_hi; };
struct Frame {
    LAS unsigned char* lds; unsigned char* ws; const float* const* in; float* out;
    int tid, lane, wave, vcu, G;
    template <class Tp> __device__ __forceinline__ Tp* W(size_t off) const { return (Tp*)(ws + off); }
    __device__ __forceinline__ const float* I(int i) const { return in[i]; }
    __device__ __forceinline__ unsigned* ctl() const { return (unsigned*)(ws + WS_CTL); }
    __device__ __forceinline__ void retid() { lane = lane_id_asm(); tid = wave * 64 + lane; }
};

__device__ __forceinline__ void cvt_item(const float* src, int ldsrc, int k0, int c0, bf16_t* dst, int lddst, int drow0, LAS unsigned* scr, int lane) {
    const int cg = lane & 15, rp = lane >> 4;
    const float* sp = src + (size_t)k0 * ldsrc + c0 + 4 * cg;
    f32x4 v[16];
#pragma unroll
    for (int j = 0; j < 8; ++j) { const int r = 2 * (rp + 4 * j); v[2 * j] = __builtin_nontemporal_load((const f32x4*)(sp + (size_t)r * ldsrc)); v[2 * j + 1] = __builtin_nontemporal_load((const f32x4*)(sp + (size_t)(r + 1) * ldsrc)); }
#pragma unroll
    for (int j = 0; j < 8; ++j) { const int kd = rp + 4 * j;
#pragma unroll
        for (int i = 0; i < 4; ++i) scr[(4 * cg + i) * 33 + kd] = cvt_pk_bf16(v[2 * j][i], v[2 * j + 1][i]); }
    LDS_WAIT();
    const int kc = lane & 7;
#pragma unroll
    for (int jj = 0; jj < 8; ++jj) { const int n = (lane >> 3) + 8 * jj; const LAS unsigned* s = scr + n * 33 + 4 * kc;
        u32x4 o; o.x = s[0]; o.y = s[1]; o.z = s[2]; o.w = s[3];
        *(u32x4*)(dst + (size_t)(drow0 + n) * lddst + k0 + 8 * kc) = o; }
    LDS_WAIT();
}
__device__ __forceinline__ void cvt_item8(const float* src, int ldsrc, int k0, int c0, unsigned char* dst, int lddst, int drow0, float scale, LAS unsigned* scr, int lane) {
    const int cg = lane & 15, rp = lane >> 4;
    const float* sp = src + (size_t)k0 * ldsrc + c0 + 4 * cg;
    f32x4 v[16];
#pragma unroll
    for (int j = 0; j < 4; ++j)
#pragma unroll
        for (int q = 0; q < 4; ++q) v[4 * j + q] = __builtin_nontemporal_load((const f32x4*)(sp + (size_t)(4 * (rp + 4 * j) + q) * ldsrc));
#pragma unroll
    for (int j = 0; j < 4; ++j) { const int kq = rp + 4 * j;
#pragma unroll
        for (int i = 0; i < 4; ++i) scr[(4 * cg + i) * 17 + kq] = pack4_fp8(v[4 * j][i] * scale, v[4 * j + 1][i] * scale, v[4 * j + 2][i] * scale, v[4 * j + 3][i] * scale); }
    LDS_WAIT();
    const int c4 = lane & 3;
#pragma unroll
    for (int jj = 0; jj < 4; ++jj) { const int n = (lane >> 2) + 16 * jj; const LAS unsigned* s = scr + n * 17 + 4 * c4;
        u32x4 o; o.x = s[0]; o.y = s[1]; o.z = s[2]; o.w = s[3];
        *(u32x4*)(dst + (size_t)(drow0 + n) * lddst + k0 + 16 * c4) = o; }
    LDS_WAIT();
}
__device__ __forceinline__ void p0_prologue(Frame& F) {
    F.retid();
    LAS unsigned* scr = (LAS unsigned*)(F.lds + F.wave * 8448);
    const int gw = F.vcu * NWAVES + F.wave, NGW = F.G * NWAVES;
    constexpr int I_IN0 = 16 * 40, I_OUT0 = 16 * 16, I_IN1 = 16 * 32, I_GT = 4 * 4 * 8, I_OUT1 = 16 * 16, I_W13 = 32 * 16 * 32, I_W2 = 32 * 16 * 16;
    constexpr int NITEMS = I_IN0 + I_OUT0 + I_IN1 + I_GT + I_OUT1 + I_W13 + I_W2;
    for (int it = gw; it < NITEMS; it += NGW) {
        int r = it; const float* src; int ldsrc, k0, sc, lddst, drow0; unsigned char* dst; bool q8 = false; float scale = 1.f;
        if (r < I_IN0) { const int kb = r / 40, db = r % 40, p = db >> 2, q = db & 3;
            if (p < 4) sc = (q < 2) ? 128 * p + 64 * q : 512 + 128 * p + 64 * (q - 2);
            else if (p < 8) sc = (q < 2) ? 1536 + 128 * (p - 4) + 64 * q : 2048 + 128 * (p - 4) + 64 * (q - 2);
            else sc = 1024 + 256 * (p - 8) + 64 * q;
            src = F.I(5); ldsrc = DIN0; k0 = 64 * kb; dst = F.W<unsigned char>(WS_WIN0); lddst = D; drow0 = 64 * db; q8 = INP_FP8_L0; scale = (float)(1 << SCL_WIN); }
        else if ((r -= I_IN0) < I_OUT0) { const int kb = r / 16, db = r % 16; src = F.I(11); ldsrc = D; k0 = 64 * kb; sc = 64 * db; dst = F.W<unsigned char>(WS_WOUT0); lddst = D; drow0 = 64 * db; }
        else if ((r -= I_OUT0) < I_IN1) { const int kb = r / 32, db = r % 32; src = F.I(12); ldsrc = 2 * DRNN; k0 = 64 * kb; sc = 64 * db; dst = F.W<unsigned char>(WS_WIN1); lddst = D; drow0 = 64 * db; q8 = INP_FP8_L1; scale = (float)(1 << SCL_WIN); }
        else if ((r -= I_IN1) < I_GT) { const int h = r / 32, r2 = r % 32, kb = r2 / 8, db = r2 % 8, p = db >> 2, q = db & 3;
            src = (q < 2 ? F.I(15) : F.I(17)) + (size_t)h * RBLK * RBLK; ldsrc = RBLK; k0 = 64 * kb; sc = 128 * p + 64 * (q & 1); dst = F.W<unsigned char>(WS_WGT) + (size_t)h * 512 * RBLK * 2; lddst = RBLK; drow0 = 64 * db; }
        else if ((r -= I_GT) < I_OUT1) { const int kb = r / 16, db = r % 16; src = F.I(20); ldsrc = D; k0 = 64 * kb; sc = 64 * db; dst = F.W<unsigned char>(WS_WOUT1); lddst = DRNN; drow0 = 64 * db; }
        else if ((r -= I_OUT1) < I_W13) { const int le = r / 512, r2 = r % 512, kb = r2 / 32, db = r2 % 32, p = db >> 2, q = db & 3;
            src = (q < 2 ? F.I(23) : F.I(24)) + (size_t)le * D * DEXP; ldsrc = DEXP; k0 = 64 * kb; sc = 128 * p + 64 * (q & 1); lddst = D; drow0 = 64 * db;
            q8 = MOE_FP8; scale = (float)(1 << SCL_W13); dst = F.W<unsigned char>(WS_W13) + (size_t)le * 2 * DEXP * D * (MOE_FP8 ? 1 : 2); }
        else { r -= I_W13; const int le = r / 256, r2 = r % 256, kb = r2 / 16, db = r2 % 16;
            src = F.I(25) + (size_t)le * DEXP * D; ldsrc = D; k0 = 64 * kb; sc = 64 * db; lddst = DEXP; drow0 = 64 * db;
            q8 = MOE_FP8; scale = (float)(1 << SCL_W2); dst = F.W<unsigned char>(WS_W2) + (size_t)le * D * DEXP * (MOE_FP8 ? 1 : 2); }
        if (q8) cvt_item8(src, ldsrc, k0, sc, dst, lddst, drow0, scale, scr, F.lane);
        else cvt_item(src, ldsrc, k0, sc, (bf16_t*)dst, lddst, drow0, scr, F.lane);
    }
    { const float* x = F.I(0); bf16_t* xb = F.W<bf16_t>(WS_X2); const size_t n8 = (size_t)T * D / 8, stride = (size_t)F.G * NTHREADS;
      unsigned char* xq = F.W<unsigned char>(WS_XQ); (void)xq;
      for (size_t i = (size_t)F.vcu * NTHREADS + F.tid; i < n8; i += stride) { const f32x4 a = __builtin_nontemporal_load((const f32x4*)(x + i * 8)), b = __builtin_nontemporal_load((const f32x4*)(x + i * 8 + 4)); *(u32x4*)(xb + i * 8) = pg8::pack8(a, b);
#if INP_FP8_L0
          u32x2 q; q.x = pack4_fp8(a[0], a[1], a[2], a[3]); q.y = pack4_fp8(b[0], b[1], b[2], b[3]); *(u32x2*)(xq + i * 8) = q;
#endif
      } }
    { const int i = F.vcu * NTHREADS + F.tid; if (i < DRNN) F.W<float>(WS_SPL)[i] = 8.0f * log1pf(expf(-F.I(19)[i])); }
}

struct DenseOrder {
    const char* A; const char* B; size_t a_tile, b_tile; int nM, nN, G, c;
    __device__ __forceinline__ bool next(int i, pg8::Unit& u) const { int pm, pn; if (!pg8::tile_of(i, G, c, nM, nN, pm, pn)) return false;
        u.A = A + (size_t)pm * a_tile; u.B = B + (size_t)pn * b_tile; u.row0 = pm * 256; u.pn = pn; u.e = 0; u.gtab = 0; return true; }
};
struct GatesOrder {
    const char* XC; const char* WG; int G, c;
    __device__ __forceinline__ bool next(int i, pg8::Unit& u) const { int pm, pn; if (!pg8::tile_of(i, G, c, T / 256, 2 * RHEADS, pm, pn)) return false;
        u.A = XC + (size_t)pm * 256 * DRNN * 2 + (size_t)(pn >> 1) * RBLK * 2; u.B = WG + (size_t)pn * 256 * RBLK * 2; u.row0 = pm * 256; u.pn = pn; u.e = 0; u.gtab = 0; return true; }
};
struct MoeOrder { LAS const int* units; int nu; const char* A; const char* B; size_t b_exp, b_tile, a_tile; bool gather;
    __device__ __forceinline__ bool next(int i, pg8::Unit& u) const { if (i >= nu) return false;
        const int e = __builtin_amdgcn_readfirstlane(units[4 * i]), pm = __builtin_amdgcn_readfirstlane(units[4 * i + 1]), pn = __builtin_amdgcn_readfirstlane(units[4 * i + 2]);
        u.A = gather ? A : A + (size_t)pm * a_tile; u.B = B + (size_t)e * b_exp + (size_t)pn * b_tile; u.row0 = pm * 256; u.pn = pn; u.e = e; u.gtab = GTAB_OFF + i * 1024; return true; }
};
__device__ __forceinline__ int moe_setup(Frame& F, int layer, int nN, bool gather, unsigned rowbytes) {
    F.retid();
    LAS int* meta = (LAS int*)(F.lds + MOEMETA_OFF); LAS int* units = (LAS int*)(F.lds + UNITS_OFF); LAS unsigned* gtab = (LAS unsigned*)(F.lds + GTAB_OFF);
    const unsigned* gcount = F.ctl() + CW_GCOUNT + 32 * layer;
    if (F.tid < NE) meta[17 + F.tid] = (int)__hip_atomic_load(gcount + F.tid, RLX_AGENT);
    __syncthreads();
    if (F.tid == 0) { int acc = 0; for (int e = 0; e < NE; ++e) { meta[e] = acc; acc += (meta[17 + e] + 255) >> 8; } meta[NE] = acc; }
    __syncthreads();
    const int nM = meta[NE]; int nu = 0;
    for (int i = 0; i < MAX_UNITS; ++i) { int pm, pn; if (!pg8::tile_of(i, F.G, (int)blockIdx.x, nM, nN, pm, pn)) break;
        int e = 0;
#pragma unroll
        for (int j = 1; j < NE; ++j) e += (meta[j] <= pm) ? 1 : 0;
        if (F.tid == 0) { units[4 * i] = e; units[4 * i + 1] = pm; units[4 * i + 2] = pn; units[4 * i + 3] = 0; }
        if (gather && F.tid < 256) { const int idx = (pm - meta[e]) * 256 + F.tid; const int cnt = meta[17 + e];
            const int tok = idx < cnt ? F.W<int>(WS_LIST)[e * T + idx] : 0; gtab[i * 256 + F.tid] = (unsigned)tok * rowbytes; }
        nu = i + 1; }
    __syncthreads();
    return nu;
}

__device__ __forceinline__ void p_mix0(Frame& F) {
    F.retid();
    LAS float* wA = (LAS float*)F.lds;
    LAS float* wB = wA + CONVA * DA;
    LAS float* pb = wB + CONVB * DB;
    for (int i = F.tid; i < CONVA * DA; i += NTHREADS) wA[i] = F.I(6)[i];
    for (int i = F.tid; i < CONVB * DB; i += NTHREADS) wB[i] = F.I(10)[i];
    for (int i = F.tid; i < DA; i += NTHREADS) { pb[i] = F.I(7)[i]; pb[DA + i] = F.I(8)[i]; pb[2 * DA + i] = F.I(9)[i]; }
    __syncthreads();
    const bf16_t* U0 = F.W<bf16_t>(WS_U0); bf16_t* CAT = F.W<bf16_t>(WS_CAT0);
    const int c0 = 8 * F.lane;
#pragma unroll 1
    for (int tb = F.vcu * NWAVES + F.wave; tb < T / 8; tb += F.G * NWAVES) {
        const int t0 = tb * 8, s0 = t0 & (SEQ - 1);
        float acc[8][8];
        { const f32x4 b0 = *(const LAS f32x4*)(pb + c0), b1 = *(const LAS f32x4*)(pb + c0 + 4);
#pragma unroll
          for (int r = 0; r < 8; ++r) { acc[r][0] = b0[0]; acc[r][1] = b0[1]; acc[r][2] = b0[2]; acc[r][3] = b0[3]; acc[r][4] = b1[0]; acc[r][5] = b1[1]; acc[r][6] = b1[2]; acc[r][7] = b1[3]; } }
#pragma unroll
        for (int jb = 0; jb < 5; ++jb) {
            u32x4 in[8];
#pragma unroll
            for (int jj = 0; jj < 8; ++jj) { const int j = jb * 8 + jj; const int d = 30 - j;
                const bool ok = (j < 38) && (s0 - d >= 0); const size_t rr = ok ? (size_t)(t0 - d) : (size_t)t0;
                in[jj] = *(const u32x4*)(U0 + rr * 1536 + c0); if (!ok) in[jj] = (u32x4){0u, 0u, 0u, 0u}; }
#pragma unroll
            for (int jj = 0; jj < 8; ++jj) { const int j = jb * 8 + jj;
                const float x0 = bf_lo(in[jj].x), x1 = bf_hi(in[jj].x), x2 = bf_lo(in[jj].y), x3 = bf_hi(in[jj].y), x4 = bf_lo(in[jj].z), x5 = bf_hi(in[jj].z), x6 = bf_lo(in[jj].w), x7 = bf_hi(in[jj].w);
#pragma unroll
                for (int r = 0; r < 8; ++r) { const int k = j - r; if (k < 0 || k >= CONVA) continue;
                    const f32x4 w0 = *(const LAS f32x4*)(wA + k * DA + c0), w1 = *(const LAS f32x4*)(wA + k * DA + c0 + 4);
                    acc[r][0] += w0[0] * x0; acc[r][1] += w0[1] * x1; acc[r][2] += w0[2] * x2; acc[r][3] += w0[3] * x3;
                    acc[r][4] += w1[0] * x4; acc[r][5] += w1[1] * x5; acc[r][6] += w1[2] * x6; acc[r][7] += w1[3] * x7; } }
        }
        float mean[8], rstd[8];
#pragma unroll
        for (int r = 0; r < 8; ++r) { float sm = 0.f;
#pragma unroll
            for (int j = 0; j < 8; ++j) sm += acc[r][j];
            mean[r] = sm; }
#pragma unroll
        for (int r = 0; r < 8; ++r) mean[r] = wave_sum(mean[r]) * (1.0f / DA);
#pragma unroll
        for (int r = 0; r < 8; ++r) { float q = 0.f;
#pragma unroll
            for (int j = 0; j < 8; ++j) { acc[r][j] -= mean[r]; q += acc[r][j] * acc[r][j]; }
            rstd[r] = q; }
#pragma unroll
        for (int r = 0; r < 8; ++r) rstd[r] = 1.0f / sqrtf(wave_sum(rstd[r]) * (1.0f / DA) + LN_EPS);
        { const f32x4 g0 = *(const LAS f32x4*)(pb + DA + c0), g1 = *(const LAS f32x4*)(pb + DA + c0 + 4), e0 = *(const LAS f32x4*)(pb + 2 * DA + c0), e1 = *(const LAS f32x4*)(pb + 2 * DA + c0 + 4);
#pragma unroll
          for (int r = 0; r < 8; ++r) { f32x4 o0, o1;
#pragma unroll
              for (int j = 0; j < 4; ++j) { o0[j] = fsilu(acc[r][j] * rstd[r] * g0[j] + e0[j]); o1[j] = fsilu(acc[r][4 + j] * rstd[r] * g1[j] + e1[j]); }
              *(u32x4*)(CAT + (size_t)(t0 + r) * D + c0) = pg8::pack8(o0, o1); } }
        { u32x4 cx[10], bbv[8];
#pragma unroll
          for (int j = 0; j < 10; ++j) { const int d = 2 - j; const bool ok = (s0 - d >= 0); const size_t rr = ok ? (size_t)(t0 - d) : (size_t)t0;
              cx[j] = *(const u32x4*)(U0 + rr * 1536 + 512 + c0); if (!ok) cx[j] = (u32x4){0u, 0u, 0u, 0u}; }
#pragma unroll
          for (int r = 0; r < 8; ++r) bbv[r] = *(const u32x4*)(U0 + (size_t)(t0 + r) * 1536 + 1024 + c0);
          f32x4 wv[3][2];
#pragma unroll
          for (int k = 0; k < 3; ++k) { wv[k][0] = *(const LAS f32x4*)(wB + k * DB + c0); wv[k][1] = *(const LAS f32x4*)(wB + k * DB + c0 + 4); }
#pragma unroll
          for (int r = 0; r < 8; ++r) { f32x4 a0 = {0.f, 0.f, 0.f, 0.f}, a1 = {0.f, 0.f, 0.f, 0.f};
#pragma unroll
              for (int k = 0; k < 3; ++k) { const u32x4 w = cx[r + k];
                  a0 += wv[k][0] * (f32x4){bf_lo(w.x), bf_hi(w.x), bf_lo(w.y), bf_hi(w.y)}; a1 += wv[k][1] * (f32x4){bf_lo(w.z), bf_hi(w.z), bf_lo(w.w), bf_hi(w.w)}; }
              const u32x4 bw = bbv[r];
              const f32x4 p0 = a0 * (f32x4){bf_lo(bw.x), bf_hi(bw.x), bf_lo(bw.y), bf_hi(bw.y)}, p1 = a1 * (f32x4){bf_lo(bw.z), bf_hi(bw.z), bf_lo(bw.w), bf_hi(bw.w)};
              *(u32x4*)(CAT + (size_t)(t0 + r) * D + 512 + c0) = pg8::pack8(p0, p1); } }
    }
    __syncthreads();
}

__device__ __forceinline__ void route16(const float (&l)[NE], int& e1, int& e2, float& g1, float& g2) {
    float mx = l[0];
#pragma unroll
    for (int e = 1; e < NE; ++e) mx = fmaxf(mx, l[e]);
    float p[NE];
#pragma unroll
    for (int e = 0; e < NE; ++e) p[e] = __expf(l[e] - mx);
    int gsel = 0; float best = -1.f, bq0 = 0.f, bq1 = 0.f, bq2 = 0.f, bq3 = 0.f;
#pragma unroll
    for (int g = 0; g < NG; ++g) { float m1 = -1.f, m2 = -1.f;
#pragma unroll
        for (int j = 0; j < EPG; ++j) { const float v = p[g * EPG + j]; if (v > m1) { m2 = m1; m1 = v; } else if (v > m2) m2 = v; }
        const float sc = m1 + m2; if (sc > best) { best = sc; gsel = g; bq0 = p[g * EPG]; bq1 = p[g * EPG + 1]; bq2 = p[g * EPG + 2]; bq3 = p[g * EPG + 3]; } }
    int i1 = 0; float p1 = bq0;
    if (bq1 > p1) { p1 = bq1; i1 = 1; } if (bq2 > p1) { p1 = bq2; i1 = 2; } if (bq3 > p1) { p1 = bq3; i1 = 3; }
    int i2 = -1; float p2 = -1.f;
    if (i1 != 0 && bq0 > p2) { p2 = bq0; i2 = 0; } if (i1 != 1 && bq1 > p2) { p2 = bq1; i2 = 1; } if (i1 != 2 && bq2 > p2) { p2 = bq2; i2 = 2; } if (i1 != 3 && bq3 > p2) { p2 = bq3; i2 = 3; }
    e1 = gsel * EPG + i1; e2 = gsel * EPG + i2; const float inv = 1.0f / (p1 + p2); g1 = p1 * inv; g2 = p2 * inv;
}
#ifndef P4_VAR
#define P4_VAR 0
#endif
__device__ __forceinline__ void p_ln1_route(Frame& F, int layer, const bf16_t* YPRE, bool dummy = false) {
    const int var = dummy ? P4_VAR : 0;
    F.retid();
    LAS float* wrT = (LAS float*)F.lds;
    LAS int* rt = (LAS int*)(F.lds + 65536);
    LAS int* re = rt; LAS int* rlp = rt + 128; LAS float* rg = (LAS float*)(rt + 256); LAS int* lcount = rt + 384; LAS int* gbase = rt + 400;
    { const float* wr = F.I(21);
      for (int idx = F.tid; idx < D * NE / 4; idx += NTHREADS) { const f32x4 v = *(const f32x4*)(wr + idx * 4); const int c = idx >> 2, e4 = (idx & 3) * 4;
          wrT[(e4 + 0) * D + c] = v[0]; wrT[(e4 + 1) * D + c] = v[1]; wrT[(e4 + 2) * D + c] = v[2]; wrT[(e4 + 3) * D + c] = v[3]; } }
    const float* g1p = F.I(1) + layer * D; const float* b1p = F.I(2) + layer * D; const float* br = F.I(22);
    bf16_t* X1 = F.W<bf16_t>(WS_X1); unsigned* gcount = F.ctl() + CW_GCOUNT + 32 * layer + (dummy ? 16 : 0);
    int* LIST = F.W<int>(WS_LIST); int* TOKSLOT = F.W<int>(WS_TOKSLOT); float* TOKGATE = F.W<float>(WS_TOKGATE); unsigned char* X1Q = F.W<unsigned char>(WS_X1Q); (void)X1Q;
    const int lane = F.lane;
    for (int tb = F.vcu; tb < T / 64; tb += F.G) {
        if (F.tid < NE) lcount[F.tid] = 0;
        __syncthreads();
        const int tok0 = tb * 64;
        const float brl = br[lane & 15];
#pragma unroll 1
        for (int grp = 0; grp < 2; ++grp) {
            const int rl0 = F.wave * 8 + grp * 4;
            f32x4 x[4][4]; float st[4];
#pragma unroll
            for (int r = 0; r < 4; ++r) { const bf16_t* yr = YPRE + (size_t)(tok0 + rl0 + r) * D + 4 * lane;
#pragma unroll
                for (int j = 0; j < 4; ++j) { const u32x2 w = *(const u32x2*)(yr + 256 * j); x[r][j] = (f32x4){bf_lo(w.x), bf_hi(w.x), bf_lo(w.y), bf_hi(w.y)}; } }
#pragma unroll
            for (int r = 0; r < 4; ++r) { float s_ = 0.f;
#pragma unroll
                for (int j = 0; j < 4; ++j) s_ += (x[r][j][0] + x[r][j][1]) + (x[r][j][2] + x[r][j][3]);
                st[r] = s_; }
#pragma unroll
            for (int r = 0; r < 4; ++r) st[r] = wave_sum(st[r]) * (1.0f / D);
#pragma unroll
            for (int r = 0; r < 4; ++r) { float q = 0.f;
#pragma unroll
                for (int j = 0; j < 4; ++j) { x[r][j] = x[r][j] - st[r]; q += (x[r][j][0] * x[r][j][0] + x[r][j][1] * x[r][j][1]) + (x[r][j][2] * x[r][j][2] + x[r][j][3] * x[r][j][3]); }
                st[r] = q; }
#pragma unroll
            for (int r = 0; r < 4; ++r) st[r] = 1.0f / sqrtf(wave_sum(st[r]) * (1.0f / D) + LN_EPS);
#pragma unroll
            for (int j = 0; j < 4; ++j) { const f32x4 gg = *(const f32x4*)(g1p + 256 * j + 4 * lane), bb = *(const f32x4*)(b1p + 256 * j + 4 * lane);
#pragma unroll
                for (int r = 0; r < 4; ++r) { x[r][j] = x[r][j] * st[r] * gg + bb;
                    u32x2 w; w.x = cvt_pk_bf16(x[r][j][0], x[r][j][1]); w.y = cvt_pk_bf16(x[r][j][2], x[r][j][3]);
                    *(u32x2*)(X1 + (size_t)(tok0 + rl0 + r) * D + 256 * j + 4 * lane) = w;
#if MOE_FP8
                    *(unsigned*)(X1Q + (size_t)(tok0 + rl0 + r) * D + 256 * j + 4 * lane) = pack4_fp8(x[r][j][0], x[r][j][1], x[r][j][2], x[r][j][3]);
#endif
                } }
            if (var == 1) { asm volatile("" :: "v"(x[0][0][0])); continue; }
            int zoff = 0; asm volatile("" : "+v"(zoff));
            const LAS float* wl = wrT + zoff + 4 * lane;
            float pr[4];
            {
                float lg[4][NE];
#pragma unroll
                for (int e = 0; e < NE; ++e) {
#pragma unroll
                    for (int r = 0; r < 4; ++r) lg[r][e] = 0.f;
#pragma unroll
                    for (int j = 0; j < 4; ++j) { const f32x4 w = *(const LAS f32x4*)(wl + e * D + 256 * j);
#pragma unroll
                        for (int r = 0; r < 4; ++r) lg[r][e] += (x[r][j][0] * w[0] + x[r][j][1] * w[1]) + (x[r][j][2] * w[2] + x[r][j][3] * w[3]); } }
                if (var == 2) {
#pragma unroll
                    for (int e = 0; e < NE; ++e) asm volatile("" :: "v"(lg[0][e]), "v"(lg[1][e]), "v"(lg[2][e]), "v"(lg[3][e]));
                    continue; }
#pragma unroll
                for (int r = 0; r < 4; ++r) { float a8[8], a4[4], a2[2];
#pragma unroll
                    for (int i = 0; i < 8; ++i) { const bool hi = lane & 1; const float send = hi ? lg[r][2 * i] : lg[r][2 * i + 1], keep = hi ? lg[r][2 * i + 1] : lg[r][2 * i]; a8[i] = keep + dpp_xor1(send); }
#pragma unroll
                    for (int i = 0; i < 4; ++i) { const bool hi = lane & 2; const float send = hi ? a8[2 * i] : a8[2 * i + 1], keep = hi ? a8[2 * i + 1] : a8[2 * i]; a4[i] = keep + dpp_xor2(send); }
#pragma unroll
                    for (int i = 0; i < 2; ++i) { const bool hi = lane & 4; const float send = hi ? a4[2 * i] : a4[2 * i + 1], keep = hi ? a4[2 * i + 1] : a4[2 * i]; a2[i] = keep + swz_xor<4>(send); }
                    { const bool hi = lane & 8; const float send = hi ? a2[0] : a2[1], keep = hi ? a2[1] : a2[0]; pr[r] = keep + swz_xor<8>(send); } }
            }
            float L;
            { const bool h16 = lane & 16, h32 = lane & 32;
              const float k0 = h16 ? pr[1] : pr[0], s0_ = h16 ? pr[0] : pr[1], k1 = h16 ? pr[3] : pr[2], s1_ = h16 ? pr[2] : pr[3];
              const float u0 = k0 + swz_xor<16>(s0_), u1 = k1 + swz_xor<16>(s1_);
              const float kk = h32 ? u1 : u0, ss = h32 ? u0 : u1;
              L = kk + __int_as_float(__builtin_amdgcn_ds_bpermute((lane ^ 32) << 2, __float_as_int(ss))) + brl; }
            float mx = L; mx = fmaxf(mx, dpp_xor1(mx)); mx = fmaxf(mx, dpp_xor2(mx)); mx = fmaxf(mx, swz_xor<4>(mx)); mx = fmaxf(mx, swz_xor<8>(mx));
            const float p = __expf(L - mx);
            const float q0 = __int_as_float(__builtin_amdgcn_mov_dpp(__float_as_int(p), 0x00, 0xF, 0xF, true)), q1 = __int_as_float(__builtin_amdgcn_mov_dpp(__float_as_int(p), 0x55, 0xF, 0xF, true)),
                        q2 = __int_as_float(__builtin_amdgcn_mov_dpp(__float_as_int(p), 0xAA, 0xF, 0xF, true)), q3 = __int_as_float(__builtin_amdgcn_mov_dpp(__float_as_int(p), 0xFF, 0xF, 0xF, true));
            int i1 = 0; float p1 = q0;
            if (q1 > p1) { p1 = q1; i1 = 1; } if (q2 > p1) { p1 = q2; i1 = 2; } if (q3 > p1) { p1 = q3; i1 = 3; }
            int i2 = -1; float p2 = -1.f;
            if (i1 != 0 && q0 > p2) { p2 = q0; i2 = 0; } if (i1 != 1 && q1 > p2) { p2 = q1; i2 = 1; } if (i1 != 2 && q2 > p2) { p2 = q2; i2 = 2; } if (i1 != 3 && q3 > p2) { p2 = q3; i2 = 3; }
            const int g = (lane >> 2) & 3;
            float bs_ = p1 + p2; int bg = g;
            { const float os = swz_xor<4>(bs_); const int og = __builtin_amdgcn_ds_swizzle(bg, (4 << 10) | 0x1F); if (os > bs_ || (os == bs_ && og < bg)) { bs_ = os; bg = og; } }
            { const float os = swz_xor<8>(bs_); const int og = __builtin_amdgcn_ds_swizzle(bg, (8 << 10) | 0x1F); if (os > bs_ || (os == bs_ && og < bg)) { bs_ = os; bg = og; } }
            if (var == 3) { asm volatile("" :: "v"(bg), "v"(i1), "v"(i2), "v"(p1), "v"(p2)); continue; }
            if (g == bg && (lane & 3) == 0) {
                const int rl = rl0 + (lane >> 4), e1 = 4 * g + i1, e2 = 4 * g + i2; const float inv = 1.0f / (p1 + p2);
                const int lp1 = __hip_atomic_fetch_add(lcount + e1, 1, __ATOMIC_RELAXED, __HIP_MEMORY_SCOPE_WORKGROUP), lp2 = __hip_atomic_fetch_add(lcount + e2, 1, __ATOMIC_RELAXED, __HIP_MEMORY_SCOPE_WORKGROUP);
                re[2 * rl] = e1; re[2 * rl + 1] = e2; rlp[2 * rl] = lp1; rlp[2 * rl + 1] = lp2; rg[2 * rl] = p1 * inv; rg[2 * rl + 1] = p2 * inv; }
        }
        __syncthreads();
        if (var != 0) continue;
        if (F.tid < NE) gbase[F.tid] = (int)__hip_atomic_fetch_add(gcount + F.tid, (unsigned)lcount[F.tid], RLX_AGENT);
        __syncthreads();
        if (F.tid < 128) { const int e = re[F.tid], pos = gbase[e] + rlp[F.tid], tok = tok0 + (F.tid >> 1);
            LIST[e * T + pos] = tok; TOKSLOT[tok * 2 + (F.tid & 1)] = e * T + pos; TOKGATE[tok * 2 + (F.tid & 1)] = rg[F.tid]; }
        __syncthreads();
    }
}

__device__ __forceinline__ void p_combine(Frame& F, int layer) {
    F.retid();
    const unsigned* gcount = F.ctl() + CW_GCOUNT + 32 * layer;
    const int lane = F.lane;
    int pre = 0;
#pragma unroll
    for (int j = 0; j < NE - 1; ++j) { const int cnt = (int)__builtin_amdgcn_readfirstlane(__hip_atomic_load(gcount + j, RLX_AGENT)); pre += ((lane & 15) > j) ? ((cnt + 255) >> 8) * 256 : 0; }
    const bf16_t* X1 = F.W<bf16_t>(WS_X1); const bf16_t* Y = F.W<bf16_t>(WS_Y); const int* TOKSLOT = F.W<int>(WS_TOKSLOT); const float* TOKGATE = F.W<float>(WS_TOKGATE);
    const float* g2p = F.I(3) + layer * D; const float* b2p = F.I(4) + layer * D;
    bf16_t* X2 = F.W<bf16_t>(WS_X2);
    for (int tb = F.vcu * NWAVES + F.wave; tb < T / 8; tb += F.G * NWAVES) {
#pragma unroll 2
        for (int i = 0; i < 8; ++i) { const int t = tb * 8 + i;
            const int s0 = __builtin_amdgcn_readfirstlane(TOKSLOT[2 * t]), s1 = __builtin_amdgcn_readfirstlane(TOKSLOT[2 * t + 1]);
            const float g0 = TOKGATE[2 * t], g1 = TOKGATE[2 * t + 1];
            const int r0 = __builtin_amdgcn_readlane(pre, s0 >> 14) + (s0 & (T - 1)), r1 = __builtin_amdgcn_readlane(pre, s1 >> 14) + (s1 & (T - 1));
            f32x4 v[4]; float s = 0.f;
#pragma unroll
            for (int j = 0; j < 4; ++j) { const u32x2 xw = *(const u32x2*)(X1 + (size_t)t * D + 256 * j + 4 * lane), y0 = *(const u32x2*)(Y + (size_t)r0 * D + 256 * j + 4 * lane), y1 = *(const u32x2*)(Y + (size_t)r1 * D + 256 * j + 4 * lane);
                v[j][0] = ALPHA * bf_lo(xw.x) + (g0 * bf_lo(y0.x) + g1 * bf_lo(y1.x)); v[j][1] = ALPHA * bf_hi(xw.x) + (g0 * bf_hi(y0.x) + g1 * bf_hi(y1.x));
                v[j][2] = ALPHA * bf_lo(xw.y) + (g0 * bf_lo(y0.y) + g1 * bf_lo(y1.y)); v[j][3] = ALPHA * bf_hi(xw.y) + (g0 * bf_hi(y0.y) + g1 * bf_hi(y1.y));
                s += (v[j][0] + v[j][1]) + (v[j][2] + v[j][3]); }
            const float mean = wave_sum(s) * (1.0f / D); float q = 0.f;
#pragma unroll
            for (int j = 0; j < 4; ++j) { v[j] = v[j] - mean; q += (v[j][0] * v[j][0] + v[j][1] * v[j][1]) + (v[j][2] * v[j][2] + v[j][3] * v[j][3]); }
            const float rstd = 1.0f / sqrtf(wave_sum(q) * (1.0f / D) + LN_EPS);
#pragma unroll
            for (int j = 0; j < 4; ++j) { const f32x4 gg = *(const f32x4*)(g2p + 256 * j + 4 * lane), bb = *(const f32x4*)(b2p + 256 * j + 4 * lane); const f32x4 o = v[j] * rstd * gg + bb;
                if (layer == 0) { u32x2 w; w.x = cvt_pk_bf16(o[0], o[1]); w.y = cvt_pk_bf16(o[2], o[3]); *(u32x2*)(X2 + (size_t)t * D + 256 * j + 4 * lane) = w;
#if INP_FP8_L1
                    *(unsigned*)(F.W<unsigned char>(WS_XQ) + (size_t)t * D + 256 * j + 4 * lane) = pack4_fp8(o[0], o[1], o[2], o[3]);
#endif
                }
                else *(f32x4*)(F.out + (size_t)t * D + 256 * j + 4 * lane) = o; }
        }
    }
}

__device__ __forceinline__ void p_conv4(Frame& F) {
    F.retid();
    const bf16_t* XR = F.W<bf16_t>(WS_XR); bf16_t* XC = F.W<bf16_t>(WS_XC); const float* w = F.I(13); const float* bias = F.I(14);
    const int lane = F.lane;
#pragma unroll 1
    for (int it = F.vcu * NWAVES + F.wave; it < (T / 8) * 2; it += F.G * NWAVES) {
        const int tb = it >> 1, c0 = 8 * lane + 512 * (it & 1), t0 = tb * 8, s0 = t0 & (SEQ - 1);
        f32x4 wk[CONVC][2], bs[2];
#pragma unroll
        for (int k = 0; k < CONVC; ++k) { wk[k][0] = *(const f32x4*)(w + k * DRNN + c0); wk[k][1] = *(const f32x4*)(w + k * DRNN + c0 + 4); }
        bs[0] = *(const f32x4*)(bias + c0); bs[1] = *(const f32x4*)(bias + c0 + 4);
        u32x4 in[11];
#pragma unroll
        for (int j = 0; j < 11; ++j) { const int d = 3 - j; const bool ok = (s0 - d >= 0); const size_t rr = ok ? (size_t)(t0 - d) : (size_t)t0;
            in[j] = *(const u32x4*)(XR + rr * DRNN + c0); if (!ok) in[j] = (u32x4){0u, 0u, 0u, 0u}; }
#pragma unroll
        for (int r = 0; r < 8; ++r) { f32x4 a0 = bs[0], a1 = bs[1];
#pragma unroll
            for (int k = 0; k < CONVC; ++k) { const u32x4 xw = in[r + k];
                a0 += wk[k][0] * (f32x4){bf_lo(xw.x), bf_hi(xw.x), bf_lo(xw.y), bf_hi(xw.y)}; a1 += wk[k][1] * (f32x4){bf_lo(xw.z), bf_hi(xw.z), bf_lo(xw.w), bf_hi(xw.w)}; }
            *(u32x4*)(XC + (size_t)(t0 + r) * DRNN + c0) = pg8::pack8(a0, a1); }
    }
}

constexpr int SCH = 64, NCHUNK = SEQ / SCH;
__device__ __forceinline__ void p_scan1(Frame& F) {
    F.retid();
    const bf16_t* L2A = F.W<bf16_t>(WS_XR); const bf16_t* BV = F.W<bf16_t>(WS_BV); float* AGG = F.W<float>(WS_AGG);
    for (int task = F.vcu * NWAVES + F.wave; task < BATCH * NCHUNK * 8; task += F.G * NWAVES) {
        const int bc = task >> 3, c = (task & 7) * 128 + 2 * F.lane; const size_t base = (size_t)bc * SCH * DRNN + c;
        float sl0 = 0.f, sl1 = 0.f, h0 = 0.f, h1 = 0.f;
#pragma unroll 16
        for (int s = 0; s < SCH; ++s) { const unsigned lw = *(const unsigned*)(L2A + base + (size_t)s * DRNN), bw = *(const unsigned*)(BV + base + (size_t)s * DRNN);
            const float l0 = bf_lo(lw), l1 = bf_hi(lw); sl0 += l0; sl1 += l1;
            h0 = __builtin_amdgcn_exp2f(l0) * h0 + bf_lo(bw); h1 = __builtin_amdgcn_exp2f(l1) * h1 + bf_hi(bw); }
        *(f32x4*)(AGG + ((size_t)bc * DRNN + c) * 2) = (f32x4){sl0, h0, sl1, h1};
    }
}
__device__ __forceinline__ void p_scan2(Frame& F, bool dummy = false) {
    F.retid();
    const bf16_t* L2A = F.W<bf16_t>(WS_XR); const bf16_t* BV = F.W<bf16_t>(WS_BV); const float* AGG = F.W<float>(WS_AGG); bf16_t* GY = F.W<bf16_t>(WS_GY); bf16_t* OUTB = dummy ? F.W<bf16_t>(WS_XC) : GY;
#pragma unroll 1
    for (int task = F.vcu * NWAVES + F.wave; task < BATCH * NCHUNK * 8; task += F.G * NWAVES) {
        const int bc = task >> 3, c = (task & 7) * 128 + 2 * F.lane; const int b = bc / NCHUNK, ch = bc % NCHUNK;
        float h0 = 0.f, h1 = 0.f;
#pragma unroll 1
        for (int j0 = 0; j0 < ch; j0 += 16) { f32x4 g[16];
#pragma unroll
            for (int i = 0; i < 16; ++i) { const int j = j0 + i; const int jc = j < ch ? j : ch - 1; g[i] = *(const f32x4*)(AGG + ((size_t)(b * NCHUNK + jc) * DRNN + c) * 2); if (j >= ch) g[i] = (f32x4){0.f, 0.f, 0.f, 0.f}; }
#pragma unroll
            for (int i = 0; i < 16; ++i) { h0 = __builtin_amdgcn_exp2f(g[i][0]) * h0 + g[i][1]; h1 = __builtin_amdgcn_exp2f(g[i][2]) * h1 + g[i][3]; } }
        const size_t base = (size_t)bc * SCH * DRNN + c;
#pragma unroll 1
        for (int s0 = 0; s0 < SCH; s0 += 16) { unsigned lw[16], bw[16], gw[16];
#pragma unroll
            for (int i = 0; i < 16; ++i) { const size_t o = base + (size_t)(s0 + i) * DRNN; lw[i] = *(const unsigned*)(L2A + o); bw[i] = *(const unsigned*)(BV + o); gw[i] = *(const unsigned*)(GY + o); }
#pragma unroll
            for (int i = 0; i < 16; ++i) { h0 = __builtin_amdgcn_exp2f(bf_lo(lw[i])) * h0 + bf_lo(bw[i]); h1 = __builtin_amdgcn_exp2f(bf_hi(lw[i])) * h1 + bf_hi(bw[i]);
                gw[i] = cvt_pk_bf16(bf_lo(gw[i]) * h0, bf_hi(gw[i]) * h1); }
#pragma unroll
            for (int i = 0; i < 16; ++i) *(unsigned*)(OUTB + base + (size_t)(s0 + i) * DRNN) = gw[i]; }
    }
}

constexpr int NPH = 18;
#ifndef N_LAUNCHES
#define N_LAUNCHES 1
#endif
__global__ void __launch_bounds__(NTHREADS, 2) mega_fwd(Args args) {
    extern __shared__ __attribute__((aligned(16))) unsigned char lds_raw[];
    Frame F;
    F.lds = (LAS unsigned char*)lds_raw; F.ws = args.ws; F.in = args.in; F.out = args.out;
    F.tid = threadIdx.x; F.lane = F.tid & 63; F.wave = __builtin_amdgcn_readfirstlane(F.tid >> 6);
    F.G = gridDim.x; { const int bx = blockIdx.x; F.vcu = (F.G % 8 == 0) ? (bx % 8) * (F.G / 8) + bx / 8 : bx; }
    for (int u = F.tid; u < (LDS_BYTES - LDSCTL_OFF) / 4; u += NTHREADS) ((LAS unsigned*)(F.lds + LDSCTL_OFF))[u] = 0u;
    __syncthreads();
    XcdBarrier bar; bar.bar = F.ctl() + CW_BAR; bar.x = 0; bar.st = nullptr; bar.wave = F.wave;
    if (N_LAUNCHES == 1) bar = xcd_barrier_post(F.ctl() + CW_BAR, (volatile LAS unsigned*)(F.lds + MISC_OFF) + 8, F.wave);
    const int lo = args.ph_lo, hi = args.ph_hi;
#ifndef PH_MASK
#define PH_MASK 0x3ffff
#endif
#define IN(k) (((PH_MASK >> (k)) & 1) && lo <= (k) && (k) < hi)
#define SEAM(k) do { if (IN(k) && IN((k) + 1)) xcd_barrier(bar); } while (0)
    const int cblk = (int)blockIdx.x;

#ifndef REP_MASK
#define REP_MASK 0
#endif
#ifndef EXTRA_BARS
#define EXTRA_BARS 0
#endif
#define REPS(k) ((((REP_MASK) >> ((k) % 32)) & 1) ? 2 : 1)
#define PHASE(k, ...) do { if (IN(k)) { for (int rep_ = 0; rep_ < REPS(k); ++rep_) { __VA_ARGS__; if (rep_ + 1 < REPS(k)) xcd_barrier(bar); } } SEAM(k); } while (0)
    for (int i = 0; i < EXTRA_BARS; ++i) xcd_barrier(bar);
    PHASE(0, p0_prologue(F));
#if INP_FP8_L0
    PHASE(1, { DenseOrder S{F.W<char>(WS_XQ), F.W<char>(WS_WIN0), (size_t)256 * D, (size_t)256 * D, T / 256, DIN0 / 256, F.G, cblk};
        pg8::EpiIn0 E{F.W<bf16_t>(WS_U0)}; pg8::gemm_phase<pg8::EpiIn0, DenseOrder, false, 1>(F.lds, F.wave, D, D, D, S, E, 0x01010101 * (127 - SCL_WIN / 2)); });
#else
    PHASE(1, { DenseOrder S{F.W<char>(WS_XB), F.W<char>(WS_WIN0), (size_t)256 * D * 2, (size_t)256 * D * 2, T / 256, DIN0 / 256, F.G, cblk};
        pg8::EpiIn0 E{F.W<bf16_t>(WS_U0)}; pg8::gemm_phase<pg8::EpiIn0, DenseOrder, false>(F.lds, F.wave, 2 * D, 2 * D, 2 * D, S, E); });
#endif
    PHASE(2, p_mix0(F));
    PHASE(3, { DenseOrder S{F.W<char>(WS_CAT0), F.W<char>(WS_WOUT0), (size_t)256 * D * 2, (size_t)256 * D * 2, T / 256, D / 256, F.G, cblk};
        pg8::EpiRes E{F.W<bf16_t>(WS_XB), F.W<bf16_t>(WS_YPRE0)}; pg8::gemm_phase<pg8::EpiRes, DenseOrder, false>(F.lds, F.wave, 2 * D, 2 * D, 2 * D, S, E); });
    PHASE(4, p_ln1_route(F, 0, F.W<bf16_t>(WS_YPRE0), rep_ + 1 < REPS(4)));
#pragma unroll 1
    for (int layer = 0; layer < 2; ++layer) {
        const int pb = layer == 0 ? 5 : 15;
#if MOE_FP8
        PHASE(pb, { const int nu = moe_setup(F, layer, 2 * DEXP / 256, true, D);
            MoeOrder S{(LAS const int*)(F.lds + UNITS_OFF), nu, F.W<char>(WS_X1Q), F.W<char>(WS_W13) + (size_t)layer * NE * 2 * DEXP * D, (size_t)2 * DEXP * D, (size_t)256 * D, 0, true};
            pg8::EpiMoe1Q E{F.W<unsigned char>(WS_H)}; pg8::gemm_phase<pg8::EpiMoe1Q, MoeOrder, true, 1>(F.lds, F.wave, D, D, D, S, E, 0x01010101 * (127 - SCL_W13 / 2)); });
        PHASE(pb + 1, { const int nu = moe_setup(F, layer, D / 256, false, 0);
            MoeOrder S{(LAS const int*)(F.lds + UNITS_OFF), nu, F.W<char>(WS_H), F.W<char>(WS_W2) + (size_t)layer * NE * D * DEXP, (size_t)D * DEXP, (size_t)256 * DEXP, (size_t)256 * DEXP, false};
            pg8::EpiMoe2 E{F.W<bf16_t>(WS_Y)}; pg8::gemm_phase<pg8::EpiMoe2, MoeOrder, false, 1>(F.lds, F.wave, DEXP, DEXP, DEXP, S, E, 0x01010101 * (127 - SCL_W2 / 2)); });
#else
        PHASE(pb, { const int nu = moe_setup(F, layer, 2 * DEXP / 256, true, 2 * D);
            MoeOrder S{(LAS const int*)(F.lds + UNITS_OFF), nu, F.W<char>(WS_X1), F.W<char>(WS_W13) + (size_t)layer * NE * 2 * DEXP * D * 2, (size_t)2 * DEXP * D * 2, (size_t)256 * D * 2, 0, true};
            pg8::EpiMoe1 E{F.W<bf16_t>(WS_H)}; pg8::gemm_phase<pg8::EpiMoe1, MoeOrder, true>(F.lds, F.wave, 2 * D, 2 * D, 2 * D, S, E); });
        PHASE(pb + 1, { const int nu = moe_setup(F, layer, D / 256, false, 0);
            MoeOrder S{(LAS const int*)(F.lds + UNITS_OFF), nu, F.W<char>(WS_H), F.W<char>(WS_W2) + (size_t)layer * NE * D * DEXP * 2, (size_t)D * DEXP * 2, (size_t)256 * DEXP * 2, (size_t)256 * DEXP * 2, false};
            pg8::EpiMoe2 E{F.W<bf16_t>(WS_Y)}; pg8::gemm_phase<pg8::EpiMoe2, MoeOrder, false>(F.lds, F.wave, 2 * DEXP, 2 * DEXP, 2 * DEXP, S, E); });
#endif
        PHASE(pb + 2, p_combine(F, layer));
        if (layer == 0) {
#if INP_FP8_L1
            PHASE(8, { DenseOrder S{F.W<char>(WS_XQ), F.W<char>(WS_WIN1), (size_t)256 * D, (size_t)256 * D, T / 256, 2 * DRNN / 256, F.G, cblk};
                pg8::EpiIn1 E{F.W<bf16_t>(WS_GY), F.W<bf16_t>(WS_XR)}; pg8::gemm_phase<pg8::EpiIn1, DenseOrder, false, 1>(F.lds, F.wave, D, D, D, S, E, 0x01010101 * (127 - SCL_WIN / 2)); });
#else
            PHASE(8, { DenseOrder S{F.W<char>(WS_X2), F.W<char>(WS_WIN1), (size_t)256 * D * 2, (size_t)256 * D * 2, T / 256, 2 * DRNN / 256, F.G, cblk};
                pg8::EpiIn1 E{F.W<bf16_t>(WS_GY), F.W<bf16_t>(WS_XR)}; pg8::gemm_phase<pg8::EpiIn1, DenseOrder, false>(F.lds, F.wave, 2 * D, 2 * D, 2 * D, S, E); });
#endif
            PHASE(9, p_conv4(F));
            PHASE(10, { GatesOrder S{F.W<char>(WS_XC), F.W<char>(WS_WGT), F.G, cblk};
                pg8::EpiGates E{F.W<bf16_t>(WS_XC), F.I(16), F.I(18), F.W<float>(WS_SPL), F.W<bf16_t>(WS_XR), F.W<bf16_t>(WS_BV)};
                pg8::gemm_phase<pg8::EpiGates, GatesOrder, false>(F.lds, F.wave, 2 * DRNN, 2 * RBLK, 2 * RBLK, S, E); });
            PHASE(11, p_scan1(F));
            PHASE(12, p_scan2(F, rep_ + 1 < REPS(12)));
            PHASE(13, { DenseOrder S{F.W<char>(WS_GY), F.W<char>(WS_WOUT1), (size_t)256 * DRNN * 2, (size_t)256 * DRNN * 2, T / 256, D / 256, F.G, cblk};
                pg8::EpiRes E{F.W<bf16_t>(WS_X2), F.W<bf16_t>(WS_YPRE1)}; pg8::gemm_phase<pg8::EpiRes, DenseOrder, false>(F.lds, F.wave, 2 * DRNN, 2 * DRNN, 2 * DRNN, S, E); });
            PHASE(14, p_ln1_route(F, 1, F.W<bf16_t>(WS_YPRE1), rep_ + 1 < REPS(14)));
        }
    }
#undef PHASE
#undef REPS
#undef IN
#undef SEAM
}

static int g_grid = 0;
static inline bool fast_setup() {
    if (g_grid == 0) {
        int dev = 0, cus = 0, per_cu = 0;
        if (hipGetDevice(&dev) != hipSuccess || hipDeviceGetAttribute(&cus, hipDeviceAttributeMultiprocessorCount, dev) != hipSuccess) { fprintf(stderr, "kernel_launch: device query failed\n"); g_grid = -1; return false; }
        if (hipFuncSetAttribute((const void*)mega_fwd, hipFuncAttributeMaxDynamicSharedMemorySize, LDS_BYTES) != hipSuccess) { fprintf(stderr, "kernel_launch: hipFuncSetAttribute failed\n"); g_grid = -1; return false; }
        if (hipOccupancyMaxActiveBlocksPerMultiprocessor(&per_cu, (const void*)mega_fwd, NTHREADS, LDS_BYTES) != hipSuccess || per_cu < 1) { fprintf(stderr, "kernel_launch: occupancy query says %d blocks per CU\n", per_cu); (void)hipGetLastError(); per_cu = 1; }
        g_grid = cus;
        if (g_grid > 256) g_grid = 256;
    }
    return g_grid > 0;
}
static inline void fast_launch(void* const* d_in, void* d_out, void* d_ws, hipStream_t stream, int lo, int hi) {
    Args a{};
    for (int i = 0; i < 26; ++i) a.in[i] = (const float*)d_in[i];
    a.out = (float*)d_out; a.ws = (unsigned char*)d_ws; a.ph_lo = lo; a.ph_hi = hi;
    hipLaunchKernelGGL(mega_fwd, dim3(g_grid), dim3(NTHREADS), LDS_BYTES, stream, a);
}
extern "C" void kernel_launch(void* const* d_in, const int* in_sizes, int n_in, void* d_out, int out_size, void* d_ws, size_t ws_size, hipStream_t stream) {
    if (n_in != 26 || out_size != T * D || ws_size < WS_FAST_END) { fprintf(stderr, "kernel_launch: unexpected shapes (n_in %d out %d ws %zu)\n", n_in, out_size, ws_size); return; }
    if (!fast_setup()) return;
    if (hipMemsetAsync((char*)d_ws + WS_CTL, 0, CTL_ZERO_BYTES, stream) != hipSuccess) { fprintf(stderr, "kernel_launch: memset failed\n"); return; }
    if (N_LAUNCHES == 1) fast_launch(d_in, d_out, d_ws, stream, 0, NPH);
    else for (int p = 0; p < NPH; ++p) fast_launch(d_in, d_out, d_ws, stream, p, p + 1);
}
```

```cpp
#define BUILD_MODE 1
#define N_LAUNCHES 1
#include <hip/hip_runtime.h>
#include <cstdio>
#include <cstdint>
#include <cmath>
constexpr int D = 1024, BATCH = 2, SEQ = 8192, T = BATCH * SEQ, DEPTH = 2;
constexpr int DA = 512, DB = 512, DIN0 = 2 * DA + 3 * DB, CONVA = 31, CONVB = 3;
constexpr int DRNN = 1024, RBLK = 256, RHEADS = 4, CONVC = 4;
constexpr int NE = 16, NG = 4, EPG = 4, DEXP = 1024;
constexpr float LN_EPS = 1e-5f, ALPHA = 1.41421356237309515f;
#define LAS __attribute__((address_space(3)))
#define GAS __attribute__((address_space(1)))
typedef unsigned short bf16_t;
typedef short bf16x8 __attribute__((ext_vector_type(8)));
typedef float f32x4 __attribute__((ext_vector_type(4)));
typedef float f32x2 __attribute__((ext_vector_type(2)));
typedef unsigned u32x4 __attribute__((ext_vector_type(4)));
typedef unsigned u32x2 __attribute__((ext_vector_type(2)));
typedef GAS unsigned gu32;
#define RLX_AGENT __ATOMIC_RELAXED, __HIP_MEMORY_SCOPE_AGENT
#define LDS_WAIT() asm volatile("s_waitcnt lgkmcnt(0)" ::: "memory")
#define VM_WAIT() asm volatile("s_waitcnt vmcnt(0)" ::: "memory")

__device__ __forceinline__ unsigned cvt_pk_bf16(float lo, float hi) { unsigned r; asm volatile("v_cvt_pk_bf16_f32 %0, %1, %2" : "=v"(r) : "v"(lo), "v"(hi)); return r; }
__device__ __forceinline__ unsigned pack4_fp8(float a, float b, float c, float d) { int r = __builtin_amdgcn_cvt_pk_fp8_f32(a, b, 0, false); r = __builtin_amdgcn_cvt_pk_fp8_f32(c, d, r, true); return (unsigned)r; }
__device__ __forceinline__ size_t lb_off(int row, int col) { return ((((size_t)(row >> 6) * 8 + (col >> 7)) * 64 + (row & 63)) * 128) + (col & 127); }
__device__ __forceinline__ float bf_lo(unsigned u) { return __uint_as_float(u << 16); }
__device__ __forceinline__ float bf_hi(unsigned u) { return __uint_as_float(u & 0xffff0000u); }
__device__ __forceinline__ float fsigmoid(float x) { return __builtin_amdgcn_rcpf(1.0f + __builtin_amdgcn_exp2f(-1.4426950408889634f * x)); }
__device__ __forceinline__ float fsilu(float x) { return x * fsigmoid(x); }
__device__ __forceinline__ float fgelu_tanh(float x) { return x * fsigmoid(1.5957691216057308f * (x + 0.044715f * x * x * x)); }
__device__ __forceinline__ float dpp_xor1(float v) { return __int_as_float(__builtin_amdgcn_mov_dpp(__float_as_int(v), 0xB1, 0xF, 0xF, true)); }
__device__ __forceinline__ float dpp_xor2(float v) { return __int_as_float(__builtin_amdgcn_mov_dpp(__float_as_int(v), 0x4E, 0xF, 0xF, true)); }
template <int M> __device__ __forceinline__ float swz_xor(float v) { return __int_as_float(__builtin_amdgcn_ds_swizzle(__float_as_int(v), (M << 10) | 0x1F)); }
__device__ __forceinline__ float half_sum(float v) { const auto r = __builtin_amdgcn_permlane32_swap(__float_as_uint(v), __float_as_uint(v), false, false); return __uint_as_float(r[0]) + __uint_as_float(r[1]); }
__device__ __forceinline__ float wave_sum(float v) { v += dpp_xor1(v); v += dpp_xor2(v); v += swz_xor<4>(v); v += swz_xor<8>(v); v += swz_xor<16>(v); return half_sum(v); }
__device__ __forceinline__ int lane_id_asm() { int l; asm volatile("v_mbcnt_lo_u32_b32 %0, -1, 0\n\tv_mbcnt_hi_u32_b32 %0, -1, %0" : "=v"(l)); return l; }

namespace pg8 {
constexpr int BM = 256, BK = 64, HALF = 128, HTB = HALF * BK * 2, STAGE_BYTES = 8 * HTB, NXCD = 8, WGM = 8;
__host__ __device__ __forceinline__ int lds_byte(int r, int c) { const int st = (r >> 4) * 2 + (c >> 5), rr = r & 15, cc = c & 31, ob = rr * 64 + cc * 2; return st * 1024 + (ob ^ (((ob >> 9) & 1) << 5)); }
__host__ __device__ __forceinline__ void stage_rc(int b, int& R, int& C) { const int st = b / 1024, sb = b % 1024, swz = sb ^ (((sb >> 9) & 1) << 5); R = (st >> 1) * 16 + swz / 64; C = (st & 1) * 32 + (swz % 64) / 2; }
__host__ __device__ __forceinline__ int perm32(int rho) { const int n = rho >> 4, i = rho & 15; return 8 * (i >> 2) + 4 * n + (i & 3); }

struct Unit { const char* A; const char* B; int row0, pn, e, gtab; };
__device__ __forceinline__ bool tile_of(int i, int G, int c, int nM, int nN, int& pm, int& pn) {
    const int nwg = nM * nN; const long L = (long)i * G + c; if (L >= nwg) return false;
    int wgid = (int)L; { const int q = nwg / NXCD, r = nwg % NXCD, xcd = wgid % NXCD, off = wgid / NXCD; wgid = (xcd < r ? xcd * (q + 1) : r * (q + 1) + (xcd - r) * q) + off; }
    const int nig = WGM * nN, gid = wgid / nig, fm = gid * WGM, gsz = (nM - fm) < WGM ? (nM - fm) : WGM;
    pm = fm + ((wgid % nig) % gsz); pn = (wgid % nig) / gsz; return true;
}

typedef int i32x8 __attribute__((ext_vector_type(8)));
typedef int i32x4 __attribute__((ext_vector_type(4)));
template <class Epi, class Sched, bool GATHER, int FMT = 0>
__device__ __forceinline__ void gemm_phase(LAS unsigned char* lds, const int wid_in, const int lda, const int ldb, const int KB, const Sched& S, const Epi& E, const int sclb = 0x7f7f7f7f) {
    const int lane = lane_id_asm(), wid = wid_in, tid = wid * 64 + lane, wr = wid >> 2, wc = wid & 3, fr = lane & 15, fq = lane >> 4;
    const int nt = KB / 128;
    int sclr = sclb; if constexpr (FMT == 1) asm volatile("" : "+v"(sclr));
    unsigned voffA[2], voffB[2];
#pragma unroll
    for (int i = 0; i < 2; ++i) { int R, C; stage_rc(tid * 16 + i * 8192, R, C); const int Rb = Epi::PERM ? ((R & ~31) + perm32(R & 31)) : R;
        voffA[i] = (unsigned)(R * lda + C * 2); voffB[i] = (unsigned)(Rb * ldb + C * 2); }
    const size_t kstep = (size_t)(BK * 2);
    const size_t hstepA = (size_t)HALF * lda, hstepB = (size_t)HALF * ldb;
    const unsigned ldsw = (unsigned)wid * 1024u;
    const int aoff = lds_byte(wr * 64 + fr, fq * 8), boff = lds_byte(wc * 32 + fr, fq * 8);
#define PG8_SA(b, h) (((b) * 2 + (h)) * HTB)
#define PG8_SB(b, h) ((4 + (b) * 2 + (h)) * HTB)
#define PG8_ST2(bufoff, gbase, o0, o1) do { \
        __builtin_amdgcn_global_load_lds((const unsigned*)((const char*)(gbase) + (o0)), (LAS unsigned*)(lds + (bufoff) + ldsw), 16, 0, 0); \
        __builtin_amdgcn_global_load_lds((const unsigned*)((const char*)(gbase) + (o1)), (LAS unsigned*)(lds + (bufoff) + ldsw + 8192), 16, 0, 0); } while (0)
#define PG8_STB(bufoff, gbase, h) PG8_ST2(bufoff, (gbase) + (h) * hstepB, voffB[0], voffB[1])
#define PG8_STA(bufoff, gbase, h, G0, G1) do { if constexpr (GATHER) { PG8_ST2(bufoff, gbase, G0, G1); } else { PG8_ST2(bufoff, (gbase) + (h) * hstepA, voffA[0], voffA[1]); } } while (0)
#define PG8_CAT8(l_, h_) __builtin_shufflevector(l_, h_, 0, 1, 2, 3, 4, 5, 6, 7)
#define PG8_LO4(v_) __builtin_bit_cast(bf16x8, __builtin_shufflevector(v_, v_, 0, 1, 2, 3))
#define PG8_HI4(v_) __builtin_bit_cast(bf16x8, __builtin_shufflevector(v_, v_, 4, 5, 6, 7))
#define PG8_LDA(dst, b, h) do { _Pragma("unroll") for (int m = 0; m < 4; ++m) { const i32x4 l_ = *(const LAS i32x4*)(lds + PG8_SA(b, h) + aoff + m * 2048), h_ = *(const LAS i32x4*)(lds + PG8_SA(b, h) + aoff + m * 2048 + 1024); dst[m] = PG8_CAT8(l_, h_); } } while (0)
#define PG8_LDB(dst, b, h) do { _Pragma("unroll") for (int n = 0; n < 2; ++n) { const i32x4 l_ = *(const LAS i32x4*)(lds + PG8_SB(b, h) + boff + n * 2048), h_ = *(const LAS i32x4*)(lds + PG8_SB(b, h) + boff + n * 2048 + 1024); dst[n] = PG8_CAT8(l_, h_); } } while (0)
#define PG8_MMA(ai, bj, At, Bt) do { __builtin_amdgcn_s_setprio(1); _Pragma("unroll") for (int m = 0; m < 4; ++m) _Pragma("unroll") for (int n = 0; n < 2; ++n) { \
        if constexpr (FMT == 0) { acc[ai][bj][m][n] = __builtin_amdgcn_mfma_f32_16x16x32_bf16(PG8_LO4(Bt[n]), PG8_LO4(At[m]), acc[ai][bj][m][n], 0, 0, 0); \
                                  acc[ai][bj][m][n] = __builtin_amdgcn_mfma_f32_16x16x32_bf16(PG8_HI4(Bt[n]), PG8_HI4(At[m]), acc[ai][bj][m][n], 0, 0, 0); } \
        else asm volatile("v_mfma_scale_f32_16x16x128_f8f6f4 %0, %1, %2, %0, %3, %3 op_sel_hi:[0,0,0]" : "+v"(acc[ai][bj][m][n]) : "v"(Bt[n]), "v"(At[m]), "v"(sclr)); } \
        __builtin_amdgcn_s_setprio(0); } while (0)
#define PG8_WAIT_V(n) asm volatile("s_waitcnt vmcnt(" #n ")" ::: "memory")
#define PG8_WAIT_L(n) asm volatile("s_waitcnt lgkmcnt(" #n ")" ::: "memory")
#define PG8_BAR __builtin_amdgcn_s_barrier()
#define PG8_SCHED __builtin_amdgcn_sched_barrier(0)
    Unit cur, nxt; int ui = 0;
    if (!S.next(0, cur)) return;
    f32x4 acc[2][2][4][2];
#pragma unroll
    for (int a = 0; a < 2; ++a)
#pragma unroll
        for (int b = 0; b < 2; ++b)
#pragma unroll
            for (int m = 0; m < 4; ++m)
#pragma unroll
                for (int n = 0; n < 2; ++n) acc[a][b][m][n] = (f32x4){0.f, 0.f, 0.f, 0.f};
    i32x8 At[4], B0[2], B1[2];
    unsigned gc[2][2] = {{0u, 0u}, {0u, 0u}};
    if constexpr (GATHER) {
#pragma unroll
        for (int i = 0; i < 2; ++i) { int R, C; stage_rc(tid * 16 + i * 8192, R, C);
#pragma unroll
            for (int h = 0; h < 2; ++h) gc[h][i] = *(const LAS unsigned*)(lds + cur.gtab + (h * HALF + R) * 4) + (unsigned)C * 2u; }
    }
    const char* cA = cur.A; const char* cB = cur.B;
    PG8_STB(PG8_SB(0, 0), cB, 0); PG8_STB(PG8_SB(0, 1), cB, 1); PG8_STA(PG8_SA(0, 0), cA, 0, gc[0][0], gc[0][1]); PG8_STA(PG8_SA(0, 1), cA, 1, gc[1][0], gc[1][1]);
    if (wr == 1) PG8_BAR;
    PG8_WAIT_V(2); PG8_BAR;
    PG8_STB(PG8_SB(1, 0), cB + kstep, 0); PG8_STA(PG8_SA(1, 0), cA + kstep, 0, gc[0][0], gc[0][1]); PG8_STB(PG8_SB(1, 1), cB + kstep, 1);
    PG8_WAIT_V(6); PG8_BAR;
#define PG8_KITER(a1_, a2_, b2_, G00, G01, G10, G11) do { \
            const char* a3_ = (a2_) + kstep; const char* b3_ = (b2_) + kstep; \
              \
            PG8_LDB(B0, 0, 0); PG8_LDB(B1, 0, 1); PG8_SCHED; PG8_LDA(At, 0, 0); PG8_STA(PG8_SA(1, 1), a1_, 1, gc[1][0], gc[1][1]); \
            PG8_WAIT_V(8); PG8_WAIT_L(0); PG8_BAR; PG8_MMA(0, 0, At, B0); PG8_MMA(0, 1, At, B1); PG8_BAR; PG8_SCHED; \
              \
            PG8_LDA(At, 0, 1); PG8_STB(PG8_SB(0, 0), b2_, 0); PG8_STB(PG8_SB(0, 1), b2_, 1); PG8_STA(PG8_SA(0, 0), a2_, 0, G00, G01); \
            PG8_WAIT_V(8); PG8_WAIT_L(0); PG8_BAR; PG8_MMA(1, 0, At, B0); PG8_MMA(1, 1, At, B1); PG8_BAR; PG8_SCHED; \
              \
            PG8_LDB(B0, 1, 0); PG8_LDB(B1, 1, 1); PG8_SCHED; PG8_LDA(At, 1, 0); PG8_STA(PG8_SA(0, 1), a2_, 1, G10, G11); \
            PG8_WAIT_V(8); PG8_WAIT_L(0); PG8_BAR; PG8_MMA(0, 0, At, B0); PG8_MMA(0, 1, At, B1); PG8_BAR; PG8_SCHED; \
              \
            PG8_LDA(At, 1, 1); PG8_STB(PG8_SB(1, 0), b3_, 0); PG8_STB(PG8_SB(1, 1), b3_, 1); PG8_STA(PG8_SA(1, 0), a3_, 0, G00, G01); \
            PG8_WAIT_V(8); PG8_WAIT_L(0); PG8_BAR; PG8_MMA(1, 0, At, B0); PG8_MMA(1, 1, At, B1); PG8_BAR; PG8_SCHED; } while (0)
    for (;;) {
        const bool has_next = S.next(ui + 1, nxt);
        const char* nA = has_next ? nxt.A : cA; const char* nB = has_next ? nxt.B : cB;
        if constexpr (!GATHER) {
#pragma unroll 1
            for (int t = 0; t < nt; t += 2) {
                const bool last = (t == nt - 2);
                const char* a1 = cA + (size_t)(t + 1) * kstep;
                const char* a2 = last ? nA : cA + (size_t)(t + 2) * kstep; const char* b2 = last ? nB : cB + (size_t)(t + 2) * kstep;
                PG8_KITER(a1, a2, b2, 0u, 0u, 0u, 0u);
            }
        } else {
#pragma unroll 1
            for (int t = 0; t < nt - 2; t += 2) {
                const char* a1 = cA + (size_t)(t + 1) * kstep; const char* a2 = cA + (size_t)(t + 2) * kstep; const char* b2 = cB + (size_t)(t + 2) * kstep;
                PG8_KITER(a1, a2, b2, gc[0][0], gc[0][1], gc[1][0], gc[1][1]);
            }
            unsigned gn[2][2] = {{gc[0][0], gc[0][1]}, {gc[1][0], gc[1][1]}};
            if (has_next) {
                const int tid2 = wid * 64 + lane_id_asm();
#pragma unroll
                for (int i = 0; i < 2; ++i) { int R, C; stage_rc(tid2 * 16 + i * 8192, R, C);
#pragma unroll
                    for (int h = 0; h < 2; ++h) gn[h][i] = *(const LAS unsigned*)(lds + nxt.gtab + (h * HALF + R) * 4) + (unsigned)C * 2u; } }
            const char* a1 = cA + (size_t)(nt - 1) * kstep;
            PG8_KITER(a1, nA, nB, gn[0][0], gn[0][1], gn[1][0], gn[1][1]);
            gc[0][0] = gn[0][0]; gc[0][1] = gn[0][1]; gc[1][0] = gn[1][0]; gc[1][1] = gn[1][1];
        }
        if (wr == 0) PG8_BAR;
        if constexpr (FMT == 1) asm volatile("s_nop 15\n\ts_nop 15" ::: "memory");
        if constexpr (GATHER) { int fr2 = fr, fq2 = fq; asm volatile("" : "+v"(fr2), "+v"(fq2));
            E(acc, cur, wr, wc, fr2, fq2); }
        else E(acc, cur, wr, wc, fr, fq);
        if (!has_next) break;
#pragma unroll
        for (int a = 0; a < 2; ++a)
#pragma unroll
            for (int b = 0; b < 2; ++b)
#pragma unroll
                for (int m = 0; m < 4; ++m)
#pragma unroll
                    for (int n = 0; n < 2; ++n) acc[a][b][m][n] = (f32x4){0.f, 0.f, 0.f, 0.f};
        cur = nxt; cA = nA; cB = nB; ++ui;
        if (wr == 1) PG8_BAR;
    }
    PG8_WAIT_V(0);
    PG8_BAR;
#undef PG8_SA
#undef PG8_SB
#undef PG8_ST2
#undef PG8_STB
#undef PG8_STA
#undef PG8_LDA
#undef PG8_CAT8
#undef PG8_LO4
#undef PG8_HI4
#undef PG8_LDB
#undef PG8_MMA
#undef PG8_WAIT_V
#undef PG8_WAIT_L
#undef PG8_BAR
#undef PG8_SCHED
#undef PG8_KITER
}

typedef f32x4 AccT[2][2][4][2];
__device__ __forceinline__ u32x4 pack8(const f32x4 a, const f32x4 b) { u32x4 w; w.x = cvt_pk_bf16(a[0], a[1]); w.y = cvt_pk_bf16(a[2], a[3]); w.z = cvt_pk_bf16(b[0], b[1]); w.w = cvt_pk_bf16(b[2], b[3]); return w; }
template <int ACT> __device__ __forceinline__ void store_plain(const AccT& acc, bf16_t* O, int ldo, int row0, int col0, int wr, int wc, int fr, int fq) {
#pragma unroll
    for (int ai = 0; ai < 2; ++ai)
#pragma unroll
        for (int m = 0; m < 4; ++m) { bf16_t* rowp = O + (size_t)(row0 + ai * HALF + wr * 64 + m * 16 + fr) * ldo + col0 + wc * 32 + 8 * fq;
#pragma unroll
            for (int bj = 0; bj < 2; ++bj) { f32x4 v0 = acc[ai][bj][m][0], v1 = acc[ai][bj][m][1];
                if (ACT == 1) {
#pragma unroll
                    for (int j = 0; j < 4; ++j) { v0[j] = fgelu_tanh(v0[j]); v1[j] = fgelu_tanh(v1[j]); } }
                *(u32x4*)(rowp + bj * HALF) = pack8(v0, v1); } }
}
template <int MODE> __device__ __forceinline__ void store_pair(const AccT& acc, bf16_t* O, int ldo, int row0, int col0, int wr, int wc, int fr, int fq) {
#pragma unroll
    for (int ai = 0; ai < 2; ++ai)
#pragma unroll
        for (int m = 0; m < 4; ++m) { bf16_t* rowp = O + (size_t)(row0 + ai * HALF + wr * 64 + m * 16 + fr) * ldo + col0 + wc * 32 + 8 * fq;
            f32x4 o[2];
#pragma unroll
            for (int n = 0; n < 2; ++n) { const f32x4 v = acc[ai][0][m][n], g = acc[ai][1][m][n];
#pragma unroll
                for (int j = 0; j < 4; ++j) o[n][j] = MODE == 0 ? v[j] * fsigmoid(g[j]) : (MODE == 1 ? v[j] * g[j] : fsilu(v[j]) * g[j]); }
            *(u32x4*)rowp = pack8(o[0], o[1]); }
}
struct EpiIn0 {
    static constexpr bool PERM = true; bf16_t* U0;
    __device__ __forceinline__ void operator()(const AccT& acc, const Unit& u, int wr, int wc, int fr, int fq) const {
        if (u.pn < 4) store_pair<0>(acc, U0, 1536, u.row0, 128 * u.pn, wr, wc, fr, fq);
        else if (u.pn < 8) store_pair<1>(acc, U0, 1536, u.row0, 512 + 128 * (u.pn - 4), wr, wc, fr, fq);
        else store_plain<0>(acc, U0, 1536, u.row0, 1024 + 256 * (u.pn - 8), wr, wc, fr, fq);
    }
};
struct EpiIn1 {
    static constexpr bool PERM = true; bf16_t* GY; bf16_t* XR;
    __device__ __forceinline__ void operator()(const AccT& acc, const Unit& u, int wr, int wc, int fr, int fq) const {
        if (u.pn < 4) store_plain<1>(acc, GY, D, u.row0, 256 * u.pn, wr, wc, fr, fq);
        else store_plain<0>(acc, XR, D, u.row0, 256 * (u.pn - 4), wr, wc, fr, fq);
    }
};
__device__ __forceinline__ void store_pair_fp8(const AccT& acc, unsigned char* O, int ldo, int row0, int col0, int wr, int wc, int fr, int fq) {
#pragma unroll
    for (int ai = 0; ai < 2; ++ai)
#pragma unroll
        for (int m = 0; m < 4; ++m) { unsigned char* rowp = O + (size_t)(row0 + ai * HALF + wr * 64 + m * 16 + fr) * ldo + col0 + wc * 32 + 8 * fq;
            u32x2 w;
#pragma unroll
            for (int n = 0; n < 2; ++n) { const f32x4 v = acc[ai][0][m][n], g = acc[ai][1][m][n]; float o[4];
#pragma unroll
                for (int j = 0; j < 4; ++j) o[j] = fminf(fmaxf(fsilu(v[j]) * g[j], -448.f), 448.f);
                const unsigned pk = pack4_fp8(o[0], o[1], o[2], o[3]); if (n == 0) w.x = pk; else w.y = pk; }
            *(u32x2*)rowp = w; }
}
struct EpiMoe1Q { static constexpr bool PERM = true; unsigned char* H;
    __device__ __forceinline__ void operator()(const AccT& acc, const Unit& u, int wr, int wc, int fr, int fq) const { store_pair_fp8(acc, H, DEXP, u.row0, 128 * u.pn, wr, wc, fr, fq); } };
struct EpiMoe1 { static constexpr bool PERM = true; bf16_t* H;
    __device__ __forceinline__ void operator()(const AccT& acc, const Unit& u, int wr, int wc, int fr, int fq) const { store_pair<2>(acc, H, DEXP, u.row0, 128 * u.pn, wr, wc, fr, fq); } };
struct EpiMoe2 { static constexpr bool PERM = true; bf16_t* Y;
    __device__ __forceinline__ void operator()(const AccT& acc, const Unit& u, int wr, int wc, int fr, int fq) const { store_plain<0>(acc, Y, D, u.row0, 256 * u.pn, wr, wc, fr, fq); } };
struct EpiRes { static constexpr bool PERM = true; const bf16_t* res; bf16_t* Y;
    __device__ __forceinline__ void operator()(const AccT& acc, const Unit& u, int wr, int wc, int fr, int fq) const {
#pragma unroll
        for (int ai = 0; ai < 2; ++ai)
#pragma unroll
            for (int m = 0; m < 4; ++m) { const size_t off = (size_t)(u.row0 + ai * HALF + wr * 64 + m * 16 + fr) * D + u.pn * 256 + wc * 32 + 8 * fq;
#pragma unroll
                for (int bj = 0; bj < 2; ++bj) { const size_t o = off + bj * HALF; const u32x4 w = *(const u32x4*)(res + o);
                    const f32x4 r0 = {bf_lo(w.x), bf_hi(w.x), bf_lo(w.y), bf_hi(w.y)}, r1 = {bf_lo(w.z), bf_hi(w.z), bf_lo(w.w), bf_hi(w.w)};
                    *(u32x4*)(Y + o) = pack8(r0 * ALPHA + acc[ai][bj][m][0], r1 * ALPHA + acc[ai][bj][m][1]); } }
    }
};
struct EpiGates { static constexpr bool PERM = true; const bf16_t* XC; const float* ba; const float* bx; const float* spl; bf16_t* L2A; bf16_t* BV;
    __device__ __forceinline__ void operator()(const AccT& acc, const Unit& u, int wr, int wc, int fr, int fq) const {
        const int col = 128 * u.pn + wc * 32 + 8 * fq;
#pragma unroll
        for (int ai = 0; ai < 2; ++ai)
#pragma unroll
            for (int m = 0; m < 4; ++m) { const size_t o = (size_t)(u.row0 + ai * HALF + wr * 64 + m * 16 + fr) * DRNN + col;
                const u32x4 xw = *(const u32x4*)(XC + o); const float xv[8] = {bf_lo(xw.x), bf_hi(xw.x), bf_lo(xw.y), bf_hi(xw.y), bf_lo(xw.z), bf_hi(xw.z), bf_lo(xw.w), bf_hi(xw.w)};
                f32x4 la2[2], bo[2];
#pragma unroll
                for (int n = 0; n < 2; ++n) { const f32x4 cba = *(const f32x4*)(ba + col + 4 * n), cbx = *(const f32x4*)(bx + col + 4 * n), csp = *(const f32x4*)(spl + col + 4 * n);
#pragma unroll
                    for (int j = 0; j < 4; ++j) { const float r = fsigmoid(acc[ai][0][m][n][j] + cba[j]), ig = fsigmoid(acc[ai][1][m][n][j] + cbx[j]);
                        const float l2 = -1.4426950408889634f * csp[j] * r;
                        const float a = __builtin_amdgcn_exp2f(l2); la2[n][j] = l2; bo[n][j] = __builtin_sqrtf(fmaxf(1.0f - a * a, 0.f)) * (ig * xv[4 * n + j]); } }
                const size_t ob = lb_off(u.row0 + ai * HALF + wr * 64 + m * 16 + fr, col); *(u32x4*)(L2A + ob) = pack8(la2[0], la2[1]); *(u32x4*)(BV + ob) = pack8(bo[0], bo[1]);
                asm volatile("" ::: "memory"); }
    }
};
}

constexpr size_t MiB = 1u << 20;
constexpr size_t WS_CTL = 0, CTL_ZERO_BYTES = 65536;
constexpr size_t WS_WIN0 = 2 * MiB, WS_WOUT0 = 7 * MiB, WS_WIN1 = 9 * MiB, WS_WGT = 13 * MiB, WS_WOUT1 = 14 * MiB, WS_W13 = 16 * MiB, WS_W2 = 144 * MiB, WS_SPL = 208 * MiB;
constexpr size_t WS_X1 = 212 * MiB, WS_X2 = 244 * MiB, WS_XB = WS_X2;
constexpr size_t WS_R = 276 * MiB;
constexpr size_t WS_U0 = WS_R, WS_CAT0 = WS_R + 48 * MiB, WS_YPRE0 = WS_R + 80 * MiB;
constexpr size_t WS_GY = WS_R, WS_XR = WS_R + 32 * MiB, WS_XC = WS_R + 64 * MiB, WS_BV = WS_R + 96 * MiB, WS_YPRE1 = WS_R + 64 * MiB;
constexpr size_t WS_H = WS_R, WS_Y = WS_R + 72 * MiB;
constexpr size_t WS_LIST = 420 * MiB, WS_TOKSLOT = 421 * MiB, WS_TOKGATE = WS_TOKSLOT + 256 * 1024, WS_AGG = 422 * MiB, WS_X1Q = 424 * MiB  , WS_FAST_END = 440 * MiB;
#ifndef MOE_FP8
#define MOE_FP8 1
#endif
#ifndef INP_FP8_L0
#define INP_FP8_L0 0
#endif
#ifndef INP_FP8_L1
#define INP_FP8_L1 1
#endif
#define INP_FP8 (INP_FP8_L0 || INP_FP8_L1)
constexpr int SCL_WIN = 6;
constexpr size_t WS_XQ = WS_X1Q;
constexpr int SCL_W13 = 6, SCL_W2 = 6;
static_assert(SCL_W13 % 2 == 0 && SCL_W2 % 2 == 0, "even scales");
constexpr int NPAD_ROWS = 2 * T + NE * 256;
static_assert(WS_H + (size_t)NPAD_ROWS * DEXP * 2 <= WS_Y && WS_Y + (size_t)NPAD_ROWS * D * 2 <= WS_LIST, "H / Y fit");
constexpr int CW_TMO = 0, CW_CODE = 1, CW_GCOUNT = 256  , CW_BAR = 4096;
constexpr int RING_BYTES = 131072, LDSCTL_OFF = RING_BYTES, MISC_OFF = LDSCTL_OFF + 320, UNITS_OFF = LDSCTL_OFF + 512, MOEMETA_OFF = LDSCTL_OFF + 768, GTAB_OFF = LDSCTL_OFF + 1024, MAX_UNITS = 8;
constexpr int LDS_BYTES = 147456;
static_assert(GTAB_OFF + MAX_UNITS * 1024 <= LDS_BYTES, "LDS map");
constexpr int NWAVES = 8, NTHREADS = 512;

#define XB_TMO      128
#define XB_XCNT(j)  (256  + 64 * (j))
#define XB_XSUB(j)  (1280 + 64 * (j))
#define XB_XGEN(j)  (2304 + 64 * (j))
#define XB_TOP      3328
#define XB_TOPGEN   3392
#define XCD_BAR_WORDS 3456
#define XB_SPIN_CAP (1u << 18)
__device__ __forceinline__ unsigned xb_ld(unsigned* p)              { return __hip_atomic_load(p, __ATOMIC_RELAXED, __HIP_MEMORY_SCOPE_AGENT); }
__device__ __forceinline__ unsigned xb_add(unsigned* p, unsigned v) { return __hip_atomic_fetch_add(p, v, __ATOMIC_RELAXED, __HIP_MEMORY_SCOPE_AGENT); }
__device__ __forceinline__ unsigned xb_xcc_id() { return (unsigned)__builtin_amdgcn_s_getreg((3 << 11) | 20) & 0xFu; }
#define XB_SPIN(cond, bar) do { unsigned _sp = 0; while (cond) { __builtin_amdgcn_s_sleep(1); \
    if ((++_sp & 255u) == 0u) { if (xb_ld(&(bar)[XB_TMO])) break; if (_sp > XB_SPIN_CAP) { atomicAdd(&(bar)[XB_TMO], 1u); break; } } } } while (0)
struct XcdBarrier { unsigned* bar; unsigned x; volatile LAS unsigned* st; int wave; };
__device__ __forceinline__ XcdBarrier xcd_barrier_post(unsigned* bar, volatile LAS unsigned* st, int wave) {
    XcdBarrier b; b.bar = bar; b.x = xb_xcc_id(); b.st = st; b.wave = wave;
    if (wave == 0 && lane_id_asm() == 0) (void)xb_add(&bar[XB_XCNT(b.x)], 1u);
    return b;
}
__device__ __forceinline__ void xcd_barrier_complete(unsigned* bar, unsigned x, unsigned& nloc, unsigned& nx) {
    const unsigned G = gridDim.x * gridDim.y * gridDim.z;
    unsigned sum, cnt, mine, sp = 0u;
    for (;;) {
        sum = 0u; cnt = 0u; mine = 0u;
#pragma unroll
        for (unsigned j = 0; j < 16; ++j) { const unsigned c = xb_ld(&bar[XB_XCNT(j)]); sum += c; cnt += (c > 0u) ? 1u : 0u; mine = (j == x) ? c : mine; }
        if (sum == G) break;
        __builtin_amdgcn_s_sleep(1);
        if ((++sp & 255u) == 0u) { if (xb_ld(&bar[XB_TMO])) break; if (sp > XB_SPIN_CAP) { atomicAdd(&bar[XB_TMO], 1u); break; } }
    }
    nloc = mine > 0u ? mine : 1u; nx = cnt > 0u ? cnt : 1u;
}
__device__ __forceinline__ void xcd_barrier(const XcdBarrier& b) {
    asm volatile("s_waitcnt vmcnt(0)" ::: "memory");
    __syncthreads();
    if (b.wave == 0 && lane_id_asm() == 0) {
        unsigned* bar = b.bar;
        __builtin_amdgcn_s_waitcnt(0);
        unsigned nloc = b.st[0], nx = b.st[1];
        if (nloc == 0u) { xcd_barrier_complete(bar, b.x, nloc, nx); b.st[0] = nloc; b.st[1] = nx; }
        const unsigned old = xb_add(&bar[XB_XSUB(b.x)], 1u);
        const unsigned gen = old / nloc;
        if (old + 1u == (gen + 1u) * nloc) {
            __builtin_amdgcn_fence(__ATOMIC_RELEASE, "agent");
            asm volatile("s_waitcnt vmcnt(0)" ::: "memory");
            const unsigned og = xb_add(&bar[XB_TOP], 1u);
            const unsigned tg = og / nx;
            if (og + 1u == (tg + 1u) * nx) xb_add(&bar[XB_TOPGEN], 1u);
            else XB_SPIN(xb_ld(&bar[XB_TOPGEN]) == tg, bar);
            __builtin_amdgcn_fence(__ATOMIC_ACQUIRE, "agent");
            xb_add(&bar[XB_XGEN(b.x)], 1u);
            asm volatile("s_waitcnt vmcnt(0)" ::: "memory");
        } else {
            XB_SPIN(xb_ld(&bar[XB_XGEN(b.x)]) == gen, bar);
            __builtin_amdgcn_fence(__ATOMIC_ACQUIRE, "agent");
            asm volatile("s_waitcnt vmcnt(0)" ::: "memory");
        }
    }
    __syncthreads();
}

struct Args { const float* in[26]; float* out; unsigned char* ws; int ph_lo, ph_hi; };
struct Frame {
    LAS unsigned char* lds; unsigned char* ws; const float* const* in; float* out;
    int tid, lane, wave, vcu, G;
    template <class Tp> __device__ __forceinline__ Tp* W(size_t off) const { return (Tp*)(ws + off); }
    __device__ __forceinline__ const float* I(int i) const { return in[i]; }
    __device__ __forceinline__ unsigned* ctl() const { return (unsigned*)(ws + WS_CTL); }
    __device__ __forceinline__ void retid() { lane = lane_id_asm(); tid = wave * 64 + lane; }
};

__device__ __forceinline__ void cvt_item(const float* src, int ldsrc, int k0, int c0, bf16_t* dst, int lddst, int drow0, LAS unsigned* scr, int lane) {
    const int cg = lane & 15, rp = lane >> 4;
    const float* sp = src + (size_t)k0 * ldsrc + c0 + 4 * cg;
    f32x4 v[16];
#pragma unroll
    for (int j = 0; j < 8; ++j) { const int r = 2 * (rp + 4 * j); v[2 * j] = __builtin_nontemporal_load((const f32x4*)(sp + (size_t)r * ldsrc)); v[2 * j + 1] = __builtin_nontemporal_load((const f32x4*)(sp + (size_t)(r + 1) * ldsrc)); }
#pragma unroll
    for (int j = 0; j < 8; ++j) { const int kd = rp + 4 * j;
#pragma unroll
        for (int i = 0; i < 4; ++i) scr[(4 * cg + i) * 33 + kd] = cvt_pk_bf16(v[2 * j][i], v[2 * j + 1][i]); }
    LDS_WAIT();
    const int kc = lane & 7;
#pragma unroll
    for (int jj = 0; jj < 8; ++jj) { const int n = (lane >> 3) + 8 * jj; const LAS unsigned* s = scr + n * 33 + 4 * kc;
        u32x4 o; o.x = s[0]; o.y = s[1]; o.z = s[2]; o.w = s[3];
        *(u32x4*)(dst + (size_t)(drow0 + n) * lddst + k0 + 8 * kc) = o; }
    LDS_WAIT();
}
__device__ __forceinline__ void cvt_item8(const float* src, int ldsrc, int k0, int c0, unsigned char* dst, int lddst, int drow0, float scale, LAS unsigned* scr, int lane) {
    const int cg = lane & 15, rp = lane >> 4;
    const float* sp = src + (size_t)k0 * ldsrc + c0 + 4 * cg;
    f32x4 v[16];
#pragma unroll
    for (int j = 0; j < 4; ++j)
#pragma unroll
        for (int q = 0; q < 4; ++q) v[4 * j + q] = __builtin_nontemporal_load((const f32x4*)(sp + (size_t)(4 * (rp + 4 * j) + q) * ldsrc));
#pragma unroll
    for (int j = 0; j < 4; ++j) { const int kq = rp + 4 * j;
#pragma unroll
        for (int i = 0; i < 4; ++i) scr[(4 * cg + i) * 17 + kq] = pack4_fp8(v[4 * j][i] * scale, v[4 * j + 1][i] * scale, v[4 * j + 2][i] * scale, v[4 * j + 3][i] * scale); }
    LDS_WAIT();
    const int c4 = lane & 3;
#pragma unroll
    for (int jj = 0; jj < 4; ++jj) { const int n = (lane >> 2) + 16 * jj; const LAS unsigned* s = scr + n * 17 + 4 * c4;
        u32x4 o; o.x = s[0]; o.y = s[1]; o.z = s[2]; o.w = s[3];
        *(u32x4*)(dst + (size_t)(drow0 + n) * lddst + k0 + 16 * c4) = o; }
    LDS_WAIT();
}
__device__ __forceinline__ void p0_prologue(Frame& F) {
    F.retid();
    LAS unsigned* scr = (LAS unsigned*)(F.lds + F.wave * 8448);
    const int gw = F.vcu * NWAVES + F.wave, NGW = F.G * NWAVES;
    constexpr int I_IN0 = 16 * 40, I_OUT0 = 16 * 16, I_IN1 = 16 * 32, I_GT = 4 * 4 * 8, I_OUT1 = 16 * 16, I_W13 = 32 * 16 * 32, I_W2 = 32 * 16 * 16;
    constexpr int NITEMS = I_IN0 + I_OUT0 + I_IN1 + I_GT + I_OUT1 + I_W13 + I_W2;
    for (int it = gw; it < NITEMS; it += NGW) {
        int r = it; const float* src; int ldsrc, k0, sc, lddst, drow0; unsigned char* dst; bool q8 = false; float scale = 1.f;
        if (r < I_IN0) { const int kb = r / 40, db = r % 40, p = db >> 2, q = db & 3;
            if (p < 4) sc = (q < 2) ? 128 * p + 64 * q : 512 + 128 * p + 64 * (q - 2);
            else if (p < 8) sc = (q < 2) ? 1536 + 128 * (p - 4) + 64 * q : 2048 + 128 * (p - 4) + 64 * (q - 2);
            else sc = 1024 + 256 * (p - 8) + 64 * q;
            src = F.I(5); ldsrc = DIN0; k0 = 64 * kb; dst = F.W<unsigned char>(WS_WIN0); lddst = D; drow0 = 64 * db; q8 = INP_FP8_L0; scale = (float)(1 << SCL_WIN); }
        else if ((r -= I_IN0) < I_OUT0) { const int kb = r / 16, db = r % 16; src = F.I(11); ldsrc = D; k0 = 64 * kb; sc = 64 * db; dst = F.W<unsigned char>(WS_WOUT0); lddst = D; drow0 = 64 * db; }
        else if ((r -= I_OUT0) < I_IN1) { const int kb = r / 32, db = r % 32; src = F.I(12); ldsrc = 2 * DRNN; k0 = 64 * kb; sc = 64 * db; dst = F.W<unsigned char>(WS_WIN1); lddst = D; drow0 = 64 * db; q8 = INP_FP8_L1; scale = (float)(1 << SCL_WIN); }
        else if ((r -= I_IN1) < I_GT) { const int h = r / 32, r2 = r % 32, kb = r2 / 8, db = r2 % 8, p = db >> 2, q = db & 3;
            src = (q < 2 ? F.I(15) : F.I(17)) + (size_t)h * RBLK * RBLK; ldsrc = RBLK; k0 = 64 * kb; sc = 128 * p + 64 * (q & 1); dst = F.W<unsigned char>(WS_WGT) + (size_t)h * 512 * RBLK * 2; lddst = RBLK; drow0 = 64 * db; }
        else if ((r -= I_GT) < I_OUT1) { const int kb = r / 16, db = r % 16; src = F.I(20); ldsrc = D; k0 = 64 * kb; sc = 64 * db; dst = F.W<unsigned char>(WS_WOUT1); lddst = DRNN; drow0 = 64 * db; }
        else if ((r -= I_OUT1) < I_W13) { const int le = r / 512, r2 = r % 512, kb = r2 / 32, db = r2 % 32, p = db >> 2, q = db & 3;
            src = (q < 2 ? F.I(23) : F.I(24)) + (size_t)le * D * DEXP; ldsrc = DEXP; k0 = 64 * kb; sc = 128 * p + 64 * (q & 1); lddst = D; drow0 = 64 * db;
            q8 = MOE_FP8; scale = (float)(1 << SCL_W13); dst = F.W<unsigned char>(WS_W13) + (size_t)le * 2 * DEXP * D * (MOE_FP8 ? 1 : 2); }
        else { r -= I_W13; const int le = r / 256, r2 = r % 256, kb = r2 / 16, db = r2 % 16;
            src = F.I(25) + (size_t)le * DEXP * D; ldsrc = D; k0 = 64 * kb; sc = 64 * db; lddst = DEXP; drow0 = 64 * db;
            q8 = MOE_FP8; scale = (float)(1 << SCL_W2); dst = F.W<unsigned char>(WS_W2) + (size_t)le * D * DEXP * (MOE_FP8 ? 1 : 2); }
        if (q8) cvt_item8(src, ldsrc, k0, sc, dst, lddst, drow0, scale, scr, F.lane);
        else cvt_item(src, ldsrc, k0, sc, (bf16_t*)dst, lddst, drow0, scr, F.lane);
    }
    { const float* x = F.I(0); bf16_t* xb = F.W<bf16_t>(WS_X2); const size_t n8 = (size_t)T * D / 8, stride = (size_t)F.G * NTHREADS;
      unsigned char* xq = F.W<unsigned char>(WS_XQ); (void)xq;
      for (size_t i = (size_t)F.vcu * NTHREADS + F.tid; i < n8; i += stride) { const f32x4 a = __builtin_nontemporal_load((const f32x4*)(x + i * 8)), b = __builtin_nontemporal_load((const f32x4*)(x + i * 8 + 4)); *(u32x4*)(xb + i * 8) = pg8::pack8(a, b);
#if INP_FP8_L0
          u32x2 q; q.x = pack4_fp8(a[0], a[1], a[2], a[3]); q.y = pack4_fp8(b[0], b[1], b[2], b[3]); *(u32x2*)(xq + i * 8) = q;
#endif
      } }
    { const int i = F.vcu * NTHREADS + F.tid; if (i < DRNN) F.W<float>(WS_SPL)[i] = 8.0f * log1pf(expf(-F.I(19)[i])); }
}

struct DenseOrder {
    const char* A; const char* B; size_t a_tile, b_tile; int nM, nN, G, c;
    __device__ __forceinline__ bool next(int i, pg8::Unit& u) const { int pm, pn; if (!pg8::tile_of(i, G, c, nM, nN, pm, pn)) return false;
        u.A = A + (size_t)pm * a_tile; u.B = B + (size_t)pn * b_tile; u.row0 = pm * 256; u.pn = pn; u.e = 0; u.gtab = 0; return true; }
};
struct GatesOrder {
    const char* XC; const char* WG; int G, c;
    __device__ __forceinline__ bool next(int i, pg8::Unit& u) const { int pm, pn; if (!pg8::tile_of(i, G, c, T / 256, 2 * RHEADS, pm, pn)) return false;
        u.A = XC + (size_t)pm * 256 * DRNN * 2 + (size_t)(pn >> 1) * RBLK * 2; u.B = WG + (size_t)pn * 256 * RBLK * 2; u.row0 = pm * 256; u.pn = pn; u.e = 0; u.gtab = 0; return true; }
};
struct MoeOrder { LAS const int* units; int nu; const char* A; const char* B; size_t b_exp, b_tile, a_tile; bool gather;
    __device__ __forceinline__ bool next(int i, pg8::Unit& u) const { if (i >= nu) return false;
        const int e = __builtin_amdgcn_readfirstlane(units[4 * i]), pm = __builtin_amdgcn_readfirstlane(units[4 * i + 1]), pn = __builtin_amdgcn_readfirstlane(units[4 * i + 2]);
        u.A = gather ? A : A + (size_t)pm * a_tile; u.B = B + (size_t)e * b_exp + (size_t)pn * b_tile; u.row0 = pm * 256; u.pn = pn; u.e = e; u.gtab = GTAB_OFF + i * 1024; return true; }
};
__device__ __forceinline__ int moe_setup(Frame& F, int layer, int nN, bool gather, unsigned rowbytes) {
    F.retid();
    LAS int* meta = (LAS int*)(F.lds + MOEMETA_OFF); LAS int* units = (LAS int*)(F.lds + UNITS_OFF); LAS unsigned* gtab = (LAS unsigned*)(F.lds + GTAB_OFF);
    const unsigned* gcount = F.ctl() + CW_GCOUNT + 32 * layer;
    if (F.tid < NE) meta[17 + F.tid] = (int)__hip_atomic_load(gcount + F.tid, RLX_AGENT);
    __syncthreads();
    if (F.tid == 0) { int acc = 0; for (int e = 0; e < NE; ++e) { meta[e] = acc; acc += (meta[17 + e] + 255) >> 8; } meta[NE] = acc; }
    __syncthreads();
    const int nM = meta[NE]; int nu = 0;
    for (int i = 0; i < MAX_UNITS; ++i) { int pm, pn; if (!pg8::tile_of(i, F.G, (int)blockIdx.x, nM, nN, pm, pn)) break;
        int e = 0;
#pragma unroll
        for (int j = 1; j < NE; ++j) e += (meta[j] <= pm) ? 1 : 0;
        if (F.tid == 0) { units[4 * i] = e; units[4 * i + 1] = pm; units[4 * i + 2] = pn; units[4 * i + 3] = 0; }
        if (gather && F.tid < 256) { const int idx = (pm - meta[e]) * 256 + F.tid; const int cnt = meta[17 + e];
            const int tok = idx < cnt ? F.W<int>(WS_LIST)[e * T + idx] : 0; gtab[i * 256 + F.tid] = (unsigned)tok * rowbytes; }
        nu = i + 1; }
    __syncthreads();
    return nu;
}

__device__ __forceinline__ void p_mix0(Frame& F) {
    F.retid();
    LAS float* wA = (LAS float*)F.lds;
    LAS float* wB = wA + CONVA * DA;
    LAS float* pb = wB + CONVB * DB;
    for (int i = F.tid; i < CONVA * DA; i += NTHREADS) wA[i] = F.I(6)[i];
    for (int i = F.tid; i < CONVB * DB; i += NTHREADS) wB[i] = F.I(10)[i];
    for (int i = F.tid; i < DA; i += NTHREADS) { pb[i] = F.I(7)[i]; pb[DA + i] = F.I(8)[i]; pb[2 * DA + i] = F.I(9)[i]; }
    __syncthreads();
    const bf16_t* U0 = F.W<bf16_t>(WS_U0); bf16_t* CAT = F.W<bf16_t>(WS_CAT0);
    const int c0 = 8 * F.lane;
#pragma unroll 1
    for (int tb = F.vcu * NWAVES + F.wave; tb < T / 8; tb += F.G * NWAVES) {
        const int t0 = tb * 8, s0 = t0 & (SEQ - 1);
        float acc[8][8];
        { const f32x4 b0 = *(const LAS f32x4*)(pb + c0), b1 = *(const LAS f32x4*)(pb + c0 + 4);
#pragma unroll
          for (int r = 0; r < 8; ++r) { acc[r][0] = b0[0]; acc[r][1] = b0[1]; acc[r][2] = b0[2]; acc[r][3] = b0[3]; acc[r][4] = b1[0]; acc[r][5] = b1[1]; acc[r][6] = b1[2]; acc[r][7] = b1[3]; } }
#pragma unroll
        for (int jb = 0; jb < 5; ++jb) {
            u32x4 in[8];
#pragma unroll
            for (int jj = 0; jj < 8; ++jj) { const int j = jb * 8 + jj; const int d = 30 - j;
                const bool ok = (j < 38) && (s0 - d >= 0); const size_t rr = ok ? (size_t)(t0 - d) : (size_t)t0;
                in[jj] = *(const u32x4*)(U0 + rr * 1536 + c0); if (!ok) in[jj] = (u32x4){0u, 0u, 0u, 0u}; }
#pragma unroll
            for (int jj = 0; jj < 8; ++jj) { const int j = jb * 8 + jj;
                const float x0 = bf_lo(in[jj].x), x1 = bf_hi(in[jj].x), x2 = bf_lo(in[jj].y), x3 = bf_hi(in[jj].y), x4 = bf_lo(in[jj].z), x5 = bf_hi(in[jj].z), x6 = bf_lo(in[jj].w), x7 = bf_hi(in[jj].w);
#pragma unroll
                for (int r = 0; r < 8; ++r) { const int k = j - r; if (k < 0 || k >= CONVA) continue;
                    const f32x4 w0 = *(const LAS f32x4*)(wA + k * DA + c0), w1 = *(const LAS f32x4*)(wA + k * DA + c0 + 4);
                    acc[r][0] += w0[0] * x0; acc[r][1] += w0[1] * x1; acc[r][2] += w0[2] * x2; acc[r][3] += w0[3] * x3;
                    acc[r][4] += w1[0] * x4; acc[r][5] += w1[1] * x5; acc[r][6] += w1[2] * x6; acc[r][7] += w1[3] * x7; } }
        }
        float mean[8], rstd[8];
#pragma unroll
        for (int r = 0; r < 8; ++r) { float sm = 0.f;
#pragma unroll
            for (int j = 0; j < 8; ++j) sm += acc[r][j];
            mean[r] = sm; }
#pragma unroll
        for (int r = 0; r < 8; ++r) mean[r] = wave_sum(mean[r]) * (1.0f / DA);
#pragma unroll
        for (int r = 0; r < 8; ++r) { float q = 0.f;
#pragma unroll
            for (int j = 0; j < 8; ++j) { acc[r][j] -= mean[r]; q += acc[r][j] * acc[r][j]; }
            rstd[r] = q; }
#pragma unroll
        for (int r = 0; r < 8; ++r) rstd[r] = 1.0f / sqrtf(wave_sum(rstd[r]) * (1.0f / DA) + LN_EPS);
        { const f32x4 g0 = *(const LAS f32x4*)(pb + DA + c0), g1 = *(const LAS f32x4*)(pb + DA + c0 + 4), e0 = *(const LAS f32x4*)(pb + 2 * DA + c0), e1 = *(const LAS f32x4*)(pb + 2 * DA + c0 + 4);
#pragma unroll
          for (int r = 0; r < 8; ++r) { f32x4 o0, o1;
#pragma unroll
              for (int j = 0; j < 4; ++j) { o0[j] = fsilu(acc[r][j] * rstd[r] * g0[j] + e0[j]); o1[j] = fsilu(acc[r][4 + j] * rstd[r] * g1[j] + e1[j]); }
              *(u32x4*)(CAT + (size_t)(t0 + r) * D + c0) = pg8::pack8(o0, o1); } }
        { u32x4 cx[10], bbv[8];
#pragma unroll
          for (int j = 0; j < 10; ++j) { const int d = 2 - j; const bool ok = (s0 - d >= 0); const size_t rr = ok ? (size_t)(t0 - d) : (size_t)t0;
              cx[j] = *(const u32x4*)(U0 + rr * 1536 + 512 + c0); if (!ok) cx[j] = (u32x4){0u, 0u, 0u, 0u}; }
#pragma unroll
          for (int r = 0; r < 8; ++r) bbv[r] = *(const u32x4*)(U0 + (size_t)(t0 + r) * 1536 + 1024 + c0);
          f32x4 wv[3][2];
#pragma unroll
          for (int k = 0; k < 3; ++k) { wv[k][0] = *(const LAS f32x4*)(wB + k * DB + c0); wv[k][1] = *(const LAS f32x4*)(wB + k * DB + c0 + 4); }
#pragma unroll
          for (int r = 0; r < 8; ++r) { f32x4 a0 = {0.f, 0.f, 0.f, 0.f}, a1 = {0.f, 0.f, 0.f, 0.f};
#pragma unroll
              for (int k = 0; k < 3; ++k) { const u32x4 w = cx[r + k];
                  a0 += wv[k][0] * (f32x4){bf_lo(w.x), bf_hi(w.x), bf_lo(w.y), bf_hi(w.y)}; a1 += wv[k][1] * (f32x4){bf_lo(w.z), bf_hi(w.z), bf_lo(w.w), bf_hi(w.w)}; }
              const u32x4 bw = bbv[r];
              const f32x4 p0 = a0 * (f32x4){bf_lo(bw.x), bf_hi(bw.x), bf_lo(bw.y), bf_hi(bw.y)}, p1 = a1 * (f32x4){bf_lo(bw.z), bf_hi(bw.z), bf_lo(bw.w), bf_hi(bw.w)};
              *(u32x4*)(CAT + (size_t)(t0 + r) * D + 512 + c0) = pg8::pack8(p0, p1); } }
    }
    __syncthreads();
}

__device__ __forceinline__ void route16(const float (&l)[NE], int& e1, int& e2, float& g1, float& g2) {
    float mx = l[0];
#pragma unroll
    for (int e = 1; e < NE; ++e) mx = fmaxf(mx, l[e]);
    float p[NE];
#pragma unroll
    for (int e = 0; e < NE; ++e) p[e] = __expf(l[e] - mx);
    int gsel = 0; float best = -1.f, bq0 = 0.f, bq1 = 0.f, bq2 = 0.f, bq3 = 0.f;
#pragma unroll
    for (int g = 0; g < NG; ++g) { float m1 = -1.f, m2 = -1.f;
#pragma unroll
        for (int j = 0; j < EPG; ++j) { const float v = p[g * EPG + j]; if (v > m1) { m2 = m1; m1 = v; } else if (v > m2) m2 = v; }
        const float sc = m1 + m2; if (sc > best) { best = sc; gsel = g; bq0 = p[g * EPG]; bq1 = p[g * EPG + 1]; bq2 = p[g * EPG + 2]; bq3 = p[g * EPG + 3]; } }
    int i1 = 0; float p1 = bq0;
    if (bq1 > p1) { p1 = bq1; i1 = 1; } if (bq2 > p1) { p1 = bq2; i1 = 2; } if (bq3 > p1) { p1 = bq3; i1 = 3; }
    int i2 = -1; float p2 = -1.f;
    if (i1 != 0 && bq0 > p2) { p2 = bq0; i2 = 0; } if (i1 != 1 && bq1 > p2) { p2 = bq1; i2 = 1; } if (i1 != 2 && bq2 > p2) { p2 = bq2; i2 = 2; } if (i1 != 3 && bq3 > p2) { p2 = bq3; i2 = 3; }
    e1 = gsel * EPG + i1; e2 = gsel * EPG + i2; const float inv = 1.0f / (p1 + p2); g1 = p1 * inv; g2 = p2 * inv;
}
#ifndef P4_VAR
#define P4_VAR 0
#endif
__device__ __forceinline__ void p_ln1_route(Frame& F, int layer, const bf16_t* YPRE, bool dummy = false) {
    const int var = dummy ? P4_VAR : 0;
    F.retid();
    LAS float* wrT = (LAS float*)F.lds;
    LAS int* rt = (LAS int*)(F.lds + 65536);
    LAS int* re = rt; LAS int* rlp = rt + 128; LAS float* rg = (LAS float*)(rt + 256); LAS int* lcount = rt + 384; LAS int* gbase = rt + 400;
    { const float* wr = F.I(21);
      for (int idx = F.tid; idx < D * NE / 4; idx += NTHREADS) { const f32x4 v = *(const f32x4*)(wr + idx * 4); const int c = idx >> 2, e4 = (idx & 3) * 4;
          wrT[(e4 + 0) * D + c] = v[0]; wrT[(e4 + 1) * D + c] = v[1]; wrT[(e4 + 2) * D + c] = v[2]; wrT[(e4 + 3) * D + c] = v[3]; } }
    const float* g1p = F.I(1) + layer * D; const float* b1p = F.I(2) + layer * D; const float* br = F.I(22);
    bf16_t* X1 = F.W<bf16_t>(WS_X1); unsigned* gcount = F.ctl() + CW_GCOUNT + 32 * layer + (dummy ? 16 : 0);
    int* LIST = F.W<int>(WS_LIST); int* TOKSLOT = F.W<int>(WS_TOKSLOT); float* TOKGATE = F.W<float>(WS_TOKGATE); unsigned char* X1Q = F.W<unsigned char>(WS_X1Q); (void)X1Q;
    const int lane = F.lane;
    for (int tb = F.vcu; tb < T / 64; tb += F.G) {
        if (F.tid < NE) lcount[F.tid] = 0;
        __syncthreads();
        const int tok0 = tb * 64;
        const float brl = br[lane & 15];
#pragma unroll 1
        for (int grp = 0; grp < 2; ++grp) {
            const int rl0 = F.wave * 8 + grp * 4;
            f32x4 x[4][4]; float st[4];
#pragma unroll
            for (int r = 0; r < 4; ++r) { const bf16_t* yr = YPRE + (size_t)(tok0 + rl0 + r) * D + 4 * lane;
#pragma unroll
                for (int j = 0; j < 4; ++j) { const u32x2 w = *(const u32x2*)(yr + 256 * j); x[r][j] = (f32x4){bf_lo(w.x), bf_hi(w.x), bf_lo(w.y), bf_hi(w.y)}; } }
#pragma unroll
            for (int r = 0; r < 4; ++r) { float s_ = 0.f;
#pragma unroll
                for (int j = 0; j < 4; ++j) s_ += (x[r][j][0] + x[r][j][1]) + (x[r][j][2] + x[r][j][3]);
                st[r] = s_; }
#pragma unroll
            for (int r = 0; r < 4; ++r) st[r] = wave_sum(st[r]) * (1.0f / D);
#pragma unroll
            for (int r = 0; r < 4; ++r) { float q = 0.f;
#pragma unroll
                for (int j = 0; j < 4; ++j) { x[r][j] = x[r][j] - st[r]; q += (x[r][j][0] * x[r][j][0] + x[r][j][1] * x[r][j][1]) + (x[r][j][2] * x[r][j][2] + x[r][j][3] * x[r][j][3]); }
                st[r] = q; }
#pragma unroll
            for (int r = 0; r < 4; ++r) st[r] = 1.0f / sqrtf(wave_sum(st[r]) * (1.0f / D) + LN_EPS);
#pragma unroll
            for (int j = 0; j < 4; ++j) { const f32x4 gg = *(const f32x4*)(g1p + 256 * j + 4 * lane), bb = *(const f32x4*)(b1p + 256 * j + 4 * lane);
#pragma unroll
                for (int r = 0; r < 4; ++r) { x[r][j] = x[r][j] * st[r] * gg + bb;
                    u32x2 w; w.x = cvt_pk_bf16(x[r][j][0], x[r][j][1]); w.y = cvt_pk_bf16(x[r][j][2], x[r][j][3]);
                    *(u32x2*)(X1 + (size_t)(tok0 + rl0 + r) * D + 256 * j + 4 * lane) = w;
#if MOE_FP8
                    *(unsigned*)(X1Q + (size_t)(tok0 + rl0 + r) * D + 256 * j + 4 * lane) = pack4_fp8(x[r][j][0], x[r][j][1], x[r][j][2], x[r][j][3]);
#endif
                } }
            if (var == 1) { asm volatile("" :: "v"(x[0][0][0])); continue; }
            int zoff = 0; asm volatile("" : "+v"(zoff));
            const LAS float* wl = wrT + zoff + 4 * lane;
            float pr[4];
            {
                float lg[4][NE];
#pragma unroll
                for (int e = 0; e < NE; ++e) {
#pragma unroll
                    for (int r = 0; r < 4; ++r) lg[r][e] = 0.f;
#pragma unroll
                    for (int j = 0; j < 4; ++j) { const f32x4 w = *(const LAS f32x4*)(wl + e * D + 256 * j);
#pragma unroll
                        for (int r = 0; r < 4; ++r) lg[r][e] += (x[r][j][0] * w[0] + x[r][j][1] * w[1]) + (x[r][j][2] * w[2] + x[r][j][3] * w[3]); } }
                if (var == 2) {
#pragma unroll
                    for (int e = 0; e < NE; ++e) asm volatile("" :: "v"(lg[0][e]), "v"(lg[1][e]), "v"(lg[2][e]), "v"(lg[3][e]));
                    continue; }
#pragma unroll
                for (int r = 0; r < 4; ++r) { float a8[8], a4[4], a2[2];
#pragma unroll
                    for (int i = 0; i < 8; ++i) { const bool hi = lane & 1; const float send = hi ? lg[r][2 * i] : lg[r][2 * i + 1], keep = hi ? lg[r][2 * i + 1] : lg[r][2 * i]; a8[i] = keep + dpp_xor1(send); }
#pragma unroll
                    for (int i = 0; i < 4; ++i) { const bool hi = lane & 2; const float send = hi ? a8[2 * i] : a8[2 * i + 1], keep = hi ? a8[2 * i + 1] : a8[2 * i]; a4[i] = keep + dpp_xor2(send); }
#pragma unroll
                    for (int i = 0; i < 2; ++i) { const bool hi = lane & 4; const float send = hi ? a4[2 * i] : a4[2 * i + 1], keep = hi ? a4[2 * i + 1] : a4[2 * i]; a2[i] = keep + swz_xor<4>(send); }
                    { const bool hi = lane & 8; const float send = hi ? a2[0] : a2[1], keep = hi ? a2[1] : a2[0]; pr[r] = keep + swz_xor<8>(send); } }
            }
            float L;
            { const bool h16 = lane & 16, h32 = lane & 32;
              const float k0 = h16 ? pr[1] : pr[0], s0_ = h16 ? pr[0] : pr[1], k1 = h16 ? pr[3] : pr[2], s1_ = h16 ? pr[2] : pr[3];
              const float u0 = k0 + swz_xor<16>(s0_), u1 = k1 + swz_xor<16>(s1_);
              const float kk = h32 ? u1 : u0, ss = h32 ? u0 : u1;
              L = kk + __int_as_float(__builtin_amdgcn_ds_bpermute((lane ^ 32) << 2, __float_as_int(ss))) + brl; }
            float mx = L; mx = fmaxf(mx, dpp_xor1(mx)); mx = fmaxf(mx, dpp_xor2(mx)); mx = fmaxf(mx, swz_xor<4>(mx)); mx = fmaxf(mx, swz_xor<8>(mx));
            const float p = __expf(L - mx);
            const float q0 = __int_as_float(__builtin_amdgcn_mov_dpp(__float_as_int(p), 0x00, 0xF, 0xF, true)), q1 = __int_as_float(__builtin_amdgcn_mov_dpp(__float_as_int(p), 0x55, 0xF, 0xF, true)),
                        q2 = __int_as_float(__builtin_amdgcn_mov_dpp(__float_as_int(p), 0xAA, 0xF, 0xF, true)), q3 = __int_as_float(__builtin_amdgcn_mov_dpp(__float_as_int(p), 0xFF, 0xF, 0xF, true));
            int i1 = 0; float p1 = q0;
            if (q1 > p1) { p1 = q1; i1 = 1; } if (q2 > p1) { p1 = q2; i1 = 2; } if (q3 > p1) { p1 = q3; i1 = 3; }
            int i2 = -1; float p2 = -1.f;
            if (i1 != 0 && q0 > p2) { p2 = q0; i2 = 0; } if (i1 != 1 && q1 > p2) { p2 = q1; i2 = 1; } if (i1 != 2 && q2 > p2) { p2 = q2; i2 = 2; } if (i1 != 3 && q3 > p2) { p2 = q3; i2 = 3; }
            const int g = (lane >> 2) & 3;
            float bs_ = p1 + p2; int bg = g;
            { const float os = swz_xor<4>(bs_); const int og = __builtin_amdgcn_ds_swizzle(bg, (4 << 10) | 0x1F); if (os > bs_ || (os == bs_ && og < bg)) { bs_ = os; bg = og; } }
            { const float os = swz_xor<8>(bs_); const int og = __builtin_amdgcn_ds_swizzle(bg, (8 << 10) | 0x1F); if (os > bs_ || (os == bs_ && og < bg)) { bs_ = os; bg = og; } }
            if (var == 3) { asm volatile("" :: "v"(bg), "v"(i1), "v"(i2), "v"(p1), "v"(p2)); continue; }
            if (g == bg && (lane & 3) == 0) {
                const int rl = rl0 + (lane >> 4), e1 = 4 * g + i1, e2 = 4 * g + i2; const float inv = 1.0f / (p1 + p2);
                const int lp1 = __hip_atomic_fetch_add(lcount + e1, 1, __ATOMIC_RELAXED, __HIP_MEMORY_SCOPE_WORKGROUP), lp2 = __hip_atomic_fetch_add(lcount + e2, 1, __ATOMIC_RELAXED, __HIP_MEMORY_SCOPE_WORKGROUP);
                re[2 * rl] = e1; re[2 * rl + 1] = e2; rlp[2 * rl] = lp1; rlp[2 * rl + 1] = lp2; rg[2 * rl] = p1 * inv; rg[2 * rl + 1] = p2 * inv; }
        }
        __syncthreads();
        if (var != 0) continue;
        if (F.tid < NE) gbase[F.tid] = (int)__hip_atomic_fetch_add(gcount + F.tid, (unsigned)lcount[F.tid], RLX_AGENT);
        __syncthreads();
        if (F.tid < 128) { const int e = re[F.tid], pos = gbase[e] + rlp[F.tid], tok = tok0 + (F.tid >> 1);
            LIST[e * T + pos] = tok; TOKSLOT[tok * 2 + (F.tid & 1)] = e * T + pos; TOKGATE[tok * 2 + (F.tid & 1)] = rg[F.tid]; }
        __syncthreads();
    }
}

__device__ __forceinline__ void p_combine(Frame& F, int layer) {
    F.retid();
    const unsigned* gcount = F.ctl() + CW_GCOUNT + 32 * layer;
    const int lane = F.lane;
    int pre = 0;
#pragma unroll
    for (int j = 0; j < NE - 1; ++j) { const int cnt = (int)__builtin_amdgcn_readfirstlane(__hip_atomic_load(gcount + j, RLX_AGENT)); pre += ((lane & 15) > j) ? ((cnt + 255) >> 8) * 256 : 0; }
    const bf16_t* X1 = F.W<bf16_t>(WS_X1); const bf16_t* Y = F.W<bf16_t>(WS_Y); const int* TOKSLOT = F.W<int>(WS_TOKSLOT); const float* TOKGATE = F.W<float>(WS_TOKGATE);
    const float* g2p = F.I(3) + layer * D; const float* b2p = F.I(4) + layer * D;
    bf16_t* X2 = F.W<bf16_t>(WS_X2);
    f32x4 gg[4], bb[4];
#pragma unroll
    for (int j = 0; j < 4; ++j) { gg[j] = *(const f32x4*)(g2p + 256 * j + 4 * lane); bb[j] = *(const f32x4*)(b2p + 256 * j + 4 * lane); }
#pragma unroll 1
    for (int tb = F.vcu * NWAVES + F.wave; tb < T / 8; tb += F.G * NWAVES) {
#pragma unroll 1
        for (int i0 = 0; i0 < 8; i0 += 4) {
            const int t0 = tb * 8 + i0;
            int r0[4], r1[4]; float g0[4], g1[4];
#pragma unroll
            for (int u = 0; u < 4; ++u) { const int s0 = __builtin_amdgcn_readfirstlane(TOKSLOT[2 * (t0 + u)]), s1 = __builtin_amdgcn_readfirstlane(TOKSLOT[2 * (t0 + u) + 1]);
                g0[u] = TOKGATE[2 * (t0 + u)]; g1[u] = TOKGATE[2 * (t0 + u) + 1];
                r0[u] = __builtin_amdgcn_readlane(pre, s0 >> 14) + (s0 & (T - 1)); r1[u] = __builtin_amdgcn_readlane(pre, s1 >> 14) + (s1 & (T - 1)); }
            u32x2 xw[4][4], y0[4][4], y1[4][4];
#pragma unroll
            for (int u = 0; u < 4; ++u)
#pragma unroll
                for (int j = 0; j < 4; ++j) { xw[u][j] = *(const u32x2*)(X1 + (size_t)(t0 + u) * D + 256 * j + 4 * lane); y0[u][j] = *(const u32x2*)(Y + (size_t)r0[u] * D + 256 * j + 4 * lane); y1[u][j] = *(const u32x2*)(Y + (size_t)r1[u] * D + 256 * j + 4 * lane); }
#pragma unroll
            for (int u = 0; u < 4; ++u) { const int t = t0 + u; f32x4 v[4]; float s = 0.f;
#pragma unroll
                for (int j = 0; j < 4; ++j) {
                    v[j][0] = ALPHA * bf_lo(xw[u][j].x) + (g0[u] * bf_lo(y0[u][j].x) + g1[u] * bf_lo(y1[u][j].x)); v[j][1] = ALPHA * bf_hi(xw[u][j].x) + (g0[u] * bf_hi(y0[u][j].x) + g1[u] * bf_hi(y1[u][j].x));
                    v[j][2] = ALPHA * bf_lo(xw[u][j].y) + (g0[u] * bf_lo(y0[u][j].y) + g1[u] * bf_lo(y1[u][j].y)); v[j][3] = ALPHA * bf_hi(xw[u][j].y) + (g0[u] * bf_hi(y0[u][j].y) + g1[u] * bf_hi(y1[u][j].y));
                    s += (v[j][0] + v[j][1]) + (v[j][2] + v[j][3]); }
                const float mean = wave_sum(s) * (1.0f / D); float q = 0.f;
#pragma unroll
                for (int j = 0; j < 4; ++j) { v[j] = v[j] - mean; q += (v[j][0] * v[j][0] + v[j][1] * v[j][1]) + (v[j][2] * v[j][2] + v[j][3] * v[j][3]); }
                const float rstd = 1.0f / sqrtf(wave_sum(q) * (1.0f / D) + LN_EPS);
#pragma unroll
                for (int j = 0; j < 4; ++j) { const f32x4 o = v[j] * rstd * gg[j] + bb[j];
                    if (layer == 0) { u32x2 w; w.x = cvt_pk_bf16(o[0], o[1]); w.y = cvt_pk_bf16(o[2], o[3]); *(u32x2*)(X2 + (size_t)t * D + 256 * j + 4 * lane) = w;
#if INP_FP8_L1
                        *(unsigned*)(F.W<unsigned char>(WS_XQ) + (size_t)t * D + 256 * j + 4 * lane) = pack4_fp8(o[0], o[1], o[2], o[3]);
#endif
                    }
                    else __builtin_nontemporal_store(o, (f32x4*)(F.out + (size_t)t * D + 256 * j + 4 * lane)); }
            }
        }
    }
}

__device__ __forceinline__ void p_conv4(Frame& F) {
    F.retid();
    const bf16_t* XR = F.W<bf16_t>(WS_XR); bf16_t* XC = F.W<bf16_t>(WS_XC); const float* w = F.I(13); const float* bias = F.I(14);
    const int lane = F.lane;
#pragma unroll 1
    for (int it = F.vcu * NWAVES + F.wave; it < (T / 8) * 2; it += F.G * NWAVES) {
        const int tb = it >> 1, c0 = 8 * lane + 512 * (it & 1), t0 = tb * 8, s0 = t0 & (SEQ - 1);
        f32x4 wk[CONVC][2], bs[2];
#pragma unroll
        for (int k = 0; k < CONVC; ++k) { wk[k][0] = *(const f32x4*)(w + k * DRNN + c0); wk[k][1] = *(const f32x4*)(w + k * DRNN + c0 + 4); }
        bs[0] = *(const f32x4*)(bias + c0); bs[1] = *(const f32x4*)(bias + c0 + 4);
        u32x4 in[11];
#pragma unroll
        for (int j = 0; j < 11; ++j) { const int d = 3 - j; const bool ok = (s0 - d >= 0); const size_t rr = ok ? (size_t)(t0 - d) : (size_t)t0;
            in[j] = *(const u32x4*)(XR + rr * DRNN + c0); if (!ok) in[j] = (u32x4){0u, 0u, 0u, 0u}; }
#pragma unroll
        for (int r = 0; r < 8; ++r) { f32x4 a0 = bs[0], a1 = bs[1];
#pragma unroll
            for (int k = 0; k < CONVC; ++k) { const u32x4 xw = in[r + k];
                a0 += wk[k][0] * (f32x4){bf_lo(xw.x), bf_hi(xw.x), bf_lo(xw.y), bf_hi(xw.y)}; a1 += wk[k][1] * (f32x4){bf_lo(xw.z), bf_hi(xw.z), bf_lo(xw.w), bf_hi(xw.w)}; }
            *(u32x4*)(XC + (size_t)(t0 + r) * DRNN + c0) = pg8::pack8(a0, a1); }
    }
}

constexpr int SCH = 64, NCHUNK = SEQ / SCH;
__device__ __forceinline__ void p_scan1(Frame& F) {
    F.retid();
    const bf16_t* L2A = F.W<bf16_t>(WS_XR); const bf16_t* BV = F.W<bf16_t>(WS_BV); float* AGG = F.W<float>(WS_AGG);
    for (int task = F.vcu * NWAVES + F.wave; task < BATCH * NCHUNK * 8; task += F.G * NWAVES) {
        const int bc = task >> 3, c = (task & 7) * 128 + 2 * F.lane; const size_t base = (size_t)task * SCH * 128 + 2 * F.lane;
        float sl0 = 0.f, sl1 = 0.f, h0 = 0.f, h1 = 0.f;
#pragma unroll 16
        for (int s = 0; s < SCH; ++s) { const unsigned lw = *(const unsigned*)(L2A + base + (size_t)s * 128), bw = *(const unsigned*)(BV + base + (size_t)s * 128);
            const float l0 = bf_lo(lw), l1 = bf_hi(lw); sl0 += l0; sl1 += l1;
            h0 = __builtin_amdgcn_exp2f(l0) * h0 + bf_lo(bw); h1 = __builtin_amdgcn_exp2f(l1) * h1 + bf_hi(bw); }
        *(f32x4*)(AGG + ((size_t)bc * DRNN + c) * 2) = (f32x4){sl0, h0, sl1, h1};
    }
}
__device__ __forceinline__ void p_scan2(Frame& F, bool dummy = false) {
    F.retid();
    const bf16_t* L2A = F.W<bf16_t>(WS_XR); const bf16_t* BV = F.W<bf16_t>(WS_BV); const float* AGG = F.W<float>(WS_AGG); bf16_t* GY = F.W<bf16_t>(WS_GY); bf16_t* OUTB = dummy ? F.W<bf16_t>(WS_XC) : GY;
#pragma unroll 1
    for (int task = F.vcu * NWAVES + F.wave; task < BATCH * NCHUNK * 8; task += F.G * NWAVES) {
        const int bc = task >> 3, c = (task & 7) * 128 + 2 * F.lane; const int b = bc / NCHUNK, ch = bc % NCHUNK;
        float h0 = 0.f, h1 = 0.f;
#pragma unroll 1
        for (int j0 = 0; j0 < ch; j0 += 16) { f32x4 g[16];
#pragma unroll
            for (int i = 0; i < 16; ++i) { const int j = j0 + i; const int jc = j < ch ? j : ch - 1; g[i] = *(const f32x4*)(AGG + ((size_t)(b * NCHUNK + jc) * DRNN + c) * 2); if (j >= ch) g[i] = (f32x4){0.f, 0.f, 0.f, 0.f}; }
#pragma unroll
            for (int i = 0; i < 16; ++i) { h0 = __builtin_amdgcn_exp2f(g[i][0]) * h0 + g[i][1]; h1 = __builtin_amdgcn_exp2f(g[i][2]) * h1 + g[i][3]; } }
        const size_t base = (size_t)bc * SCH * DRNN + c, bbase = (size_t)task * SCH * 128 + 2 * F.lane;
#pragma unroll 1
        for (int s0 = 0; s0 < SCH; s0 += 16) { unsigned lw[16], bw[16], gw[16];
#pragma unroll
            for (int i = 0; i < 16; ++i) { const size_t o = base + (size_t)(s0 + i) * DRNN, ob = bbase + (size_t)(s0 + i) * 128; lw[i] = *(const unsigned*)(L2A + ob); bw[i] = *(const unsigned*)(BV + ob); gw[i] = *(const unsigned*)(GY + o); }
#pragma unroll
            for (int i = 0; i < 16; ++i) { h0 = __builtin_amdgcn_exp2f(bf_lo(lw[i])) * h0 + bf_lo(bw[i]); h1 = __builtin_amdgcn_exp2f(bf_hi(lw[i])) * h1 + bf_hi(bw[i]);
                gw[i] = cvt_pk_bf16(bf_lo(gw[i]) * h0, bf_hi(gw[i]) * h1); }
#pragma unroll
            for (int i = 0; i < 16; ++i) *(unsigned*)(OUTB + base + (size_t)(s0 + i) * DRNN) = gw[i]; }
    }
}

constexpr int NPH = 18;
#ifndef N_LAUNCHES
#define N_LAUNCHES 1
#endif
__global__ void __launch_bounds__(NTHREADS, 2) mega_fwd(Args args) {
    extern __shared__ __attribute__((aligned(16))) unsigned char lds_raw[];
    Frame F;
    F.lds = (LAS unsigned char*)lds_raw; F.ws = args.ws; F.in = args.in; F.out = args.out;
    F.tid = threadIdx.x; F.lane = F.tid & 63; F.wave = __builtin_amdgcn_readfirstlane(F.tid >> 6);
    F.G = gridDim.x; { const int bx = blockIdx.x; F.vcu = (F.G % 8 == 0) ? (bx % 8) * (F.G / 8) + bx / 8 : bx; }
    for (int u = F.tid; u < (LDS_BYTES - LDSCTL_OFF) / 4; u += NTHREADS) ((LAS unsigned*)(F.lds + LDSCTL_OFF))[u] = 0u;
    __syncthreads();
    XcdBarrier bar; bar.bar = F.ctl() + CW_BAR; bar.x = 0; bar.st = nullptr; bar.wave = F.wave;
    if (N_LAUNCHES == 1) bar = xcd_barrier_post(F.ctl() + CW_BAR, (volatile LAS unsigned*)(F.lds + MISC_OFF) + 8, F.wave);
    const int lo = args.ph_lo, hi = args.ph_hi;
#ifndef PH_MASK
#define PH_MASK 0x3ffff
#endif
#define IN(k) (((PH_MASK >> (k)) & 1) && lo <= (k) && (k) < hi)
#define SEAM(k) do { if (IN(k) && IN((k) + 1)) xcd_barrier(bar); } while (0)
    const int cblk = (int)blockIdx.x;

#ifndef REP_MASK
#define REP_MASK 0
#endif
#ifndef EXTRA_BARS
#define EXTRA_BARS 0
#endif
#define REPS(k) ((((REP_MASK) >> ((k) % 32)) & 1) ? 2 : 1)
#define PHASE(k, ...) do { if (IN(k)) { for (int rep_ = 0; rep_ < REPS(k); ++rep_) { __VA_ARGS__; if (rep_ + 1 < REPS(k)) xcd_barrier(bar); } } SEAM(k); } while (0)
    for (int i = 0; i < EXTRA_BARS; ++i) xcd_barrier(bar);
    PHASE(0, p0_prologue(F));
#if INP_FP8_L0
    PHASE(1, { DenseOrder S{F.W<char>(WS_XQ), F.W<char>(WS_WIN0), (size_t)256 * D, (size_t)256 * D, T / 256, DIN0 / 256, F.G, cblk};
        pg8::EpiIn0 E{F.W<bf16_t>(WS_U0)}; pg8::gemm_phase<pg8::EpiIn0, DenseOrder, false, 1>(F.lds, F.wave, D, D, D, S, E, 0x01010101 * (127 - SCL_WIN / 2)); });
#else
    PHASE(1, { DenseOrder S{F.W<char>(WS_XB), F.W<char>(WS_WIN0), (size_t)256 * D * 2, (size_t)256 * D * 2, T / 256, DIN0 / 256, F.G, cblk};
        pg8::EpiIn0 E{F.W<bf16_t>(WS_U0)}; pg8::gemm_phase<pg8::EpiIn0, DenseOrder, false>(F.lds, F.wave, 2 * D, 2 * D, 2 * D, S, E); });
#endif
    PHASE(2, p_mix0(F));
    PHASE(3, { DenseOrder S{F.W<char>(WS_CAT0), F.W<char>(WS_WOUT0), (size_t)256 * D * 2, (size_t)256 * D * 2, T / 256, D / 256, F.G, cblk};
        pg8::EpiRes E{F.W<bf16_t>(WS_XB), F.W<bf16_t>(WS_YPRE0)}; pg8::gemm_phase<pg8::EpiRes, DenseOrder, false>(F.lds, F.wave, 2 * D, 2 * D, 2 * D, S, E); });
    PHASE(4, p_ln1_route(F, 0, F.W<bf16_t>(WS_YPRE0), rep_ + 1 < REPS(4)));
#pragma unroll 1
    for (int layer = 0; layer < 2; ++layer) {
        const int pb = layer == 0 ? 5 : 15;
#if MOE_FP8
        PHASE(pb, { const int nu = moe_setup(F, layer, 2 * DEXP / 256, true, D);
            MoeOrder S{(LAS const int*)(F.lds + UNITS_OFF), nu, F.W<char>(WS_X1Q), F.W<char>(WS_W13) + (size_t)layer * NE * 2 * DEXP * D, (size_t)2 * DEXP * D, (size_t)256 * D, 0, true};
            pg8::EpiMoe1Q E{F.W<unsigned char>(WS_H)}; pg8::gemm_phase<pg8::EpiMoe1Q, MoeOrder, true, 1>(F.lds, F.wave, D, D, D, S, E, 0x01010101 * (127 - SCL_W13 / 2)); });
        PHASE(pb + 1, { const int nu = moe_setup(F, layer, D / 256, false, 0);
            MoeOrder S{(LAS const int*)(F.lds + UNITS_OFF), nu, F.W<char>(WS_H), F.W<char>(WS_W2) + (size_t)layer * NE * D * DEXP, (size_t)D * DEXP, (size_t)256 * DEXP, (size_t)256 * DEXP, false};
            pg8::EpiMoe2 E{F.W<bf16_t>(WS_Y)}; pg8::gemm_phase<pg8::EpiMoe2, MoeOrder, false, 1>(F.lds, F.wave, DEXP, DEXP, DEXP, S, E, 0x01010101 * (127 - SCL_W2 / 2)); });
#else
        PHASE(pb, { const int nu = moe_setup(F, layer, 2 * DEXP / 256, true, 2 * D);
            MoeOrder S{(LAS const int*)(F.lds + UNITS_OFF), nu, F.W<char>(WS_X1), F.W<char>(WS_W13) + (size_t)layer * NE * 2 * DEXP * D * 2, (size_t)2 * DEXP * D * 2, (size_t)256 * D * 2, 0, true};
            pg8::EpiMoe1 E{F.W<bf16_t>(WS_H)}; pg8::gemm_phase<pg8::EpiMoe1, MoeOrder, true>(F.lds, F.wave, 2 * D, 2 * D, 2 * D, S, E); });
        PHASE(pb + 1, { const int nu = moe_setup(F, layer, D / 256, false, 0);
            MoeOrder S{(LAS const int*)(F.lds + UNITS_OFF), nu, F.W<char>(WS_H), F.W<char>(WS_W2) + (size_t)layer * NE * D * DEXP * 2, (size_t)D * DEXP * 2, (size_t)256 * DEXP * 2, (size_t)256 * DEXP * 2, false};
            pg8::EpiMoe2 E{F.W<bf16_t>(WS_Y)}; pg8::gemm_phase<pg8::EpiMoe2, MoeOrder, false>(F.lds, F.wave, 2 * DEXP, 2 * DEXP, 2 * DEXP, S, E); });
#endif
        PHASE(pb + 2, p_combine(F, layer));
        if (layer == 0) {
#if INP_FP8_L1
            PHASE(8, { DenseOrder S{F.W<char>(WS_XQ), F.W<char>(WS_WIN1), (size_t)256 * D, (size_t)256 * D, T / 256, 2 * DRNN / 256, F.G, cblk};
                pg8::EpiIn1 E{F.W<bf16_t>(WS_GY), F.W<bf16_t>(WS_XR)}; pg8::gemm_phase<pg8::EpiIn1, DenseOrder, false, 1>(F.lds, F.wave, D, D, D, S, E, 0x01010101 * (127 - SCL_WIN / 2)); });
#else
            PHASE(8, { DenseOrder S{F.W<char>(WS_X2), F.W<char>(WS_WIN1), (size_t)256 * D * 2, (size_t)256 * D * 2, T / 256, 2 * DRNN / 256, F.G, cblk};
                pg8::EpiIn1 E{F.W<bf16_t>(WS_GY), F.W<bf16_t>(WS_XR)}; pg8::gemm_phase<pg8::EpiIn1, DenseOrder, false>(F.lds, F.wave, 2 * D, 2 * D, 2 * D, S, E); });
#endif
            PHASE(9, p_conv4(F));
            PHASE(10, { GatesOrder S{F.W<char>(WS_XC), F.W<char>(WS_WGT), F.G, cblk};
                pg8::EpiGates E{F.W<bf16_t>(WS_XC), F.I(16), F.I(18), F.W<float>(WS_SPL), F.W<bf16_t>(WS_XR), F.W<bf16_t>(WS_BV)};
                pg8::gemm_phase<pg8::EpiGates, GatesOrder, false>(F.lds, F.wave, 2 * DRNN, 2 * RBLK, 2 * RBLK, S, E); });
            PHASE(11, p_scan1(F));
            PHASE(12, p_scan2(F, rep_ + 1 < REPS(12)));
            PHASE(13, { DenseOrder S{F.W<char>(WS_GY), F.W<char>(WS_WOUT1), (size_t)256 * DRNN * 2, (size_t)256 * DRNN * 2, T / 256, D / 256, F.G, cblk};
                pg8::EpiRes E{F.W<bf16_t>(WS_X2), F.W<bf16_t>(WS_YPRE1)}; pg8::gemm_phase<pg8::EpiRes, DenseOrder, false>(F.lds, F.wave, 2 * DRNN, 2 * DRNN, 2 * DRNN, S, E); });
            PHASE(14, p_ln1_route(F, 1, F.W<bf16_t>(WS_YPRE1), rep_ + 1 < REPS(14)));
        }
    }
#undef PHASE
#undef REPS
#undef IN
#undef SEAM
}

static int g_grid = 0;
static inline bool fast_setup() {
    if (g_grid == 0) {
        int dev = 0, cus = 0, per_cu = 0;
        if (hipGetDevice(&dev) != hipSuccess || hipDeviceGetAttribute(&cus, hipDeviceAttributeMultiprocessorCount, dev) != hipSuccess) { fprintf(stderr, "kernel_launch: device query failed\n"); g_grid = -1; return false; }
        if (hipFuncSetAttribute((const void*)mega_fwd, hipFuncAttributeMaxDynamicSharedMemorySize, LDS_BYTES) != hipSuccess) { fprintf(stderr, "kernel_launch: hipFuncSetAttribute failed\n"); g_grid = -1; return false; }
        if (hipOccupancyMaxActiveBlocksPerMultiprocessor(&per_cu, (const void*)mega_fwd, NTHREADS, LDS_BYTES) != hipSuccess || per_cu < 1) { fprintf(stderr, "kernel_launch: occupancy query says %d blocks per CU\n", per_cu); (void)hipGetLastError(); per_cu = 1; }
        g_grid = cus;
        if (g_grid > 256) g_grid = 256;
    }
    return g_grid > 0;
}
static inline void fast_launch(void* const* d_in, void* d_out, void* d_ws, hipStream_t stream, int lo, int hi) {
    Args a{};
    for (int i = 0; i < 26; ++i) a.in[i] = (const float*)d_in[i];
    a.out = (float*)d_out; a.ws = (unsigned char*)d_ws; a.ph_lo = lo; a.ph_hi = hi;
    hipLaunchKernelGGL(mega_fwd, dim3(g_grid), dim3(NTHREADS), LDS_BYTES, stream, a);
}
extern "C" void kernel_launch(void* const* d_in, const int* in_sizes, int n_in, void* d_out, int out_size, void* d_ws, size_t ws_size, hipStream_t stream) {
    if (n_in != 26 || out_size != T * D || ws_size < WS_FAST_END) { fprintf(stderr, "kernel_launch: unexpected shapes (n_in %d out %d ws %zu)\n", n_in, out_size, ws_size); return; }
    if (!fast_setup()) return;
    if (hipMemsetAsync((char*)d_ws + WS_CTL, 0, CTL_ZERO_BYTES, stream) != hipSuccess) { fprintf(stderr, "kernel_launch: memset failed\n"); return; }
    if (N_LAUNCHES == 1) fast_launch(d_in, d_out, d_ws, stream, 0, NPH);
    else for (int p = 0; p < NPH; ++p) fast_launch(d_in, d_out, d_ws, stream, p, p + 1);
}
```
